# Optimizing an MI355X kernel written in HIP

```python
import jax, jax.numpy as jnp
from jax import lax
import numpy as np

D_MODEL = 1024
BATCH = 8
SEQ = 2048
DEPTH = 4

CHUNK = 64
N_LEFT_CHUNKS = 8
HEAD_DIM = 64
D_ATT = 3 * D_MODEL // 8
D_RET = 3 * D_MODEL // 8
D_CONV = D_MODEL - D_ATT - D_RET
D_MIX = D_ATT + D_CONV + D_RET
H_ATT = D_ATT // HEAD_DIM
H_RET = D_RET // HEAD_DIM
CONV_K = 31
REL_CLIP = 128
D_FF = 4 * D_MODEL
D_PLE = 256
ROPE_THETA = 10000.0
EPS = 1e-6
SPLIT_SIZES = [D_ATT, D_ATT, D_ATT, 2 * D_CONV, D_RET, D_RET, D_RET, D_RET]
D_IN = sum(SPLIT_SIZES)

kernel_name = "hymba_style_chunk_causal_hybrid_trunk"


def rmsnorm(x, g):
    xf = x.astype(jnp.float32)
    y = xf * lax.rsqrt(jnp.mean(xf * xf, axis=-1, keepdims=True) + EPS)
    return (y * g.astype(jnp.float32)).astype(x.dtype)


def layernorm(x, g, b):
    xf = x.astype(jnp.float32)
    mu = jnp.mean(xf, axis=-1, keepdims=True)
    var = jnp.mean(jnp.square(xf - mu), axis=-1, keepdims=True)
    y = (xf - mu) * lax.rsqrt(var + EPS)
    return (y * g.astype(jnp.float32) + b.astype(jnp.float32)).astype(x.dtype)


def to_chunk_heads(t, n_heads):
    b, s, _ = t.shape
    return t.reshape(b, s // CHUNK, CHUNK, n_heads, HEAD_DIM).transpose(0, 3, 1, 2, 4)


def from_chunk_heads(t):
    b, h, nc, c, d = t.shape
    return t.transpose(0, 2, 3, 1, 4).reshape(b, nc * c, h * d)


def chunked_attention(q, k, v, qn_g, kn_g, rel_bias):
    q = rmsnorm(to_chunk_heads(q, H_ATT), qn_g)
    k = rmsnorm(to_chunk_heads(k, H_ATT), kn_g)
    v = to_chunk_heads(v, H_ATT)
    b, h, nc, c, d = q.shape
    band = N_LEFT_CHUNKS + 1
    pad = ((0, 0), (0, 0), (N_LEFT_CHUNKS, 0), (0, 0), (0, 0))
    idx = jnp.arange(nc)[:, None] + jnp.arange(band)[None, :]
    kb = jnp.pad(k, pad)[:, :, idx].reshape(b, h, nc, band * c, d)
    vb = jnp.pad(v, pad)[:, :, idx].reshape(b, h, nc, band * c, d)
    valid = jnp.repeat(idx >= N_LEFT_CHUNKS, c, axis=1)
    q_pos = N_LEFT_CHUNKS * c + jnp.arange(c)
    rel = q_pos[:, None] - jnp.arange(band * c)[None, :]
    bias = rel_bias.astype(jnp.float32)[:, jnp.clip(rel, -REL_CLIP, REL_CLIP) + REL_CLIP]
    scores = jnp.einsum('bhncd,bhnkd->bhnck', q, kb).astype(jnp.float32) * (d ** -0.5)
    scores = scores + bias[None, :, None]
    scores = jnp.where(valid[None, None, :, None, :], scores, -1e30)
    probs = jax.nn.softmax(scores, axis=-1).astype(v.dtype)
    out = jnp.einsum('bhnck,bhnkd->bhncd', probs, vb)
    return from_chunk_heads(out)


def conformer_conv(u, conv_w, conv_b, ln_g, ln_b, pw_w, pw_b):
    a, gate = jnp.split(u, 2, axis=-1)
    glu = a * jax.nn.sigmoid(gate)
    y = lax.conv_general_dilated(
        glu, conv_w[:, None, :].astype(glu.dtype), window_strides=(1,),
        padding=[(CONV_K - 1, 0)], dimension_numbers=('NWC', 'WIO', 'NWC'),
        feature_group_count=D_CONV)
    y = layernorm(y + conv_b, ln_g, ln_b)
    y = jax.nn.silu(y)
    return y @ pw_w + pw_b


def rope(t, cos, sin):
    t1, t2 = jnp.split(t, 2, axis=-1)
    c = cos[None, :, None, :]
    s = sin[None, :, None, :]
    return jnp.concatenate([t1 * c - t2 * s, t1 * s + t2 * c], axis=-1)


def retention(q, k, v, g, gn_g):
    b, s, _ = q.shape
    nc = s // CHUNK
    pos = jnp.arange(s, dtype=jnp.float32)
    inv_freq = ROPE_THETA ** (-jnp.arange(0, HEAD_DIM, 2, dtype=jnp.float32) / HEAD_DIM)
    ang = pos[:, None] * inv_freq[None, :]
    cos, sin = jnp.cos(ang), jnp.sin(ang)
    qf = rope(q.astype(jnp.float32).reshape(b, s, H_RET, HEAD_DIM), cos, sin) * (HEAD_DIM ** -0.5)
    kf = rope(k.astype(jnp.float32).reshape(b, s, H_RET, HEAD_DIM), cos, sin)
    qc = qf.reshape(b, nc, CHUNK, H_RET, HEAD_DIM).transpose(0, 3, 1, 2, 4)
    kc = kf.reshape(b, nc, CHUNK, H_RET, HEAD_DIM).transpose(0, 3, 1, 2, 4)
    vc = to_chunk_heads(v.astype(jnp.float32), H_RET)
    log_gamma = jnp.log(1.0 - 2.0 ** (-5.0 - jnp.arange(H_RET, dtype=jnp.float32)))
    n = jnp.arange(CHUNK, dtype=jnp.float32)
    dist = jnp.abs(n[:, None] - n[None, :])
    d_intra = jnp.exp(log_gamma[:, None, None] * dist[None])
    intra = jnp.einsum('bhncm,bhnme->bhnce',
                       jnp.einsum('bhncd,bhnmd->bhncm', qc, kc) * d_intra[None, :, None], vc)
    k_dec = kc * jnp.exp(log_gamma[:, None] * (CHUNK - 1 - n)[None, :])[None, :, None, :, None]
    kv = jnp.einsum('bhnmd,bhnme->bhnde', k_dec, vc)
    chunk_decay = jnp.exp(log_gamma * CHUNK)[None, :, None, None]

    def step(state, kv_c):
        return chunk_decay * state + kv_c, state

    init = jnp.zeros((b, H_RET, HEAD_DIM, HEAD_DIM), jnp.float32)
    _, prev = lax.scan(step, init, jnp.moveaxis(kv, 2, 0))
    prev = jnp.moveaxis(prev, 0, 2)
    q_dec = qc * jnp.exp(log_gamma[:, None] * (n + 1.0)[None, :])[None, :, None, :, None]
    cross = jnp.einsum('bhncd,bhnde->bhnce', q_dec, prev)
    out = intra + cross
    mu = jnp.mean(out, axis=-1, keepdims=True)
    var = jnp.mean(jnp.square(out - mu), axis=-1, keepdims=True)
    out = from_chunk_heads((out - mu) * lax.rsqrt(var + EPS)) * gn_g.astype(jnp.float32)
    return (jax.nn.silu(g.astype(jnp.float32)) * out).astype(q.dtype)


def setup_inputs(seed: int = 0) -> dict:
    key = jax.random.key(seed)
    ks = jax.random.split(key, 24)
    f32 = jnp.float32

    def nrm(k, shape, scale):
        return jax.random.normal(k, shape, f32) * scale

    def gain(k, shape):
        return 1.0 + 0.02 * jax.random.normal(k, shape, f32)

    L = DEPTH
    return {
        "x": nrm(ks[0], (BATCH, SEQ, D_MODEL), 1.0),
        "p": nrm(ks[1], (DEPTH, BATCH, SEQ, D_PLE), 1.0),
        "norm_mix_g": gain(ks[2], (L, D_MODEL)),
        "w_in": nrm(ks[3], (L, D_MODEL, D_IN), D_MODEL ** -0.5),
        "qn_g": gain(ks[4], (L, HEAD_DIM)),
        "kn_g": gain(ks[5], (L, HEAD_DIM)),
        "rel_bias": nrm(ks[6], (L, H_ATT, 2 * REL_CLIP + 1), 0.1),
        "conv_w": nrm(ks[7], (L, CONV_K, D_CONV), CONV_K ** -0.5),
        "conv_b": nrm(ks[8], (L, D_CONV), 0.02),
        "conv_ln_g": gain(ks[9], (L, D_CONV)),
        "conv_ln_b": nrm(ks[10], (L, D_CONV), 0.02),
        "conv_pw_w": nrm(ks[11], (L, D_CONV, D_CONV), D_CONV ** -0.5),
        "conv_pw_b": nrm(ks[12], (L, D_CONV), 0.02),
        "ret_gn_g": gain(ks[13], (L, D_RET)),
        "w_o": nrm(ks[14], (L, D_MIX, D_MODEL), D_MIX ** -0.5),
        "norm_ffn_g": gain(ks[15], (L, D_MODEL)),
        "w1": nrm(ks[16], (L, D_MODEL, D_FF), D_MODEL ** -0.5),
        "w2": nrm(ks[17], (L, D_FF, D_MODEL), D_FF ** -0.5),
        "norm_ple_g": gain(ks[18], (L, D_MODEL)),
        "w_pg": nrm(ks[19], (L, D_MODEL, D_MODEL), D_MODEL ** -0.5),
        "w_ple": nrm(ks[20], (L, D_PLE, D_MODEL), D_PLE ** -0.5),
    }


def reference(x, p, norm_mix_g, w_in, qn_g, kn_g, rel_bias, conv_w, conv_b, conv_ln_g,
              conv_ln_b, conv_pw_w, conv_pw_b, ret_gn_g, w_o, norm_ffn_g, w1, w2,
              norm_ple_g, w_pg, w_ple):
    offsets = np.cumsum(SPLIT_SIZES)[:-1].tolist()
    h = x
    for i in range(DEPTH):
        xn = rmsnorm(h, norm_mix_g[i])
        proj = xn @ w_in[i]
        qa, ka, va, uc, qr, kr, vr, gr = jnp.split(proj, offsets, axis=-1)
        att = chunked_attention(qa, ka, va, qn_g[i], kn_g[i], rel_bias[i])
        conv = conformer_conv(uc, conv_w[i], conv_b[i], conv_ln_g[i], conv_ln_b[i],
                              conv_pw_w[i], conv_pw_b[i])
        ret = retention(qr, kr, vr, gr, ret_gn_g[i])
        h = h + jnp.concatenate([att, conv, ret], axis=-1) @ w_o[i]
        hn = rmsnorm(h, norm_ffn_g[i])
        h = h + jnp.square(jax.nn.relu(hn @ w1[i])) @ w2[i]
        gate = jax.nn.sigmoid(rmsnorm(h, norm_ple_g[i]) @ w_pg[i])
        h = h + gate * (p[i] @ w_ple[i])
    return h
```

```cpp
#include <hip/hip_runtime.h>
#include <cstdio>
#include <cstdint>

namespace {
constexpr int D_MODEL = 1024, BATCH = 8, SEQ = 2048, DEPTH = 4, CHUNK = 64, NLEFT = 8, HD = 64;
constexpr int D_ATT = 384, D_RET = 384, D_CONV = 256, H_ATT = 6, H_RET = 6, CONV_K = 31, REL_CLIP = 128;
constexpr int D_FF = 4096, D_PLE = 256, D_IN = 3200, M = BATCH * SEQ, NC = SEQ / CHUNK;
constexpr float EPS = 1e-6f;
constexpr int C_QA = 0, C_KA = 384, C_VA = 768, C_UC = 1152, C_QR = 1664, C_KR = 2048, C_VR = 2432, C_GR = 2816;

template <int EPI>
__global__ __launch_bounds__(256) void k_gemm(const float* __restrict__ A, int lda, const float* __restrict__ W, int ldw, float* C, int ldc, int K, const float* aux, int ldaux) {
    __shared__ float As[16][68];
    __shared__ float Ws[16][68];
    const int t = threadIdx.x, tx = t & 15, ty = t >> 4;
    const int m0 = blockIdx.y * 64, n0 = blockIdx.x * 64;
    float acc[4][4];
#pragma unroll
    for (int i = 0; i < 4; ++i)
#pragma unroll
        for (int j = 0; j < 4; ++j) acc[i][j] = 0.f;
    for (int k0 = 0; k0 < K; k0 += 16) {
        const float4 a = *(const float4*)(A + (size_t)(m0 + (t >> 2)) * lda + k0 + (t & 3) * 4);
        const float4 w = *(const float4*)(W + (size_t)(k0 + (t >> 4)) * ldw + n0 + (t & 15) * 4);
        As[(t & 3) * 4 + 0][t >> 2] = a.x; As[(t & 3) * 4 + 1][t >> 2] = a.y; As[(t & 3) * 4 + 2][t >> 2] = a.z; As[(t & 3) * 4 + 3][t >> 2] = a.w;
        *(float4*)&Ws[t >> 4][(t & 15) * 4] = w;
        __syncthreads();
#pragma unroll
        for (int k = 0; k < 16; ++k) {
            const float4 av = *(const float4*)&As[k][ty * 4];
            const float4 bv = *(const float4*)&Ws[k][tx * 4];
            const float aa[4] = {av.x, av.y, av.z, av.w}, bb[4] = {bv.x, bv.y, bv.z, bv.w};
#pragma unroll
            for (int i = 0; i < 4; ++i)
#pragma unroll
                for (int j = 0; j < 4; ++j) acc[i][j] = fmaf(aa[i], bb[j], acc[i][j]);
        }
        __syncthreads();
    }
#pragma unroll
    for (int i = 0; i < 4; ++i) {
        const int row = m0 + ty * 4 + i;
#pragma unroll
        for (int j = 0; j < 4; ++j) {
            const int col = n0 + tx * 4 + j;
            float* cp = C + (size_t)row * ldc + col;
            const float v = acc[i][j];
            if (EPI == 0) *cp = v;
            else if (EPI == 1) *cp = *cp + v;
            else if (EPI == 2) { const float r = v > 0.f ? v : 0.f; *cp = r * r; }
            else if (EPI == 3) *cp = v + aux[col];
            else if (EPI == 5) { const float g = aux[(size_t)row * ldaux + col]; *cp = *cp + v / (1.f + expf(-g)); }
        }
    }
}

__global__ __launch_bounds__(256) void k_rmsnorm(const float* __restrict__ x, const float* __restrict__ g, float* __restrict__ y) {
    const int row = blockIdx.x * 4 + (threadIdx.x >> 6), lane = threadIdx.x & 63;
    const float4* xr = (const float4*)(x + (size_t)row * D_MODEL);
    float4 v[4]; float s = 0.f;
#pragma unroll
    for (int j = 0; j < 4; ++j) { v[j] = xr[lane + 64 * j]; s += v[j].x * v[j].x + v[j].y * v[j].y + v[j].z * v[j].z + v[j].w * v[j].w; }
#pragma unroll
    for (int o = 1; o < 64; o <<= 1) s += __shfl_xor(s, o);
    const float r = rsqrtf(s * (1.f / D_MODEL) + EPS);
    float4* yr = (float4*)(y + (size_t)row * D_MODEL);
#pragma unroll
    for (int j = 0; j < 4; ++j) { const float4 gg = ((const float4*)g)[lane + 64 * j]; float4 o; o.x = v[j].x * r * gg.x; o.y = v[j].y * r * gg.y; o.z = v[j].z * r * gg.z; o.w = v[j].w * r * gg.w; yr[lane + 64 * j] = o; }
}

__device__ __forceinline__ void sincos_acc(float ang, float& s, float& c) {
    const double x = (double)ang;
    const double kd = rint(x * 0.63661977236758134);
    const double r = (x - kd * 1.5707963267948966) - kd * 6.123233995736766e-17;
    const int q = ((int)kd) & 3;
    const double r2 = r * r;
    const double sp = r * (1.0 + r2 * (-1.0 / 6 + r2 * (1.0 / 120 + r2 * (-1.0 / 5040 + r2 * (1.0 / 362880 + r2 * (-1.0 / 39916800))))));
    const double cp = 1.0 + r2 * (-0.5 + r2 * (1.0 / 24 + r2 * (-1.0 / 720 + r2 * (1.0 / 40320 + r2 * (-1.0 / 3628800 + r2 * (1.0 / 479001600))))));
    double ss, cc;
    if (q == 0) { ss = sp; cc = cp; } else if (q == 1) { ss = cp; cc = -sp; } else if (q == 2) { ss = -sp; cc = -cp; } else { ss = -cp; cc = sp; }
    s = (float)ss; c = (float)cc;
}
__global__ void k_rope_table(float2* cs) {
    const int idx = blockIdx.x * blockDim.x + threadIdx.x;
    if (idx >= SEQ * 32) return;
    const int pos = idx >> 5, i = idx & 31;
    const float inv_freq = powf(10000.0f, -(float)(2 * i) / 64.0f);
    const float ang = (float)pos * inv_freq;
    float s, c; sincos_acc(ang, s, c);
    cs[idx] = make_float2(c, s);
}

__global__ __launch_bounds__(256) void k_prep(float* proj, const float* __restrict__ qn_g, const float* __restrict__ kn_g, const float2* __restrict__ cs) {
    const int idx = blockIdx.x * blockDim.x + threadIdx.x;
    if (idx >= M * 28) return;
    const int m = idx / 28, w = idx % 28;
    float* row = proj + (size_t)m * D_IN;
    if (w < 12) {
        float* p = row + w * 64; const float* g = w < 6 ? qn_g : kn_g; const float sc = w < 6 ? 0.125f : 1.0f;
        float s = 0.f;
        for (int d = 0; d < 64; ++d) s += p[d] * p[d];
        const float r = rsqrtf(s * (1.f / 64.f) + EPS);
        for (int d = 0; d < 64; ++d) p[d] = p[d] * r * g[d] * sc;
    } else if (w < 24) {
        const int hh = w - 12; float* p = row + C_QR + hh * 64; const float sc = hh < 6 ? 0.125f : 1.0f;
        const int pos = m % SEQ;
        for (int i = 0; i < 32; ++i) {
            const float2 c = cs[pos * 32 + i]; const float t1 = p[i], t2 = p[i + 32];
            p[i] = (t1 * c.x - t2 * c.y) * sc; p[i + 32] = (t1 * c.y + t2 * c.x) * sc;
        }
    } else {
        const int qd = w - 24; float* p = row + C_UC + qd * 64;
        for (int c = 0; c < 64; ++c) { const float a = p[c], g = p[c + 256]; p[c] = a / (1.f + expf(-g)); }
    }
}

__global__ __launch_bounds__(64) void k_attn(const float* __restrict__ proj, const float* __restrict__ rel_bias, float* __restrict__ mix) {
    const int n = blockIdx.x, h = blockIdx.y, b = blockIdx.z, i = threadIdx.x;
    const size_t rowq = (size_t)b * SEQ + n * CHUNK + i;
    float q[64], o[64];
    const float* qp = proj + rowq * D_IN + C_QA + h * 64;
#pragma unroll
    for (int d = 0; d < 64; ++d) { q[d] = qp[d]; o[d] = 0.f; }
    float mx = -1e30f, l = 0.f;
    const float* rb = rel_bias + h * (2 * REL_CLIP + 1);
    const int c0 = n - NLEFT < 0 ? 0 : n - NLEFT;
    for (int c = c0; c <= n; ++c) {
        for (int jj = 0; jj < CHUNK; ++jj) {
            const size_t rowk = (size_t)b * SEQ + c * CHUNK + jj;
            const float* kp = proj + rowk * D_IN + C_KA + h * 64;
            const float* vp = proj + rowk * D_IN + C_VA + h * 64;
            float s = 0.f;
#pragma unroll
            for (int d = 0; d < 64; ++d) s = fmaf(q[d], kp[d], s);
            int rel = (n - c) * CHUNK + i - jj; rel = rel < -REL_CLIP ? -REL_CLIP : (rel > REL_CLIP ? REL_CLIP : rel);
            s += rb[rel + REL_CLIP];
            const float mn = fmaxf(mx, s), alpha = expf(mx - mn), p = expf(s - mn);
            l = l * alpha + p; mx = mn;
#pragma unroll
            for (int d = 0; d < 64; ++d) o[d] = fmaf(p, vp[d], o[d] * alpha);
        }
    }
    const float inv = 1.f / l;
    float* op = mix + rowq * D_MODEL + h * 64;
#pragma unroll
    for (int d = 0; d < 64; ++d) op[d] = o[d] * inv;
}

__global__ __launch_bounds__(256) void k_dwconv(const float* __restrict__ proj, const float* __restrict__ cw, const float* __restrict__ cb, float* __restrict__ y) {
    const int m = blockIdx.x, c = threadIdx.x, s = m % SEQ;
    float acc = cb[c];
    for (int j = 0; j < CONV_K; ++j) { const int sp = s - (CONV_K - 1) + j; if (sp >= 0) acc = fmaf(proj[(size_t)(m - (CONV_K - 1) + j) * D_IN + C_UC + c], cw[j * D_CONV + c], acc); }
    y[(size_t)m * D_CONV + c] = acc;
}
__global__ __launch_bounds__(256) void k_conv_ln(float* y, const float* __restrict__ g, const float* __restrict__ bt) {
    const int row = blockIdx.x * 4 + (threadIdx.x >> 6), lane = threadIdx.x & 63;
    float4 v = ((const float4*)(y + (size_t)row * D_CONV))[lane];
    float s = v.x + v.y + v.z + v.w;
#pragma unroll
    for (int o = 1; o < 64; o <<= 1) s += __shfl_xor(s, o);
    const float mu = s * (1.f / D_CONV);
    v.x -= mu; v.y -= mu; v.z -= mu; v.w -= mu;
    float q = v.x * v.x + v.y * v.y + v.z * v.z + v.w * v.w;
#pragma unroll
    for (int o = 1; o < 64; o <<= 1) q += __shfl_xor(q, o);
    const float r = rsqrtf(q * (1.f / D_CONV) + EPS);
    const float4 gg = ((const float4*)g)[lane], bb = ((const float4*)bt)[lane];
    float4 o; o.x = v.x * r * gg.x + bb.x; o.y = v.y * r * gg.y + bb.y; o.z = v.z * r * gg.z + bb.z; o.w = v.w * r * gg.w + bb.w;
    o.x = o.x / (1.f + expf(-o.x)); o.y = o.y / (1.f + expf(-o.y)); o.z = o.z / (1.f + expf(-o.z)); o.w = o.w / (1.f + expf(-o.w));
    ((float4*)(y + (size_t)row * D_CONV))[lane] = o;
}

__device__ __forceinline__ float log_gamma(int h) { return logf(1.0f - exp2f(-5.0f - (float)h)); }
__global__ __launch_bounds__(256) void k_ret_kv(const float* __restrict__ proj, float* __restrict__ kv) {
    const int n = blockIdx.x, h = blockIdx.y, b = blockIdx.z, t = threadIdx.x;
    __shared__ float ks[64][65], vs[64][65];
    const float lg = log_gamma(h);
    for (int i = t; i < 4096; i += 256) { const int m = i >> 6, d = i & 63; const size_t row = (size_t)b * SEQ + n * CHUNK + m;
        ks[m][d] = proj[row * D_IN + C_KR + h * 64 + d] * expf(lg * (float)(63 - m)); vs[m][d] = proj[row * D_IN + C_VR + h * 64 + d]; }
    __syncthreads();
    float* out = kv + ((size_t)((b * H_RET + h) * NC + n)) * 4096;
    for (int i = t; i < 4096; i += 256) { const int d = i >> 6, e = i & 63; float a = 0.f;
        for (int m = 0; m < 64; ++m) a = fmaf(ks[m][d], vs[m][e], a);
        out[i] = a; }
}
__global__ __launch_bounds__(256) void k_ret_scan(float* kv) {
    const int bh = blockIdx.x, h = bh % H_RET;
    const float dec = expf(log_gamma(h) * (float)CHUNK);
    for (int i = threadIdx.x; i < 4096; i += 256) {
        float st = 0.f; float* p = kv + (size_t)bh * NC * 4096 + i;
        for (int n = 0; n < NC; ++n) { const float x = p[(size_t)n * 4096]; p[(size_t)n * 4096] = st; st = dec * st + x; }
    }
}
__global__ __launch_bounds__(256) void k_ret_out(const float* __restrict__ proj, const float* __restrict__ prev, const float* __restrict__ gn_g, float* __restrict__ mix) {
    const int n = blockIdx.x, h = blockIdx.y, b = blockIdx.z, t = threadIdx.x;
    __shared__ float qs[64][65], ks[64][65], vs[64][65], S[64][65];
    const float lg = log_gamma(h);
    for (int i = t; i < 4096; i += 256) { const int m = i >> 6, d = i & 63; const size_t row = (size_t)b * SEQ + n * CHUNK + m;
        qs[m][d] = proj[row * D_IN + C_QR + h * 64 + d]; ks[m][d] = proj[row * D_IN + C_KR + h * 64 + d]; vs[m][d] = proj[row * D_IN + C_VR + h * 64 + d]; }
    __syncthreads();
    for (int i = t; i < 4096; i += 256) { const int c = i >> 6, m = i & 63; float a = 0.f;
        for (int d = 0; d < 64; ++d) a = fmaf(qs[c][d], ks[m][d], a);
        const int dist = c > m ? c - m : m - c;
        S[c][m] = a * expf(lg * (float)dist); }
    __syncthreads();
    const float* pv = prev + ((size_t)((b * H_RET + h) * NC + n)) * 4096;
    float o[16];
#pragma unroll
    for (int r = 0; r < 16; ++r) { const int i = t + 256 * r; const int c = i >> 6, e = i & 63; float a = 0.f;
        for (int m = 0; m < 64; ++m) a = fmaf(S[c][m], vs[m][e], a);
        float x = 0.f;
        for (int d = 0; d < 64; ++d) x = fmaf(qs[c][d], pv[d * 64 + e], x);
        o[r] = a + x * expf(lg * (float)(c + 1)); }
    __syncthreads();
#pragma unroll
    for (int r = 0; r < 16; ++r) { const int i = t + 256 * r; ks[i >> 6][i & 63] = o[r]; }
    __syncthreads();
    for (int i = t; i < 4096; i += 256) { const int c = i >> 6, e = i & 63;
        float mu = 0.f; for (int d = 0; d < 64; ++d) mu += ks[c][d]; mu *= (1.f / 64.f);
        float var = 0.f; for (int d = 0; d < 64; ++d) { const float dd = ks[c][d] - mu; var += dd * dd; } var *= (1.f / 64.f);
        const size_t row = (size_t)b * SEQ + n * CHUNK + c;
        const float g = proj[row * D_IN + C_GR + h * 64 + e];
        const float y = (ks[c][e] - mu) * rsqrtf(var + EPS) * gn_g[h * 64 + e];
        mix[row * D_MODEL + D_ATT + D_CONV + h * 64 + e] = g / (1.f + expf(-g)) * y; }
}
}

extern "C" void kernel_launch(void* const* d_in, const int* in_sizes, int n_in, void* d_out, int out_size, void* d_ws, size_t ws_size, hipStream_t stream) {
    const float* x = (const float*)d_in[0]; const float* p = (const float*)d_in[1]; const float* norm_mix_g = (const float*)d_in[2]; const float* w_in = (const float*)d_in[3];
    const float* qn_g = (const float*)d_in[4]; const float* kn_g = (const float*)d_in[5]; const float* rel_bias = (const float*)d_in[6]; const float* conv_w = (const float*)d_in[7];
    const float* conv_b = (const float*)d_in[8]; const float* conv_ln_g = (const float*)d_in[9]; const float* conv_ln_b = (const float*)d_in[10]; const float* conv_pw_w = (const float*)d_in[11];
    const float* conv_pw_b = (const float*)d_in[12]; const float* ret_gn_g = (const float*)d_in[13]; const float* w_o = (const float*)d_in[14]; const float* norm_ffn_g = (const float*)d_in[15];
    const float* w1 = (const float*)d_in[16]; const float* w2 = (const float*)d_in[17]; const float* norm_ple_g = (const float*)d_in[18]; const float* w_pg = (const float*)d_in[19]; const float* w_ple = (const float*)d_in[20];
    float* h = (float*)d_out;
    constexpr size_t MiB = 1u << 20;
    if (ws_size < 306 * MiB) { fprintf(stderr, "kernel_launch: workspace too small (%zu)\n", ws_size); return; }
    float* PROJ = (float*)((char*)d_ws);
    float* XN = (float*)((char*)d_ws + 200 * MiB);
    float* KV = (float*)((char*)d_ws + 264 * MiB);
    float* CY = (float*)((char*)d_ws + 288 * MiB);
    float2* CS = (float2*)((char*)d_ws + 304 * MiB);

    hipMemcpyAsync(h, x, (size_t)M * D_MODEL * 4, hipMemcpyDeviceToDevice, stream);
    k_rope_table<<<(SEQ * 32 + 255) / 256, 256, 0, stream>>>(CS);
    for (int L = 0; L < DEPTH; ++L) {
        k_rmsnorm<<<M / 4, 256, 0, stream>>>(h, norm_mix_g + L * D_MODEL, XN);
        k_gemm<0><<<dim3(D_IN / 64, M / 64), 256, 0, stream>>>(XN, D_MODEL, w_in + (size_t)L * D_MODEL * D_IN, D_IN, PROJ, D_IN, D_MODEL, nullptr, 0);
        k_prep<<<(M * 28 + 255) / 256, 256, 0, stream>>>(PROJ, qn_g + L * HD, kn_g + L * HD, CS);
        float* MIX = XN;
        k_attn<<<dim3(NC, H_ATT, BATCH), 64, 0, stream>>>(PROJ, rel_bias + L * H_ATT * (2 * REL_CLIP + 1), MIX);
        k_dwconv<<<M, 256, 0, stream>>>(PROJ, conv_w + L * CONV_K * D_CONV, conv_b + L * D_CONV, CY);
        k_conv_ln<<<M / 4, 256, 0, stream>>>(CY, conv_ln_g + L * D_CONV, conv_ln_b + L * D_CONV);
        k_gemm<3><<<dim3(D_CONV / 64, M / 64), 256, 0, stream>>>(CY, D_CONV, conv_pw_w + (size_t)L * D_CONV * D_CONV, D_CONV, MIX + D_ATT, D_MODEL, D_CONV, conv_pw_b + L * D_CONV, 0);
        k_ret_kv<<<dim3(NC, H_RET, BATCH), 256, 0, stream>>>(PROJ, KV);
        k_ret_scan<<<BATCH * H_RET, 256, 0, stream>>>(KV);
        k_ret_out<<<dim3(NC, H_RET, BATCH), 256, 0, stream>>>(PROJ, KV, ret_gn_g + L * D_RET, MIX);
        k_gemm<1><<<dim3(D_MODEL / 64, M / 64), 256, 0, stream>>>(MIX, D_MODEL, w_o + (size_t)L * D_MODEL * D_MODEL, D_MODEL, h, D_MODEL, D_MODEL, nullptr, 0);
        k_rmsnorm<<<M / 4, 256, 0, stream>>>(h, norm_ffn_g + L * D_MODEL, XN);
        for (int tc = 0; tc < 4; ++tc) {
            float* HID = PROJ;
            k_gemm<2><<<dim3(D_FF / 64, 4096 / 64), 256, 0, stream>>>(XN + (size_t)tc * 4096 * D_MODEL, D_MODEL, w1 + (size_t)L * D_MODEL * D_FF, D_FF, HID, D_FF, D_MODEL, nullptr, 0);
            k_gemm<1><<<dim3(D_MODEL / 64, 4096 / 64), 256, 0, stream>>>(HID, D_FF, w2 + (size_t)L * D_FF * D_MODEL, D_MODEL, h + (size_t)tc * 4096 * D_MODEL, D_MODEL, D_FF, nullptr, 0);
        }
        k_rmsnorm<<<M / 4, 256, 0, stream>>>(h, norm_ple_g + L * D_MODEL, XN);
        float* T1 = PROJ;
        k_gemm<0><<<dim3(D_MODEL / 64, M / 64), 256, 0, stream>>>(XN, D_MODEL, w_pg + (size_t)L * D_MODEL * D_MODEL, D_MODEL, T1, D_MODEL, D_MODEL, nullptr, 0);
        k_gemm<5><<<dim3(D_MODEL / 64, M / 64), 256, 0, stream>>>(p + (size_t)L * M * D_PLE, D_PLE, w_ple + (size_t)L * D_PLE * D_MODEL, D_MODEL, h, D_MODEL, D_PLE, T1, D_MODEL);
    }
}
```

```cpp
#include <hip/hip_runtime.h>
#include <cstdio>
#include <cstdint>

#ifndef MK_PER_PHASE
#define MK_PER_PHASE 0
#endif

namespace pg8 {
#define PG8_LAS __attribute__((address_space(3)))
typedef unsigned short bf16_t;
typedef short bf16x8 __attribute__((ext_vector_type(8)));
typedef float f32x4 __attribute__((ext_vector_type(4)));
typedef unsigned u32x4 __attribute__((ext_vector_type(4)));
constexpr int BM = 256, BK = 64, HALF = 128, HTB = HALF * BK * 2, STAGE_BYTES = 8 * HTB, NXCD = 8, WGM = 8;
__host__ __device__ __forceinline__ int lds_byte(int r, int c) { const int st = (r >> 4) * 2 + (c >> 5), rr = r & 15, cc = c & 31, ob = rr * 64 + cc * 2; return st * 1024 + (ob ^ (((ob >> 9) & 1) << 5)); }
__host__ __device__ __forceinline__ void stage_rc(int b, int& R, int& C) { const int st = b / 1024, sb = b % 1024, swz = sb ^ (((sb >> 9) & 1) << 5); R = (st >> 1) * 16 + swz / 64; C = (st & 1) * 32 + (swz % 64) / 2; }
__host__ __device__ __forceinline__ int perm32(int rho) { const int n = rho >> 4, i = rho & 15; return 8 * (i >> 2) + 4 * n + (i & 3); }
struct Unit { int pm, pn; };
struct StaticOrder {
    int nM, nN, nwg, G, c; const char* A; const char* Bt; size_t tstep;
    __device__ void init(int M, int N, int K, int G_, int c_, const void* A_, const void* Bt_) { nM = M / BM; nN = N / BM; nwg = nM * nN; G = G_; c = c_; A = (const char*)A_; Bt = (const char*)Bt_; tstep = (size_t)BM * K * 2; }
    __device__ bool next(int i, Unit& u) const {
        const long L = (long)i * G + c; if (L >= nwg) return false;
        int wgid = (int)L; { const int q = nwg / NXCD, r = nwg % NXCD, xcd = wgid % NXCD, off = wgid / NXCD; wgid = (xcd < r ? xcd * (q + 1) : r * (q + 1) + (xcd - r) * q) + off; }
        const int nig = WGM * nN, gid = wgid / nig, fm = gid * WGM, gsz = (nM - fm) < WGM ? (nM - fm) : WGM;
        u.pm = fm + ((wgid % nig) % gsz); u.pn = (wgid % nig) / gsz; return true;
    }
    __device__ __forceinline__ const char* a_ptr(const Unit& u) const { return A + (size_t)u.pm * tstep; }
    __device__ __forceinline__ const char* b_ptr(const Unit& u) const { return Bt + (size_t)u.pn * tstep; }
    __device__ __forceinline__ void a_ready(const Unit&) const {}
    __device__ __forceinline__ void done(const Unit&) const {}
};
__device__ __forceinline__ unsigned cvt_pk_bf16(float lo, float hi) { unsigned r; asm volatile("v_cvt_pk_bf16_f32 %0, %1, %2" : "=v"(r) : "v"(lo), "v"(hi)); return r; }
__device__ __forceinline__ u32x4 pack8(f32x4 v0, f32x4 v1) { u32x4 w; w.x = cvt_pk_bf16(v0[0], v0[1]); w.y = cvt_pk_bf16(v0[2], v0[3]); w.z = cvt_pk_bf16(v1[0], v1[1]); w.w = cvt_pk_bf16(v1[2], v1[3]); return w; }
__device__ __forceinline__ float bfl(unsigned w) { return __uint_as_float(w << 16); }
__device__ __forceinline__ float bfh(unsigned w) { return __uint_as_float(w & 0xffff0000u); }

__device__ __forceinline__ float row_rstd(const float* SS, int row) {
    const f32x4* p = (const f32x4*)(SS + (size_t)row * 16); const f32x4 a = p[0], b = p[1], c = p[2], d = p[3];
    const float s = ((a[0] + a[1]) + (a[2] + a[3])) + ((b[0] + b[1]) + (b[2] + b[3])) + ((c[0] + c[1]) + (c[2] + c[3])) + ((d[0] + d[1]) + (d[2] + d[3]));
    return rsqrtf(s * (1.0f / 1024.0f) + 1e-6f);
}
template <int ACT, bool SCALE> struct EpiBf16 {
    static constexpr bool PERM = true, AFTER_DRAIN = false;
    bf16_t* O; int ldc; const float* SS;
    __device__ __forceinline__ void operator()(const f32x4 (&acc)[2][2][4][2], const Unit& u, int wr, int wc, int fr, int fq) const {
#pragma unroll
        for (int ai = 0; ai < 2; ++ai)
#pragma unroll
            for (int m = 0; m < 4; ++m) { const int row = u.pm * BM + ai * HALF + wr * 64 + m * 16 + fr; const float r = SCALE ? row_rstd(SS, row) : 1.0f;
#pragma unroll
                for (int bj = 0; bj < 2; ++bj) { const int col = u.pn * BM + bj * HALF + wc * 32 + 8 * fq; f32x4 v0 = acc[ai][bj][m][0] * r, v1 = acc[ai][bj][m][1] * r;
                    if (ACT == 1) {
#pragma unroll
                        for (int j = 0; j < 4; ++j) { const float a = fmaxf(v0[j], 0.f), b = fmaxf(v1[j], 0.f); v0[j] = a * a; v1[j] = b * b; } }
                    *(u32x4*)(O + (size_t)row * ldc + col) = pack8(v0, v1); } }
    }
};
struct EpiBias {
    static constexpr bool PERM = true, AFTER_DRAIN = false;
    bf16_t* O; int ldc; const float* bias;
    __device__ __forceinline__ void operator()(const f32x4 (&acc)[2][2][4][2], const Unit& u, int wr, int wc, int fr, int fq) const {
#pragma unroll
        for (int ai = 0; ai < 2; ++ai)
#pragma unroll
            for (int m = 0; m < 4; ++m) { const int row = u.pm * BM + ai * HALF + wr * 64 + m * 16 + fr;
#pragma unroll
                for (int bj = 0; bj < 2; ++bj) { const int col = u.pn * BM + bj * HALF + wc * 32 + 8 * fq; const f32x4 b0 = *(const f32x4*)(bias + col), b1 = *(const f32x4*)(bias + col + 4);
                    *(u32x4*)(O + (size_t)row * ldc + col) = pack8(acc[ai][bj][m][0] + b0, acc[ai][bj][m][1] + b1); } }
    }
};
template <bool GATE> struct EpiRes {
    static constexpr bool PERM = true, AFTER_DRAIN = false;
    float* H; bf16_t* HB; float* SSout; const float* SSin; const bf16_t* PLE;
    __device__ __forceinline__ void operator()(const f32x4 (&acc)[2][2][4][2], const Unit& u, int wr, int wc, int fr, int fq) const {
#pragma unroll
        for (int ai = 0; ai < 2; ++ai)
#pragma unroll
            for (int m = 0; m < 4; ++m) { const int row = u.pm * BM + ai * HALF + wr * 64 + m * 16 + fr; float ssq = 0.f; const float r = GATE ? row_rstd(SSin, row) : 1.0f;
#pragma unroll
                for (int bj = 0; bj < 2; ++bj) { const int col = u.pn * BM + bj * HALF + wc * 32 + 8 * fq; float* hp = H + (size_t)row * 1024 + col;
                    f32x4 v0 = acc[ai][bj][m][0], v1 = acc[ai][bj][m][1];
                    if (GATE) { const u32x4 pw = *(const u32x4*)(PLE + (size_t)row * 1024 + col);
                        const f32x4 p0 = {bfl(pw.x), bfh(pw.x), bfl(pw.y), bfh(pw.y)}, p1 = {bfl(pw.z), bfh(pw.z), bfl(pw.w), bfh(pw.w)};
#pragma unroll
                        for (int j = 0; j < 4; ++j) { v0[j] = p0[j] / (1.0f + __expf(-v0[j] * r)); v1[j] = p1[j] / (1.0f + __expf(-v1[j] * r)); } }
                    v0 = v0 + *(const f32x4*)hp; v1 = v1 + *(const f32x4*)(hp + 4);
                    *(f32x4*)hp = v0; *(f32x4*)(hp + 4) = v1;
                    *(u32x4*)(HB + (size_t)row * 1024 + col) = pack8(v0, v1);
                    ssq += (v0[0] * v0[0] + v0[1] * v0[1]) + (v0[2] * v0[2] + v0[3] * v0[3]) + (v1[0] * v1[0] + v1[1] * v1[1]) + (v1[2] * v1[2] + v1[3] * v1[3]); }
                ssq += __shfl_xor(ssq, 16); ssq += __shfl_xor(ssq, 32);
                if (fq == 0) SSout[(size_t)row * 16 + u.pn * 4 + wc] = ssq; }
    }
};

template <class Epi, class Sched, bool ALIGN_EPI = false, bool SP2 = false>
__device__ __forceinline__ void gemm_phase(PG8_LAS unsigned char* lds, const int K, const Sched& S, const Epi& E, const int tid) {
    const int wid = __builtin_amdgcn_readfirstlane(tid >> 6), lane = tid & 63, wr = wid >> 2, wc = wid & 3, fr = lane & 15, fq = lane >> 4;
    const int nt = K / BK;
    unsigned voffA[2], voffB[2];
#pragma unroll
    for (int i = 0; i < 2; ++i) { int R, C; stage_rc(tid * 16 + i * 8192, R, C); const int Rb = Epi::PERM ? ((R & ~31) + perm32(R & 31)) : R;
        voffA[i] = (unsigned)(R * K + C) * 2u; voffB[i] = (unsigned)(Rb * K + C) * 2u; }
    const size_t kstep = (size_t)(BK * 2);
    const size_t hstep = (size_t)HALF * K * 2;
    const unsigned ldsw = (unsigned)wid * 1024u;
    const int aoff = lds_byte(wr * 64 + fr, fq * 8), boff = lds_byte(wc * 32 + fr, fq * 8);
#define PG8_SA(b, h) (((b) * 2 + (h)) * HTB)
#define PG8_SB(b, h) ((4 + (b) * 2 + (h)) * HTB)
#define PG8_STAGE(bufoff, gbase, voff) do { _Pragma("unroll") for (int _i = 0; _i < 2; ++_i) \
        __builtin_amdgcn_global_load_lds((const unsigned*)((const char*)(gbase) + (voff)[_i]), (PG8_LAS unsigned*)(lds + (bufoff) + ldsw + _i * 8192), 16, 0, 0); } while (0)
#define PG8_LDA(dst, b, h) do { _Pragma("unroll") for (int m = 0; m < 4; ++m) _Pragma("unroll") for (int k = 0; k < 2; ++k) dst[m][k] = *(const PG8_LAS bf16x8*)(lds + PG8_SA(b, h) + aoff + m * 2048 + k * 1024); } while (0)
#define PG8_LDB(dst, b, h) do { _Pragma("unroll") for (int n = 0; n < 2; ++n) _Pragma("unroll") for (int k = 0; k < 2; ++k) dst[n][k] = *(const PG8_LAS bf16x8*)(lds + PG8_SB(b, h) + boff + n * 2048 + k * 1024); } while (0)
#define PG8_MMA(ai, bj, At, Bt) do { __builtin_amdgcn_s_setprio(1); _Pragma("unroll") for (int m = 0; m < 4; ++m) _Pragma("unroll") for (int n = 0; n < 2; ++n) _Pragma("unroll") for (int k = 0; k < 2; ++k) \
        acc[ai][bj][m][n] = __builtin_amdgcn_mfma_f32_16x16x32_bf16(Bt[n][k], At[m][k], acc[ai][bj][m][n], 0, 0, 0); __builtin_amdgcn_s_setprio(0); } while (0)
#define PG8_WAIT_V(n) asm volatile("s_waitcnt vmcnt(" #n ")" ::: "memory")
#define PG8_WAIT_L(n) asm volatile("s_waitcnt lgkmcnt(" #n ")" ::: "memory")
#define PG8_BAR __builtin_amdgcn_s_barrier()
#define PG8_SCHED __builtin_amdgcn_sched_barrier(0)
    Unit cur, nxt; int ui = 0;
    if (!S.next(0, cur)) return;
    f32x4 acc[2][2][4][2];
#pragma unroll
    for (int a = 0; a < 2; ++a)
#pragma unroll
        for (int b = 0; b < 2; ++b)
#pragma unroll
            for (int m = 0; m < 4; ++m)
#pragma unroll
                for (int n = 0; n < 2; ++n) acc[a][b][m][n] = (f32x4){0.f, 0.f, 0.f, 0.f};
    bf16x8 At[4][2], B0[2][2], B1[2][2];
    const char* cA = S.a_ptr(cur); const char* cB = S.b_ptr(cur);
    S.a_ready(cur);
    if constexpr (SP2) {
        PG8_STAGE(PG8_SB(0, 0), cB, voffB); PG8_STAGE(PG8_SB(0, 1), cB + hstep, voffB); PG8_STAGE(PG8_SA(0, 0), cA, voffA); PG8_STAGE(PG8_SA(0, 1), cA + hstep, voffA);
        if (wr == 1) PG8_BAR;
        PG8_WAIT_V(2); PG8_BAR;
        PG8_STAGE(PG8_SB(1, 0), cB + kstep, voffB); PG8_STAGE(PG8_SA(1, 0), cA + kstep, voffA); PG8_STAGE(PG8_SB(1, 1), cB + hstep + kstep, voffB);
        PG8_WAIT_V(6); PG8_BAR;
    } else {
        PG8_STAGE(PG8_SB(0, 0), cB, voffB); PG8_STAGE(PG8_SA(0, 0), cA, voffA); PG8_STAGE(PG8_SB(0, 1), cB + hstep, voffB); PG8_STAGE(PG8_SA(0, 1), cA + hstep, voffA);
        if (wr == 1) PG8_BAR;
        PG8_WAIT_V(4); PG8_BAR;
        PG8_STAGE(PG8_SB(1, 0), cB + kstep, voffB); PG8_STAGE(PG8_SA(1, 0), cA + kstep, voffA); PG8_STAGE(PG8_SB(1, 1), cB + hstep + kstep, voffB);
        PG8_WAIT_V(6); PG8_BAR;
    }
    for (;;) {
        const bool has_next = S.next(ui + 1, nxt);
        const char* nA = has_next ? S.a_ptr(nxt) : cA; const char* nB = has_next ? S.b_ptr(nxt) : cB;
        for (int t = 0; t < nt; t += 2) {
            const bool last = (t == nt - 2);
            const char* a1 = cA + (size_t)(t + 1) * kstep;
            const char* a2 = last ? nA : cA + (size_t)(t + 2) * kstep; const char* b2 = last ? nB : cB + (size_t)(t + 2) * kstep;
            const char* a3 = a2 + kstep; const char* b3 = b2 + kstep;
            if (last && has_next) S.a_ready(nxt);
            if constexpr (SP2) {
            PG8_LDB(B0, 0, 0); PG8_LDB(B1, 0, 1); PG8_SCHED; PG8_LDA(At, 0, 0); PG8_STAGE(PG8_SA(1, 1), a1 + hstep, voffA);
            PG8_WAIT_V(8); PG8_WAIT_L(0); PG8_BAR; PG8_MMA(0, 0, At, B0); PG8_MMA(0, 1, At, B1); PG8_BAR; PG8_SCHED;
            PG8_LDA(At, 0, 1); PG8_STAGE(PG8_SB(0, 0), b2, voffB); PG8_STAGE(PG8_SB(0, 1), b2 + hstep, voffB); PG8_STAGE(PG8_SA(0, 0), a2, voffA);
            PG8_WAIT_V(8); PG8_WAIT_L(0); PG8_BAR; PG8_MMA(1, 0, At, B0); PG8_MMA(1, 1, At, B1); PG8_BAR; PG8_SCHED;
            PG8_LDB(B0, 1, 0); PG8_LDB(B1, 1, 1); PG8_SCHED; PG8_LDA(At, 1, 0); PG8_STAGE(PG8_SA(0, 1), a2 + hstep, voffA);
            PG8_WAIT_V(8); PG8_WAIT_L(0); PG8_BAR; PG8_MMA(0, 0, At, B0); PG8_MMA(0, 1, At, B1); PG8_BAR; PG8_SCHED;
            PG8_LDA(At, 1, 1); PG8_STAGE(PG8_SB(1, 0), b3, voffB); PG8_STAGE(PG8_SB(1, 1), b3 + hstep, voffB); PG8_STAGE(PG8_SA(1, 0), a3, voffA);
            PG8_WAIT_V(8); PG8_WAIT_L(0); PG8_BAR; PG8_MMA(1, 0, At, B0); PG8_MMA(1, 1, At, B1); PG8_BAR; PG8_SCHED;
            } else {
            PG8_LDB(B0, 0, 0); PG8_SCHED; PG8_LDA(At, 0, 0); PG8_STAGE(PG8_SA(1, 1), a1 + hstep, voffA);
            PG8_WAIT_L(8); PG8_BAR; PG8_WAIT_L(0); PG8_MMA(0, 0, At, B0); PG8_BAR; PG8_SCHED;
            PG8_LDB(B1, 0, 1); PG8_STAGE(PG8_SB(0, 0), b2, voffB);
            PG8_BAR; PG8_WAIT_L(0); PG8_MMA(0, 1, At, B1); PG8_BAR;
            PG8_LDA(At, 0, 1); PG8_STAGE(PG8_SA(0, 0), a2, voffA);
            PG8_BAR; PG8_WAIT_L(0); PG8_MMA(1, 0, At, B0); PG8_BAR; PG8_SCHED;
            PG8_STAGE(PG8_SB(0, 1), b2 + hstep, voffB);
            PG8_WAIT_V(6); PG8_BAR; PG8_MMA(1, 1, At, B1); PG8_BAR;
            PG8_LDB(B0, 1, 0); PG8_SCHED; PG8_LDA(At, 1, 0); PG8_STAGE(PG8_SA(0, 1), a2 + hstep, voffA);
            PG8_WAIT_L(8); PG8_BAR; PG8_WAIT_L(0); PG8_MMA(0, 0, At, B0); PG8_BAR; PG8_SCHED;
            PG8_LDB(B1, 1, 1); PG8_STAGE(PG8_SB(1, 0), b3, voffB);
            PG8_BAR; PG8_WAIT_L(0); PG8_MMA(0, 1, At, B1); PG8_BAR;
            PG8_LDA(At, 1, 1); PG8_STAGE(PG8_SA(1, 0), a3, voffA);
            PG8_BAR; PG8_WAIT_L(0); PG8_MMA(1, 0, At, B0); PG8_BAR; PG8_SCHED;
            PG8_STAGE(PG8_SB(1, 1), b3 + hstep, voffB);
            PG8_WAIT_V(6); PG8_BAR; PG8_MMA(1, 1, At, B1); PG8_BAR;
            }
        }
        if constexpr (ALIGN_EPI) { if (wr == 0) PG8_BAR; }
        if constexpr (!Epi::AFTER_DRAIN) { E(acc, cur, wr, wc, fr, fq); S.done(cur); }
        if (!has_next) break;
#pragma unroll
        for (int a = 0; a < 2; ++a)
#pragma unroll
            for (int b = 0; b < 2; ++b)
#pragma unroll
                for (int m = 0; m < 4; ++m)
#pragma unroll
                    for (int n = 0; n < 2; ++n) acc[a][b][m][n] = (f32x4){0.f, 0.f, 0.f, 0.f};
        cur = nxt; cA = nA; cB = nB; ++ui;
        if constexpr (ALIGN_EPI) { if (wr == 1) PG8_BAR; }
    }
    PG8_WAIT_V(0);
    if constexpr (!ALIGN_EPI) { if (wr == 0) PG8_BAR; }
    PG8_BAR;
    if constexpr (Epi::AFTER_DRAIN) { E.fused(acc, cur, wr, wc, fr, fq, lds, wid, lane); S.done(cur); }
#undef PG8_SA
#undef PG8_SB
#undef PG8_STAGE
#undef PG8_LDA
#undef PG8_LDB
#undef PG8_MMA
#undef PG8_WAIT_V
#undef PG8_WAIT_L
#undef PG8_BAR
#undef PG8_SCHED
}
}

constexpr int D_MODEL = 1024, BATCH = 8, SEQ = 2048, DEPTH = 4, CHUNK = 64, NLEFT = 8, HD = 64;
constexpr int D_ATT = 384, D_RET = 384, D_CONV = 256, H_ATT = 6, H_RET = 6, CONV_K = 31, REL_CLIP = 128;
constexpr int D_FF = 4096, D_PLE = 256, D_IN = 3200, M = BATCH * SEQ, NC = SEQ / CHUNK;
constexpr int PROJ_LD = 3328;
constexpr float EPS = 1e-6f;
constexpr int C_QA = 0, C_KA = 384, C_VA = 768, C_UC = 1152, C_QR = 1664, C_KR = 2048, C_VR = 2432, C_GR = 2816;
constexpr int NWAVES = 8;

constexpr size_t MiB = 1u << 20;
constexpr size_t WS_CTL = 0, CTL_ZERO_BYTES = 1 * MiB;
constexpr size_t WS_SS = 1 * MiB;
constexpr size_t WS_WBUF = 4 * MiB, WBUF_BYTES = 28 * MiB;
constexpr size_t WS_HB = 60 * MiB, HB_BYTES = 32 * MiB;
constexpr size_t WS_PLE = 124 * MiB;
constexpr size_t WS_KV = 124 * MiB;
constexpr size_t WS_PROJ = 156 * MiB;
constexpr size_t WS_MIX = 260 * MiB;
constexpr size_t WS_HID = 156 * MiB;
constexpr size_t WS_CY = 292 * MiB;
constexpr size_t WS_CYB = 308 * MiB;
constexpr size_t WS_PB = 316 * MiB;
constexpr size_t WS_CS = 324 * MiB;
constexpr size_t WS_END = 325 * MiB;
constexpr size_t WO_WIN = 0, WO_WO = WO_WIN + (size_t)PROJ_LD * 1024, WO_W1 = WO_WO + 1024 * 1024, WO_W2 = WO_W1 + 4096 * 1024, WO_WPG = WO_W2 + 4096 * 1024,
                 WO_WPLE = WO_WPG + 1024 * 1024, WO_PW = WO_WPLE + 1024 * 256, WO_END = WO_PW + 256 * 256;
static_assert(WO_END * 2 <= WBUF_BYTES, "weight buffer");
constexpr int CW_BAR = 4096;

constexpr int RING_OFF = 0, RING_BYTES = 131072;
constexpr int LDSCTL_OFF = RING_BYTES, MISC_OFF = LDSCTL_OFF + 320;
constexpr int LDS_BYTES = 147456, PTR_OFF = LDSCTL_OFF + 1024;

#define GAS __attribute__((address_space(1)))
#define LAS __attribute__((address_space(3)))
typedef unsigned short bf16;
typedef unsigned v4u __attribute__((ext_vector_type(4)));
typedef float f32x4 __attribute__((ext_vector_type(4)));
typedef GAS unsigned gu32;
#define LDS_WAIT() asm volatile("s_waitcnt lgkmcnt(0)" ::: "memory")
__device__ __forceinline__ unsigned f2bf(float f) { unsigned u = __builtin_bit_cast(unsigned, f); return (u + 0x7fffu + ((u >> 16) & 1u)) >> 16; }
__device__ __forceinline__ unsigned pk2(float lo, float hi) { return f2bf(lo) | (f2bf(hi) << 16); }
__device__ __forceinline__ float bf2f(bf16 v) { return __uint_as_float((unsigned)v << 16); }

#define XB_TMO      128
#define XB_XCNT(j)  (256  + 64 * (j))
#define XB_XSUB(j)  (1280 + 64 * (j))
#define XB_XGEN(j)  (2304 + 64 * (j))
#define XB_TOP      3328
#define XB_TOPGEN   3392
#define XCD_BAR_WORDS 3456
#define XB_SPIN_CAP (1u << 18)

__device__ __forceinline__ unsigned xb_ld(unsigned* p)              { return __hip_atomic_load(p, __ATOMIC_RELAXED, __HIP_MEMORY_SCOPE_AGENT); }
__device__ __forceinline__ unsigned xb_add(unsigned* p, unsigned v) { return __hip_atomic_fetch_add(p, v, __ATOMIC_RELAXED, __HIP_MEMORY_SCOPE_AGENT); }
__device__ __forceinline__ unsigned xb_xcc_id() { return (unsigned)__builtin_amdgcn_s_getreg((3 << 11) | 20) & 0xFu; }
#define XB_SPIN(cond, bar) do { unsigned _sp = 0; while (cond) { __builtin_amdgcn_s_sleep(1); \
    if ((++_sp & 255u) == 0u) { if (xb_ld(&(bar)[XB_TMO])) break; if (_sp > XB_SPIN_CAP) { atomicAdd(&(bar)[XB_TMO], 1u); break; } } } } while (0)

struct XcdBarrier {
    unsigned* bar; unsigned x;
    volatile LAS unsigned* st;
};

__device__ __forceinline__ XcdBarrier xcd_barrier_post(unsigned* bar, volatile LAS unsigned* st) {
    XcdBarrier b; b.bar = bar; b.x = xb_xcc_id(); b.st = st;
    if (threadIdx.x == 0) (void)xb_add(&bar[XB_XCNT(b.x)], 1u);
    return b;
}
__device__ __forceinline__ void xcd_barrier_complete(unsigned* bar, unsigned x, unsigned& nloc, unsigned& nx) {
    const unsigned G = gridDim.x * gridDim.y * gridDim.z;
    unsigned sum, cnt, mine, sp = 0u;
    for (;;) {
        sum = 0u; cnt = 0u; mine = 0u;
#pragma unroll
        for (unsigned j = 0; j < 16; ++j) { const unsigned c = xb_ld(&bar[XB_XCNT(j)]); sum += c; cnt += (c > 0u) ? 1u : 0u; mine = (j == x) ? c : mine; }
        if (sum == G) break;
        __builtin_amdgcn_s_sleep(1);
        if ((++sp & 255u) == 0u) { if (xb_ld(&bar[XB_TMO])) break; if (sp > XB_SPIN_CAP) { atomicAdd(&bar[XB_TMO], 1u); break; } }
    }
    nloc = mine > 0u ? mine : 1u; nx = cnt > 0u ? cnt : 1u;
}

__device__ __forceinline__ void xcd_barrier(const XcdBarrier& b) {
    asm volatile("s_waitcnt vmcnt(0)" ::: "memory");
    __syncthreads();
    if (threadIdx.x == 0) {
        unsigned* bar = b.bar;
        __builtin_amdgcn_s_waitcnt(0);
        unsigned nloc = b.st[0], nx = b.st[1];
        if (nloc == 0u) { xcd_barrier_complete(bar, b.x, nloc, nx); b.st[0] = nloc; b.st[1] = nx; }
        const unsigned old = xb_add(&bar[XB_XSUB(b.x)], 1u);
        const unsigned gen = old / nloc;
        if (old + 1u == (gen + 1u) * nloc) {
            __builtin_amdgcn_fence(__ATOMIC_RELEASE, "agent");
            asm volatile("s_waitcnt vmcnt(0)" ::: "memory");
            const unsigned og = xb_add(&bar[XB_TOP], 1u);
            const unsigned tg = og / nx;
            if (og + 1u == (tg + 1u) * nx) xb_add(&bar[XB_TOPGEN], 1u);
            else XB_SPIN(xb_ld(&bar[XB_TOPGEN]) == tg, bar);
            __builtin_amdgcn_fence(__ATOMIC_ACQUIRE, "agent");
            xb_add(&bar[XB_XGEN(b.x)], 1u);
            asm volatile("s_waitcnt vmcnt(0)" ::: "memory");
        } else {
            XB_SPIN(xb_ld(&bar[XB_XGEN(b.x)]) == gen, bar);
            __builtin_amdgcn_fence(__ATOMIC_ACQUIRE, "agent");
            asm volatile("s_waitcnt vmcnt(0)" ::: "memory");
        }
    }
    __syncthreads();
}

__device__ __forceinline__ unsigned long long rfl64(unsigned long long v) { const unsigned lo = __builtin_amdgcn_readfirstlane((unsigned)v), hi = __builtin_amdgcn_readfirstlane((unsigned)(v >> 32)); return ((unsigned long long)hi << 32) | lo; }
struct Args { const float* in[21]; float* out; unsigned char* ws; int ph_lo, ph_hi; };
struct Frame {
    LAS unsigned char* lds; int tid, lane, wave, G, bid, gw, ngw;
    float* H; unsigned char* ws;
    __device__ __forceinline__ const float* in(int k) const { return (const float*)(uintptr_t)rfl64(((LAS unsigned long long*)(lds + PTR_OFF))[k]); }
};
__device__ __forceinline__ float wave_sum(float v) {
#pragma unroll
    for (int o = 1; o < 64; o <<= 1) v += __shfl_xor(v, o);
    return v;
}
__device__ __forceinline__ float sigmoidf_(float x) { return 1.0f / (1.0f + expf(-x)); }

__device__ __forceinline__ void transpose_item(const float* W, int K, int N, const float* gain, bf16* WT, LAS float* scr, int item, int lane) {
    const int nblk = N / 32, kb = item / nblk, nb = item % nblk, k0 = 64 * kb, n0 = 32 * nb;
#pragma unroll 8
    for (int i = 0; i < 32; ++i) { const int kk = 2 * i + (lane >> 5); float v = W[(size_t)(k0 + kk) * N + n0 + (lane & 31)]; if (gain) v *= gain[k0 + kk]; scr[kk * 33 + (lane & 31)] = v; }
    LDS_WAIT(); asm volatile("" ::: "memory");
    const int c = lane & 7;
#pragma unroll
    for (int j = 0; j < 4; ++j) { const int n = (lane >> 3) + 8 * j; const LAS float* s = scr + (8 * c) * 33 + n;
        v4u o; o.x = pk2(s[0 * 33], s[1 * 33]); o.y = pk2(s[2 * 33], s[3 * 33]); o.z = pk2(s[4 * 33], s[5 * 33]); o.w = pk2(s[6 * 33], s[7 * 33]);
        *(GAS v4u*)(WT + (size_t)(n0 + n) * K + k0 + 8 * c) = o; }
    LDS_WAIT(); asm volatile("" ::: "memory");
}
__device__ __forceinline__ void convert_layer(Frame& F, int L) {
    bf16* WB = (bf16*)(F.ws + WS_WBUF + (size_t)(L & 1) * WBUF_BYTES);
    LAS float* scr = (LAS float*)(F.lds + RING_OFF + F.wave * 16384);
    const float* w_in = F.in(3) + (size_t)L * 1024 * D_IN; const float* w_o = F.in(14) + (size_t)L * 1024 * 1024; const float* w1 = F.in(16) + (size_t)L * 1024 * 4096;
    const float* w2 = F.in(17) + (size_t)L * 4096 * 1024; const float* w_pg = F.in(19) + (size_t)L * 1024 * 1024; const float* w_ple = F.in(20) + (size_t)L * 256 * 1024;
    const float* pw = F.in(11) + (size_t)L * 256 * 256;
    const float* g_mix = F.in(2) + L * 1024; const float* g_ffn = F.in(15) + L * 1024; const float* g_ple = F.in(18) + L * 1024;
    constexpr int I_IN = 16 * (D_IN / 32), I_O = 16 * 32, I_1 = 16 * 128, I_2 = 64 * 32, I_PG = 16 * 32, I_PLE = 4 * 32, I_PW = 4 * 8;
    constexpr int NIT = I_IN + I_O + I_1 + I_2 + I_PG + I_PLE + I_PW;
    for (int it = F.gw; it < NIT; it += F.ngw) {
        int r = it;
        if (r < I_IN) { transpose_item(w_in, 1024, D_IN, g_mix, WB + WO_WIN, scr, r, F.lane); continue; } r -= I_IN;
        if (r < I_O) { transpose_item(w_o, 1024, 1024, nullptr, WB + WO_WO, scr, r, F.lane); continue; } r -= I_O;
        if (r < I_1) { transpose_item(w1, 1024, 4096, g_ffn, WB + WO_W1, scr, r, F.lane); continue; } r -= I_1;
        if (r < I_2) { transpose_item(w2, 4096, 1024, nullptr, WB + WO_W2, scr, r, F.lane); continue; } r -= I_2;
        if (r < I_PG) { transpose_item(w_pg, 1024, 1024, g_ple, WB + WO_WPG, scr, r, F.lane); continue; } r -= I_PG;
        if (r < I_PLE) { transpose_item(w_ple, 256, 1024, nullptr, WB + WO_WPLE, scr, r, F.lane); continue; } r -= I_PLE;
        transpose_item(pw, 256, 256, nullptr, WB + WO_PW, scr, r, F.lane);
    }
    { GAS v4u* z = (GAS v4u*)(WB + WO_WIN + (size_t)D_IN * 1024); const int n16 = (PROJ_LD - D_IN) * 1024 * 2 / 16;
      for (int i = F.bid * 512 + F.tid; i < n16; i += F.G * 512) z[i] = (v4u){0u, 0u, 0u, 0u}; }
}
__device__ __forceinline__ void sincos_acc(float ang, float& s, float& c) {
    const double x = (double)ang; const double kd = rint(x * 0.63661977236758134);
    const double r = (x - kd * 1.5707963267948966) - kd * 6.123233995736766e-17; const int q = ((int)kd) & 3; const double r2 = r * r;
    const double sp = r * (1.0 + r2 * (-1.0 / 6 + r2 * (1.0 / 120 + r2 * (-1.0 / 5040 + r2 * (1.0 / 362880 + r2 * (-1.0 / 39916800))))));
    const double cp = 1.0 + r2 * (-0.5 + r2 * (1.0 / 24 + r2 * (-1.0 / 720 + r2 * (1.0 / 40320 + r2 * (-1.0 / 3628800 + r2 * (1.0 / 479001600))))));
    double ss, cc;
    if (q == 0) { ss = sp; cc = cp; } else if (q == 1) { ss = cp; cc = -sp; } else if (q == 2) { ss = -sp; cc = -cp; } else { ss = -cp; cc = sp; }
    s = (float)ss; c = (float)cc;
}
__device__ __forceinline__ void prologue(Frame& F) {
    convert_layer(F, 0);
    const float* x = F.in(0); bf16* HB = (bf16*)(F.ws + WS_HB); float* SS = (float*)(F.ws + WS_SS);
    for (int m = F.gw; m < M; m += F.ngw) {
        const GAS f32x4* xr = (const GAS f32x4*)(x + (size_t)m * 1024) + F.lane; GAS f32x4* hr = (GAS f32x4*)(F.H + (size_t)m * 1024) + F.lane;
        GAS unsigned long long* o8 = (GAS unsigned long long*)(HB + (size_t)m * 1024) + F.lane; float s = 0.f;
#pragma unroll
        for (int j = 0; j < 4; ++j) { const f32x4 v = xr[64 * j]; hr[64 * j] = v; s += (v.x * v.x + v.y * v.y) + (v.z * v.z + v.w * v.w);
            o8[64 * j] = (unsigned long long)pk2(v.x, v.y) | ((unsigned long long)pk2(v.z, v.w) << 32); }
        s = wave_sum(s);
        if (F.lane < 16) SS[(size_t)m * 16 + F.lane] = F.lane == 0 ? s : 0.f;
    }
    { float2* cs = (float2*)(F.ws + WS_CS);
      for (int idx = F.bid * 512 + F.tid; idx < SEQ * 32; idx += F.G * 512) { const int pos = idx >> 5, i = idx & 31; const float inv_freq = powf(10000.0f, -(float)(2 * i) / 64.0f);
          float s, c; sincos_acc((float)pos * inv_freq, s, c); cs[idx] = make_float2(c, s); } }
}

__device__ __forceinline__ void convert_p(Frame& F, int L) {
    const GAS f32x4* p4 = (const GAS f32x4*)(F.in(1) + (size_t)L * M * D_PLE); GAS unsigned long long* o8 = (GAS unsigned long long*)(F.ws + WS_PB); const int n4 = M * D_PLE / 4;
    for (int i = F.bid * 512 + F.tid; i < n4; i += F.G * 512) { const f32x4 v = p4[i]; o8[i] = (unsigned long long)pk2(v.x, v.y) | ((unsigned long long)pk2(v.z, v.w) << 32); }
}
__device__ __forceinline__ float log_gamma(int h) { return logf(1.0f - exp2f(-5.0f - (float)h)); }
__device__ __forceinline__ void mix_prep(Frame& F, int L) {
    bf16* proj = (bf16*)(F.ws + WS_PROJ); const float* qn_g = F.in(4) + L * 64; const float* kn_g = F.in(5) + L * 64; const float2* cs = (const float2*)(F.ws + WS_CS);
    for (int idx = F.bid * 512 + F.tid; idx < M * 28; idx += F.G * 512) {
        const int m = idx / 28, w = idx % 28; bf16* row = proj + (size_t)m * PROJ_LD;
        if (w < 12) { bf16* p = row + w * 64; const float* g = w < 6 ? qn_g : kn_g; const float sc = w < 6 ? 0.125f : 1.0f; float s = 0.f;
            for (int d = 0; d < 64; ++d) { const float v = bf2f(p[d]); s += v * v; }
            const float r = rsqrtf(s * (1.f / 64.f) + EPS);
            for (int d = 0; d < 64; ++d) p[d] = (bf16)f2bf(bf2f(p[d]) * r * g[d] * sc);
        } else if (w < 24) { const int hh = w - 12; bf16* p = row + C_QR + hh * 64; const float sc = hh < 6 ? 0.125f : 1.0f; const int pos = m % SEQ;
            for (int i = 0; i < 32; ++i) { const float2 c = cs[pos * 32 + i]; const float t1 = bf2f(p[i]), t2 = bf2f(p[i + 32]);
                p[i] = (bf16)f2bf((t1 * c.x - t2 * c.y) * sc); p[i + 32] = (bf16)f2bf((t1 * c.y + t2 * c.x) * sc); }
        } else { const int qd = w - 24; bf16* p = row + C_UC + qd * 64;
            for (int c = 0; c < 64; ++c) { const float a = bf2f(p[c]), g = bf2f(p[c + 256]); p[c] = (bf16)f2bf(a * sigmoidf_(g)); } }
    }
}
__device__ __forceinline__ void mix_attn(Frame& F, int L) {
    const bf16* proj = (const bf16*)(F.ws + WS_PROJ); bf16* mix = (bf16*)(F.ws + WS_MIX); const float* rel_bias = F.in(6) + L * H_ATT * 257;
    for (int u = F.gw; u < BATCH * H_ATT * NC; u += F.ngw) {
        const int n = u % NC, h = (u / NC) % H_ATT, b = u / (NC * H_ATT), i = F.lane;
        const size_t rowq = (size_t)b * SEQ + n * CHUNK + i;
        float q[64], o[64]; const bf16* qp = proj + rowq * PROJ_LD + C_QA + h * 64;
#pragma unroll
        for (int d = 0; d < 64; ++d) { q[d] = bf2f(qp[d]); o[d] = 0.f; }
        float mx = -1e30f, l = 0.f; const float* rb = rel_bias + h * 257; const int c0 = n - NLEFT < 0 ? 0 : n - NLEFT;
        for (int c = c0; c <= n; ++c)
            for (int jj = 0; jj < CHUNK; ++jj) {
                const size_t rowk = (size_t)b * SEQ + c * CHUNK + jj; const bf16* kp = proj + rowk * PROJ_LD + C_KA + h * 64; const bf16* vp = proj + rowk * PROJ_LD + C_VA + h * 64;
                float s = 0.f;
#pragma unroll
                for (int d = 0; d < 64; ++d) s = fmaf(q[d], bf2f(kp[d]), s);
                int rel = (n - c) * CHUNK + i - jj; rel = rel < -REL_CLIP ? -REL_CLIP : (rel > REL_CLIP ? REL_CLIP : rel);
                s += rb[rel + REL_CLIP];
                const float mn = fmaxf(mx, s), alpha = expf(mx - mn), p = expf(s - mn); l = l * alpha + p; mx = mn;
#pragma unroll
                for (int d = 0; d < 64; ++d) o[d] = fmaf(p, bf2f(vp[d]), o[d] * alpha);
            }
        const float inv = 1.f / l; bf16* op = mix + rowq * 1024 + h * 64;
#pragma unroll
        for (int d = 0; d < 64; ++d) op[d] = (bf16)f2bf(o[d] * inv);
    }
}
__device__ __forceinline__ void mix_dwconv(Frame& F, int L) {
    const bf16* proj = (const bf16*)(F.ws + WS_PROJ); float* y = (float*)(F.ws + WS_CY); const float* cw = F.in(7) + L * CONV_K * 256; const float* cb = F.in(8) + L * 256;
    for (int idx = F.bid * 512 + F.tid; idx < M * 256; idx += F.G * 512) { const int m = idx >> 8, c = idx & 255, s = m % SEQ; float acc = cb[c];
        for (int j = 0; j < CONV_K; ++j) { const int sp = s - (CONV_K - 1) + j; if (sp >= 0) acc = fmaf(bf2f(proj[(size_t)(m - (CONV_K - 1) + j) * PROJ_LD + C_UC + c]), cw[j * 256 + c], acc); }
        y[idx] = acc; }
}
__device__ __forceinline__ void mix_conv_ln(Frame& F, int L) {
    const float* y = (const float*)(F.ws + WS_CY); bf16* yb = (bf16*)(F.ws + WS_CYB); const float* g = F.in(9) + L * 256; const float* bt = F.in(10) + L * 256;
    for (int row = F.gw; row < M; row += F.ngw) {
        f32x4 v = ((const f32x4*)(y + (size_t)row * 256))[F.lane];
        const float mu = wave_sum((v.x + v.y) + (v.z + v.w)) * (1.f / 256.f); v = v - mu;
        const float r = rsqrtf(wave_sum((v.x * v.x + v.y * v.y) + (v.z * v.z + v.w * v.w)) * (1.f / 256.f) + EPS);
        const f32x4 gg = ((const f32x4*)g)[F.lane], bb = ((const f32x4*)bt)[F.lane]; f32x4 o = v * r * gg + bb;
        o.x *= sigmoidf_(o.x); o.y *= sigmoidf_(o.y); o.z *= sigmoidf_(o.z); o.w *= sigmoidf_(o.w);
        ((unsigned long long*)(yb + (size_t)row * 256))[F.lane] = (unsigned long long)pk2(o.x, o.y) | ((unsigned long long)pk2(o.z, o.w) << 32);
    }
}
__device__ __forceinline__ void mix_ret_kv(Frame& F) {
    const bf16* proj = (const bf16*)(F.ws + WS_PROJ); float* kv = (float*)(F.ws + WS_KV);
    LAS float* ks = (LAS float*)(F.lds + RING_OFF); LAS float* vs = ks + 64 * 65;
    for (int u = F.bid; u < BATCH * H_RET * NC; u += F.G) {
        const int n = u % NC, h = (u / NC) % H_RET, b = u / (NC * H_RET); const float lg = log_gamma(h);
        __syncthreads();
        for (int i = F.tid; i < 4096; i += 512) { const int m = i >> 6, d = i & 63; const size_t row = (size_t)b * SEQ + n * CHUNK + m;
            ks[m * 65 + d] = bf2f(proj[row * PROJ_LD + C_KR + h * 64 + d]) * expf(lg * (float)(63 - m)); vs[m * 65 + d] = bf2f(proj[row * PROJ_LD + C_VR + h * 64 + d]); }
        __syncthreads();
        float* out = kv + (size_t)u * 4096;
#pragma unroll 1
        for (int i = F.tid; i < 4096; i += 512) { const int d = i >> 6, e = i & 63; float a = 0.f;
#pragma unroll 8
            for (int m = 0; m < 64; ++m) a = fmaf(ks[m * 65 + d], vs[m * 65 + e], a);
            out[i] = a; }
    }
}
__device__ __forceinline__ void mix_ret_scan(Frame& F) {
    float* kv = (float*)(F.ws + WS_KV);
    for (int bh = F.bid; bh < BATCH * H_RET; bh += F.G) { const float dec = expf(log_gamma(bh % H_RET) * (float)CHUNK);
        for (int i = F.tid; i < 4096; i += 512) { float st = 0.f; float* p = kv + (size_t)bh * NC * 4096 + i;
            for (int n = 0; n < NC; ++n) { const float x = p[(size_t)n * 4096]; p[(size_t)n * 4096] = st; st = dec * st + x; } } }
}
__device__ __forceinline__ void mix_ret_out(Frame& F, int L) {
    const bf16* proj = (const bf16*)(F.ws + WS_PROJ); const float* prev = (const float*)(F.ws + WS_KV); bf16* mix = (bf16*)(F.ws + WS_MIX); const float* gn_g = F.in(13) + L * D_RET;
    LAS float* qs = (LAS float*)(F.lds + RING_OFF); LAS float* ks = qs + 64 * 65; LAS float* vs = ks + 64 * 65; LAS float* S = vs + 64 * 65;
    for (int u = F.bid; u < BATCH * H_RET * NC; u += F.G) {
        const int n = u % NC, h = (u / NC) % H_RET, b = u / (NC * H_RET); const float lg = log_gamma(h);
        __syncthreads();
        for (int i = F.tid; i < 4096; i += 512) { const int m = i >> 6, d = i & 63; const size_t row = (size_t)b * SEQ + n * CHUNK + m;
            qs[m * 65 + d] = bf2f(proj[row * PROJ_LD + C_QR + h * 64 + d]); ks[m * 65 + d] = bf2f(proj[row * PROJ_LD + C_KR + h * 64 + d]); vs[m * 65 + d] = bf2f(proj[row * PROJ_LD + C_VR + h * 64 + d]); }
        __syncthreads();
#pragma unroll 1
        for (int i = F.tid; i < 4096; i += 512) { const int c = i >> 6, m = i & 63; float a = 0.f;
#pragma unroll 8
            for (int d = 0; d < 64; ++d) a = fmaf(qs[c * 65 + d], ks[m * 65 + d], a);
            const int dist = c > m ? c - m : m - c; S[c * 65 + m] = a * expf(lg * (float)dist); }
        __syncthreads();
        const float* pv = prev + (size_t)u * 4096; LAS float* O2 = S + 64 * 65;
#pragma unroll 1
        for (int i = F.tid; i < 4096; i += 512) { const int c = i >> 6, e = i & 63; float a = 0.f;
#pragma unroll 8
            for (int m = 0; m < 64; ++m) a = fmaf(S[c * 65 + m], vs[m * 65 + e], a);
            float x = 0.f;
#pragma unroll 8
            for (int d = 0; d < 64; ++d) x = fmaf(qs[c * 65 + d], pv[d * 64 + e], x);
            O2[c * 65 + e] = a + x * expf(lg * (float)(c + 1)); }
        __syncthreads();
        for (int i = F.tid; i < 4096; i += 512) { const int c = i >> 6, e = i & 63;
            float mu = 0.f;
#pragma unroll 8
            for (int d = 0; d < 64; ++d) mu += O2[c * 65 + d];
            mu *= (1.f / 64.f);
            float var = 0.f;
#pragma unroll 8
            for (int d = 0; d < 64; ++d) { const float dd = O2[c * 65 + d] - mu; var += dd * dd; }
            var *= (1.f / 64.f);
            const size_t row = (size_t)b * SEQ + n * CHUNK + c; const float g = bf2f(proj[row * PROJ_LD + C_GR + h * 64 + e]);
            const float y = (O2[c * 65 + e] - mu) * rsqrtf(var + EPS) * gn_g[h * 64 + e];
            mix[row * 1024 + D_ATT + D_CONV + h * 64 + e] = (bf16)f2bf(g * sigmoidf_(g) * y); }
    }
    __syncthreads();
}

template <int SUB> __device__ __forceinline__ void layer_phase(Frame& F, const int L) {
    bf16* HBP = (bf16*)(F.ws + WS_HB + (size_t)(L & 1) * HB_BYTES); bf16* HBQ = (bf16*)(F.ws + WS_HB + (size_t)((L + 1) & 1) * HB_BYTES);
    float* SS0 = (float*)(F.ws + WS_SS); float* SS1 = SS0 + (size_t)M * 16; float* SS2 = SS1 + (size_t)M * 16;
    bf16* PROJ = (bf16*)(F.ws + WS_PROJ); bf16* MIX = (bf16*)(F.ws + WS_MIX);
    bf16* HID = (bf16*)(F.ws + WS_HID); bf16* PLE = (bf16*)(F.ws + WS_PLE); bf16* CYB = (bf16*)(F.ws + WS_CYB);
    const bf16* WB = (const bf16*)(F.ws + WS_WBUF + (size_t)(L & 1) * WBUF_BYTES);
    if constexpr (SUB == 0) {
        pg8::StaticOrder S; S.init(M, PROJ_LD, 1024, F.G, F.bid, HBP, WB + WO_WIN);
        pg8::EpiBf16<0, true> E{PROJ, PROJ_LD, SS0};
        pg8::gemm_phase<pg8::EpiBf16<0, true>, pg8::StaticOrder, true, true>(F.lds + RING_OFF, 1024, S, E, F.tid);
    } else if constexpr (SUB == 1) {
        mix_prep(F, L); convert_p(F, L);
        if (L + 1 < DEPTH) convert_layer(F, L + 1);
    } else if constexpr (SUB == 2) {
        mix_ret_kv(F); mix_dwconv(F, L); mix_attn(F, L);
    } else if constexpr (SUB == 3) {
        mix_ret_scan(F); mix_conv_ln(F, L);
    } else if constexpr (SUB == 4) {
        { pg8::StaticOrder S; S.init(M, 256, 256, F.G, F.bid, CYB, WB + WO_PW);
          pg8::EpiBias E{MIX + D_ATT, 1024, F.in(12) + L * 256};
          pg8::gemm_phase<pg8::EpiBias, pg8::StaticOrder, false, true>(F.lds + RING_OFF, 256, S, E, F.tid); }
        __syncthreads();
        mix_ret_out(F, L);
    } else if constexpr (SUB == 5) {
        pg8::StaticOrder S; S.init(M, 1024, 1024, F.G, F.bid, MIX, WB + WO_WO);
        pg8::EpiRes<false> E{F.H, HBQ, SS1, nullptr, nullptr};
        pg8::gemm_phase<pg8::EpiRes<false>, pg8::StaticOrder, false, true>(F.lds + RING_OFF, 1024, S, E, F.tid);
    } else if constexpr (SUB == 6) {
        pg8::StaticOrder S; S.init(M, 4096, 1024, F.G, F.bid, HBQ, WB + WO_W1);
        pg8::EpiBf16<1, true> E{HID, 4096, SS1};
        pg8::gemm_phase<pg8::EpiBf16<1, true>, pg8::StaticOrder, true, true>(F.lds + RING_OFF, 1024, S, E, F.tid);
    } else if constexpr (SUB == 7) {
        pg8::StaticOrder S; S.init(M, 1024, 4096, F.G, F.bid, HID, WB + WO_W2);
        pg8::EpiRes<false> E{F.H, HBP, SS2, nullptr, nullptr};
        pg8::gemm_phase<pg8::EpiRes<false>, pg8::StaticOrder, false, true>(F.lds + RING_OFF, 4096, S, E, F.tid);
    } else {
        { pg8::StaticOrder S; S.init(M, 1024, 256, F.G, F.bid, (const bf16*)(F.ws + WS_PB), WB + WO_WPLE);
          pg8::EpiBf16<0, false> E{PLE, 1024, nullptr};
          pg8::gemm_phase<pg8::EpiBf16<0, false>, pg8::StaticOrder, false, true>(F.lds + RING_OFF, 256, S, E, F.tid); }
        __syncthreads();
        { pg8::StaticOrder S; S.init(M, 1024, 1024, F.G, F.bid, HBP, WB + WO_WPG);
          pg8::EpiRes<true> E{F.H, HBQ, SS0, SS2, PLE};
          pg8::gemm_phase<pg8::EpiRes<true>, pg8::StaticOrder, false, true>(F.lds + RING_OFF, 1024, S, E, F.tid); }
    }
}
constexpr int PH_PER_LAYER = 9, N_PHASES = 1 + PH_PER_LAYER * DEPTH;
__global__ void __launch_bounds__(NWAVES * 64, 2) mk_fwd(Args args) {
    extern __shared__ __attribute__((aligned(16))) unsigned char lds[];
    LAS unsigned char* const ldsb = (LAS unsigned char*)lds;
    for (int u = threadIdx.x; u < (LDS_BYTES - LDSCTL_OFF) / 4; u += NWAVES * 64) ((LAS unsigned*)(ldsb + LDSCTL_OFF))[u] = 0u;
    __syncthreads();
    if (threadIdx.x == 0) {
        LAS unsigned long long* P = (LAS unsigned long long*)(ldsb + PTR_OFF);
#pragma unroll
        for (int i = 0; i < 21; ++i) P[i] = (unsigned long long)(uintptr_t)args.in[i];
        P[21] = (unsigned long long)(uintptr_t)args.out; P[22] = (unsigned long long)(uintptr_t)args.ws;
    }
    __syncthreads();
    XcdBarrier bar; { unsigned char* ws0 = args.ws; bar.bar = (unsigned*)(ws0 + WS_CTL) + CW_BAR; bar.x = 0; bar.st = nullptr;
    const bool multi = (args.ph_hi - args.ph_lo) > 1;
    if (multi) bar = xcd_barrier_post((unsigned*)(ws0 + WS_CTL) + CW_BAR, (volatile LAS unsigned*)(ldsb + MISC_OFF) + 8); }
    const int lo = args.ph_lo, hi = args.ph_hi;
    const int wave0 = __builtin_amdgcn_readfirstlane(threadIdx.x >> 6);
#define FRAME_INIT() \
        int wv_ = wave0, bid_ = blockIdx.x; asm volatile("" : "+s"(wv_)); asm volatile("" : "+s"(bid_)); \
        int tid_ = wv_ * 64 + (int)__builtin_amdgcn_mbcnt_hi(~0u, __builtin_amdgcn_mbcnt_lo(~0u, 0u)); \
        Frame F; F.lds = ldsb; F.tid = tid_; F.lane = tid_ & 63; F.wave = __builtin_amdgcn_readfirstlane(tid_ >> 6); \
        F.G = gridDim.x; F.bid = bid_; F.gw = F.bid * NWAVES + F.wave; F.ngw = F.G * NWAVES; \
        { LAS unsigned long long* P = (LAS unsigned long long*)(ldsb + PTR_OFF); \
          F.H = (float*)(uintptr_t)rfl64(P[21]); F.ws = (unsigned char*)(uintptr_t)rfl64(P[22]); }
#define GRID_BAR() do { XcdBarrier b2; b2.bar = (unsigned*)(F.ws + WS_CTL) + CW_BAR; b2.x = xb_xcc_id(); b2.st = (volatile LAS unsigned*)(F.lds + MISC_OFF) + 8; xcd_barrier(b2); } while (0)
#define RUN_PHASE(ph, call) if (lo <= (ph) && (ph) < hi) { FRAME_INIT(); call; if ((ph) + 1 < hi) GRID_BAR(); }
    RUN_PHASE(0, prologue(F))
#define RUN_LAYER(L) \
    RUN_PHASE(1 + 9 * (L) + 0, (layer_phase<0>(F, (L)))) RUN_PHASE(1 + 9 * (L) + 1, (layer_phase<1>(F, (L)))) RUN_PHASE(1 + 9 * (L) + 2, (layer_phase<2>(F, (L)))) \
    RUN_PHASE(1 + 9 * (L) + 3, (layer_phase<3>(F, (L)))) RUN_PHASE(1 + 9 * (L) + 4, (layer_phase<4>(F, (L)))) RUN_PHASE(1 + 9 * (L) + 5, (layer_phase<5>(F, (L)))) \
    RUN_PHASE(1 + 9 * (L) + 6, (layer_phase<6>(F, (L)))) RUN_PHASE(1 + 9 * (L) + 7, (layer_phase<7>(F, (L)))) RUN_PHASE(1 + 9 * (L) + 8, (layer_phase<8>(F, (L))))
    RUN_LAYER(0) RUN_LAYER(1) RUN_LAYER(2) RUN_LAYER(3)
}

extern "C" void kernel_launch(void* const* d_in, const int* in_sizes, int n_in, void* d_out, int out_size, void* d_ws, size_t ws_size, hipStream_t stream) {
    static int grid = 0;
    if (grid == 0) {
        if (n_in != 21 || out_size != M * D_MODEL || ws_size < WS_END) { fprintf(stderr, "kernel_launch: unexpected shapes / workspace (%d inputs, out %d, ws %zu)\n", n_in, out_size, ws_size); grid = -1; return; }
        int dev = 0, cus = 0, per_cu = 0;
        if (hipGetDevice(&dev) != hipSuccess || hipDeviceGetAttribute(&cus, hipDeviceAttributeMultiprocessorCount, dev) != hipSuccess) { grid = -1; return; }
        if (hipFuncSetAttribute((const void*)mk_fwd, hipFuncAttributeMaxDynamicSharedMemorySize, LDS_BYTES) != hipSuccess) { fprintf(stderr, "kernel_launch: hipFuncSetAttribute failed\n"); grid = -1; return; }
        if (hipOccupancyMaxActiveBlocksPerMultiprocessor(&per_cu, (const void*)mk_fwd, NWAVES * 64, LDS_BYTES) != hipSuccess || per_cu < 1) { fprintf(stderr, "kernel_launch: occupancy query says %d\n", per_cu); per_cu = 1; }
        (void)hipGetLastError();
        grid = cus;
    }
    if (grid < 0) return;
    if (hipMemsetAsync((char*)d_ws + WS_CTL, 0, CTL_ZERO_BYTES, stream) != hipSuccess) return;
    Args a{};
    for (int i = 0; i < 21; ++i) a.in[i] = (const float*)d_in[i];
    a.out = (float*)d_out; a.ws = (unsigned char*)d_ws;
#if MK_PER_PHASE
    for (int ph = 0; ph < N_PHASES; ++ph) { a.ph_lo = ph; a.ph_hi = ph + 1; hipLaunchKernelGGL(mk_fwd, dim3(grid), dim3(NWAVES * 64), LDS_BYTES, stream, a); }
#else
    a.ph_lo = 0; a.ph_hi = N_PHASES;
    void* kargs[] = {&a};
    hipError_t e = hipLaunchCooperativeKernel((const void*)mk_fwd, dim3(grid), dim3(NWAVES * 64), kargs, LDS_BYTES, stream);
    if (e != hipSuccess) fprintf(stderr, "kernel_launch: cooperative launch failed: %s (grid %d)\n", hipGetErrorString(e), grid);
#endif
}
```

```cpp
#include <hip/hip_runtime.h>
#include <cstdio>
#include <cstdint>

#ifndef MK_PER_PHASE
#define MK_PER_PHASE 0
#endif

namespace pg8 {
#define PG8_LAS __attribute__((address_space(3)))
typedef unsigned short bf16_t;
typedef short bf16x8 __attribute__((ext_vector_type(8)));
typedef float f32x4 __attribute__((ext_vector_type(4)));
typedef unsigned u32x4 __attribute__((ext_vector_type(4)));
constexpr int BM = 256, BK = 64, HALF = 128, HTB = HALF * BK * 2, STAGE_BYTES = 8 * HTB, NXCD = 8, WGM = 8;
__host__ __device__ __forceinline__ int lds_byte(int r, int c) { const int st = (r >> 4) * 2 + (c >> 5), rr = r & 15, cc = c & 31, ob = rr * 64 + cc * 2; return st * 1024 + (ob ^ (((ob >> 9) & 1) << 5)); }
__host__ __device__ __forceinline__ void stage_rc(int b, int& R, int& C) { const int st = b / 1024, sb = b % 1024, swz = sb ^ (((sb >> 9) & 1) << 5); R = (st >> 1) * 16 + swz / 64; C = (st & 1) * 32 + (swz % 64) / 2; }
__host__ __device__ __forceinline__ int perm32(int rho) { const int n = rho >> 4, i = rho & 15; return 8 * (i >> 2) + 4 * n + (i & 3); }
struct Unit { int pm, pn; };
struct StaticOrder {
    int nM, nN, nwg, G, c; const char* A; const char* Bt; size_t tstep;
    __device__ void init(int M, int N, int K, int G_, int c_, const void* A_, const void* Bt_) { nM = M / BM; nN = N / BM; nwg = nM * nN; G = G_; c = c_; A = (const char*)A_; Bt = (const char*)Bt_; tstep = (size_t)BM * K * 2; }
    __device__ bool next(int i, Unit& u) const {
        const long L = (long)i * G + c; if (L >= nwg) return false;
        int wgid = (int)L; { const int q = nwg / NXCD, r = nwg % NXCD, xcd = wgid % NXCD, off = wgid / NXCD; wgid = (xcd < r ? xcd * (q + 1) : r * (q + 1) + (xcd - r) * q) + off; }
        const int nig = WGM * nN, gid = wgid / nig, fm = gid * WGM, gsz = (nM - fm) < WGM ? (nM - fm) : WGM;
        u.pm = fm + ((wgid % nig) % gsz); u.pn = (wgid % nig) / gsz; return true;
    }
    __device__ __forceinline__ const char* a_ptr(const Unit& u) const { return A + (size_t)u.pm * tstep; }
    __device__ __forceinline__ const char* b_ptr(const Unit& u) const { return Bt + (size_t)u.pn * tstep; }
    __device__ __forceinline__ void a_ready(const Unit&) const {}
    __device__ __forceinline__ void done(const Unit&) const {}
};
__device__ __forceinline__ unsigned cvt_pk_bf16(float lo, float hi) { unsigned r; asm volatile("v_cvt_pk_bf16_f32 %0, %1, %2" : "=v"(r) : "v"(lo), "v"(hi)); return r; }
__device__ __forceinline__ u32x4 pack8(f32x4 v0, f32x4 v1) { u32x4 w; w.x = cvt_pk_bf16(v0[0], v0[1]); w.y = cvt_pk_bf16(v0[2], v0[3]); w.z = cvt_pk_bf16(v1[0], v1[1]); w.w = cvt_pk_bf16(v1[2], v1[3]); return w; }
__device__ __forceinline__ float bfl(unsigned w) { return __uint_as_float(w << 16); }
__device__ __forceinline__ float bfh(unsigned w) { return __uint_as_float(w & 0xffff0000u); }

__device__ __forceinline__ float row_rstd(const float* SS, int row) {
    const f32x4* p = (const f32x4*)(SS + (size_t)row * 16); const f32x4 a = p[0], b = p[1], c = p[2], d = p[3];
    const float s = ((a[0] + a[1]) + (a[2] + a[3])) + ((b[0] + b[1]) + (b[2] + b[3])) + ((c[0] + c[1]) + (c[2] + c[3])) + ((d[0] + d[1]) + (d[2] + d[3]));
    return rsqrtf(s * (1.0f / 1024.0f) + 1e-6f);
}
template <int ACT, bool SCALE> struct EpiBf16 {
    static constexpr bool PERM = true, AFTER_DRAIN = false;
    bf16_t* O; int ldc; const float* SS;
    __device__ __forceinline__ void operator()(const f32x4 (&acc)[2][2][4][2], const Unit& u, int wr, int wc, int fr, int fq) const {
#pragma unroll
        for (int ai = 0; ai < 2; ++ai)
#pragma unroll
            for (int m = 0; m < 4; ++m) { const int row = u.pm * BM + ai * HALF + wr * 64 + m * 16 + fr; const float r = SCALE ? row_rstd(SS, row) : 1.0f;
#pragma unroll
                for (int bj = 0; bj < 2; ++bj) { const int col = u.pn * BM + bj * HALF + wc * 32 + 8 * fq; f32x4 v0 = acc[ai][bj][m][0] * r, v1 = acc[ai][bj][m][1] * r;
                    if (ACT == 1) {
#pragma unroll
                        for (int j = 0; j < 4; ++j) { const float a = fmaxf(v0[j], 0.f), b = fmaxf(v1[j], 0.f); v0[j] = a * a; v1[j] = b * b; } }
                    *(u32x4*)(O + (size_t)row * ldc + col) = pack8(v0, v1); } }
    }
};
struct EpiBias {
    static constexpr bool PERM = true, AFTER_DRAIN = false;
    bf16_t* O; int ldc; const float* bias;
    __device__ __forceinline__ void operator()(const f32x4 (&acc)[2][2][4][2], const Unit& u, int wr, int wc, int fr, int fq) const {
#pragma unroll
        for (int ai = 0; ai < 2; ++ai)
#pragma unroll
            for (int m = 0; m < 4; ++m) { const int row = u.pm * BM + ai * HALF + wr * 64 + m * 16 + fr;
#pragma unroll
                for (int bj = 0; bj < 2; ++bj) { const int col = u.pn * BM + bj * HALF + wc * 32 + 8 * fq; const f32x4 b0 = *(const f32x4*)(bias + col), b1 = *(const f32x4*)(bias + col + 4);
                    *(u32x4*)(O + (size_t)row * ldc + col) = pack8(acc[ai][bj][m][0] + b0, acc[ai][bj][m][1] + b1); } }
    }
};
template <bool GATE> struct EpiRes {
    static constexpr bool PERM = true, AFTER_DRAIN = false;
    float* H; bf16_t* HB; float* SSout; const float* SSin; const bf16_t* PLE;
    __device__ __forceinline__ void operator()(const f32x4 (&acc)[2][2][4][2], const Unit& u, int wr, int wc, int fr, int fq) const {
#pragma unroll
        for (int ai = 0; ai < 2; ++ai)
#pragma unroll
            for (int m = 0; m < 4; ++m) { const int row = u.pm * BM + ai * HALF + wr * 64 + m * 16 + fr; float ssq = 0.f; const float r = GATE ? row_rstd(SSin, row) : 1.0f;
#pragma unroll
                for (int bj = 0; bj < 2; ++bj) { const int col = u.pn * BM + bj * HALF + wc * 32 + 8 * fq; float* hp = H + (size_t)row * 1024 + col;
                    f32x4 v0 = acc[ai][bj][m][0], v1 = acc[ai][bj][m][1];
                    if (GATE) { const u32x4 pw = *(const u32x4*)(PLE + (size_t)row * 1024 + col);
                        const f32x4 p0 = {bfl(pw.x), bfh(pw.x), bfl(pw.y), bfh(pw.y)}, p1 = {bfl(pw.z), bfh(pw.z), bfl(pw.w), bfh(pw.w)};
#pragma unroll
                        for (int j = 0; j < 4; ++j) { v0[j] = p0[j] / (1.0f + __expf(-v0[j] * r)); v1[j] = p1[j] / (1.0f + __expf(-v1[j] * r)); } }
                    v0 = v0 + *(const f32x4*)hp; v1 = v1 + *(const f32x4*)(hp + 4);
                    *(f32x4*)hp = v0; *(f32x4*)(hp + 4) = v1;
                    *(u32x4*)(HB + (size_t)row * 1024 + col) = pack8(v0, v1);
                    ssq += (v0[0] * v0[0] + v0[1] * v0[1]) + (v0[2] * v0[2] + v0[3] * v0[3]) + (v1[0] * v1[0] + v1[1] * v1[1]) + (v1[2] * v1[2] + v1[3] * v1[3]); }
                ssq += __shfl_xor(ssq, 16); ssq += __shfl_xor(ssq, 32);
                if (fq == 0) SSout[(size_t)row * 16 + u.pn * 4 + wc] = ssq; }
    }
};

typedef float f32x2v __attribute__((ext_vector_type(2)));
typedef unsigned u32x2 __attribute__((ext_vector_type(2)));
struct InProjOut {
    bf16_t *QFa, *KFa, *VFa, *QFr, *KFr, *KTr, *VFr, *G, *GLU;
    const float* SS; const float* qn_g; const float* kn_g; const float* CS; const float* CST; const float* DK;
};
struct InProjOrder : StaticOrder {
    __device__ __forceinline__ const char* a_ptr(const Unit& u) const { return u.pn < 10 ? A + (size_t)u.pm * tstep : Bt + (size_t)u.pn * tstep; }
    __device__ __forceinline__ const char* b_ptr(const Unit& u) const { return u.pn < 10 ? Bt + (size_t)u.pn * tstep : A + (size_t)u.pm * tstep; }
};
__device__ __forceinline__ float sigm(float x) { return 1.0f / (1.0f + __expf(-x)); }
__device__ __forceinline__ u32x2 pack4(f32x4 v) { u32x2 w; w.x = cvt_pk_bf16(v[0], v[1]); w.y = cvt_pk_bf16(v[2], v[3]); return w; }
struct EpiInProj {
    static constexpr bool PERM = true, AFTER_DRAIN = false;
    InProjOut o;
    __device__ __forceinline__ void operator()(const f32x4 (&acc)[2][2][4][2], const Unit& u, int wr, int wc, int fr, int fq) const {
        asm volatile("" : "+v"(fr), "+v"(fq));
        const int T = u.pn;
        if (T < 10) {
            int kind, head;
            if (T < 3) { const int g = 4 * T + wc; kind = g < 6 ? 0 : 1; head = g < 6 ? g : g - 6; }
            else if (T < 5) { kind = 2; head = 0; }
            else { const int g = 4 * (T - 5) + wc; kind = g < 6 ? 3 : (g < 12 ? 4 : (g < 18 ? 5 : 6)); head = g % 6; }
            if (kind == 6) return;
#pragma unroll
            for (int ai = 0; ai < 2; ++ai)
#pragma unroll
                for (int m = 0; m < 4; ++m) {
                    const int token = u.pm * BM + ai * HALF + wr * 64 + m * 16 + fr; const float rstd = row_rstd(o.SS, token);
                    const int bb = token >> 11, s = token & 2047;
                    f32x4 a0 = acc[ai][0][m][0] * rstd, a1 = acc[ai][0][m][1] * rstd, b0 = acc[ai][1][m][0] * rstd, b1 = acc[ai][1][m][1] * rstd;
                    if (kind == 0 || kind == 1) {
                        float ss = (a0[0] * a0[0] + a0[1] * a0[1]) + (a0[2] * a0[2] + a0[3] * a0[3]) + (a1[0] * a1[0] + a1[1] * a1[1]) + (a1[2] * a1[2] + a1[3] * a1[3])
                                 + (b0[0] * b0[0] + b0[1] * b0[1]) + (b0[2] * b0[2] + b0[3] * b0[3]) + (b1[0] * b1[0] + b1[1] * b1[1]) + (b1[2] * b1[2] + b1[3] * b1[3]);
                        ss += __shfl_xor(ss, 16); ss += __shfl_xor(ss, 32);
                        const float r2 = rsqrtf(ss * (1.0f / 64.0f) + 1e-6f) * (kind == 0 ? 0.125f * 1.4426950408889634f : 1.0f);
                        const float* gp = (kind == 0 ? o.qn_g : o.kn_g) + 8 * fq;
                        const f32x4 g0 = *(const f32x4*)gp, g1 = *(const f32x4*)(gp + 4), g2 = *(const f32x4*)(gp + 32), g3 = *(const f32x4*)(gp + 36);
                        bf16_t* base = (kind == 0 ? o.QFa : o.KFa) + ((size_t)((bb * 6 + head) * 64 + (s >> 5)) * 4 + (fq >> 1)) * 512 + ((fq & 1) * 32 + (s & 31)) * 8;
                        *(u32x4*)base = pack8(a0 * g0 * r2, a1 * g1 * r2); *(u32x4*)(base + 1024) = pack8(b0 * g2 * r2, b1 * g3 * r2);
                    } else if (kind == 3 || kind == 4) {
                        const float sc = kind == 3 ? 0.125f : 1.0f;
                        const f32x4* cp = (const f32x4*)(o.CS + (size_t)s * 64 + 16 * fq);
                        const f32x4 c0 = cp[0], c1 = cp[1], c2 = cp[2], c3 = cp[3];
                        f32x4 x0, x1, y0, y1;
                        x0[0] = (a0[0] * c0[0] - b0[0] * c0[1]) * sc; y0[0] = (a0[0] * c0[1] + b0[0] * c0[0]) * sc; x0[1] = (a0[1] * c0[2] - b0[1] * c0[3]) * sc; y0[1] = (a0[1] * c0[3] + b0[1] * c0[2]) * sc;
                        x0[2] = (a0[2] * c1[0] - b0[2] * c1[1]) * sc; y0[2] = (a0[2] * c1[1] + b0[2] * c1[0]) * sc; x0[3] = (a0[3] * c1[2] - b0[3] * c1[3]) * sc; y0[3] = (a0[3] * c1[3] + b0[3] * c1[2]) * sc;
                        x1[0] = (a1[0] * c2[0] - b1[0] * c2[1]) * sc; y1[0] = (a1[0] * c2[1] + b1[0] * c2[0]) * sc; x1[1] = (a1[1] * c2[2] - b1[1] * c2[3]) * sc; y1[1] = (a1[1] * c2[3] + b1[1] * c2[2]) * sc;
                        x1[2] = (a1[2] * c3[0] - b1[2] * c3[1]) * sc; y1[2] = (a1[2] * c3[1] + b1[2] * c3[0]) * sc; x1[3] = (a1[3] * c3[2] - b1[3] * c3[3]) * sc; y1[3] = (a1[3] * c3[3] + b1[3] * c3[2]) * sc;
                        bf16_t* base = (kind == 3 ? o.QFr : o.KFr) + ((size_t)((bb * 6 + head) * 64 + (s >> 5)) * 4 + (fq >> 1)) * 512 + ((fq & 1) * 32 + (s & 31)) * 8;
                        *(u32x4*)base = pack8(x0, x1); *(u32x4*)(base + 1024) = pack8(y0, y1);
                    } else if (kind == 5) {
#pragma unroll
                        for (int j = 0; j < 4; ++j) { a0[j] *= sigm(a0[j]); a1[j] *= sigm(a1[j]); b0[j] *= sigm(b0[j]); b1[j] *= sigm(b1[j]); }
                        bf16_t* base = o.G + (size_t)token * 384 + head * 64 + 8 * fq;
                        *(u32x4*)base = pack8(a0, a1); *(u32x4*)(base + 32) = pack8(b0, b1);
                    } else {
#pragma unroll
                        for (int j = 0; j < 4; ++j) { a0[j] *= sigm(b0[j]); a1[j] *= sigm(b1[j]); }
                        *(u32x4*)(o.GLU + (size_t)token * 256 + 128 * (T - 3) + 32 * wc + 8 * fq) = pack8(a0, a1);
                    }
                }
        } else {
#pragma unroll
            for (int bj = 0; bj < 2; ++bj) {
                const int tok0 = u.pm * BM + bj * HALF + wc * 32 + 8 * fq, bb = tok0 >> 11, s0 = tok0 & 2047, kb16 = s0 >> 4, uu = (s0 >> 3) & 1;
                f32x4 rs0, rs1;
#pragma unroll
                for (int j = 0; j < 4; ++j) { rs0[j] = row_rstd(o.SS, tok0 + j); rs1[j] = row_rstd(o.SS, tok0 + 4 + j); }
#pragma unroll
                for (int ai = 0; ai < 2; ++ai) {
                    const int g = 4 * (T - 10) + 2 * ai + wr;
                    if (g >= 18) continue;
                    const int head = g % 6, bh = bb * 6 + head;
                    if (g < 12) {
                        bf16_t* dst = (g < 6 ? o.VFa : o.VFr) + ((size_t)(bh * 128 + kb16) * 2) * 512 + 4 * uu;
#pragma unroll
                        for (int m = 0; m < 4; ++m) { bf16_t* p = dst + ((m >> 1) * 64 + 16 * (m & 1) + fr) * 8;
                            *(u32x2*)p = pack4(acc[ai][bj][m][0] * rs0); *(u32x2*)(p + 256) = pack4(acc[ai][bj][m][1] * rs1); }
                    } else {
                        bf16_t* dst = o.KTr + ((size_t)(bh * 128 + kb16) * 2) * 512 + 4 * uu;
                        const f32x4 dk0 = *(const f32x4*)(o.DK + head * 64 + (s0 & 63)), dk1 = *(const f32x4*)(o.DK + head * 64 + (s0 & 63) + 4);
#pragma unroll
                        for (int m = 0; m < 2; ++m) { const int i = 16 * m + fr;
                            const f32x4* cp = (const f32x4*)(o.CST + ((size_t)i * 2048 + s0) * 2);
                            const f32x4 c0 = cp[0], c1 = cp[1], c2 = cp[2], c3 = cp[3];
                            const f32x4 t10 = acc[ai][bj][m][0] * rs0, t11 = acc[ai][bj][m][1] * rs1, t20 = acc[ai][bj][m + 2][0] * rs0, t21 = acc[ai][bj][m + 2][1] * rs1;
                            f32x4 x0, x1, y0, y1;
                            x0[0] = (t10[0] * c0[0] - t20[0] * c0[1]) * dk0[0]; y0[0] = (t10[0] * c0[1] + t20[0] * c0[0]) * dk0[0]; x0[1] = (t10[1] * c0[2] - t20[1] * c0[3]) * dk0[1]; y0[1] = (t10[1] * c0[3] + t20[1] * c0[2]) * dk0[1];
                            x0[2] = (t10[2] * c1[0] - t20[2] * c1[1]) * dk0[2]; y0[2] = (t10[2] * c1[1] + t20[2] * c1[0]) * dk0[2]; x0[3] = (t10[3] * c1[2] - t20[3] * c1[3]) * dk0[3]; y0[3] = (t10[3] * c1[3] + t20[3] * c1[2]) * dk0[3];
                            x1[0] = (t11[0] * c2[0] - t21[0] * c2[1]) * dk1[0]; y1[0] = (t11[0] * c2[1] + t21[0] * c2[0]) * dk1[0]; x1[1] = (t11[1] * c2[2] - t21[1] * c2[3]) * dk1[1]; y1[1] = (t11[1] * c2[3] + t21[1] * c2[2]) * dk1[1];
                            x1[2] = (t11[2] * c3[0] - t21[2] * c3[1]) * dk1[2]; y1[2] = (t11[2] * c3[1] + t21[2] * c3[0]) * dk1[2]; x1[3] = (t11[3] * c3[2] - t21[3] * c3[3]) * dk1[3]; y1[3] = (t11[3] * c3[3] + t21[3] * c3[2]) * dk1[3];
                            bf16_t* p = dst + i * 8;
                            *(u32x2*)p = pack4(x0); *(u32x2*)(p + 256) = pack4(x1); *(u32x2*)(p + 512) = pack4(y0); *(u32x2*)(p + 512 + 256) = pack4(y1); }
                    }
                }
            }
        }
    }
};

template <class Epi, class Sched, bool ALIGN_EPI = false, bool SP2 = false>
__device__ __forceinline__ void gemm_phase(PG8_LAS unsigned char* lds, const int K, const Sched& S, const Epi& E, const int tid) {
    const int wid = __builtin_amdgcn_readfirstlane(tid >> 6), lane = tid & 63, wr = wid >> 2, wc = wid & 3, fr = lane & 15, fq = lane >> 4;
    const int nt = K / BK;
    unsigned voffA[2], voffB[2];
#pragma unroll
    for (int i = 0; i < 2; ++i) { int R, C; stage_rc(tid * 16 + i * 8192, R, C); const int Rb = Epi::PERM ? ((R & ~31) + perm32(R & 31)) : R;
        voffA[i] = (unsigned)(R * K + C) * 2u; voffB[i] = (unsigned)(Rb * K + C) * 2u; }
    const size_t kstep = (size_t)(BK * 2);
    const size_t hstep = (size_t)HALF * K * 2;
    const unsigned ldsw = (unsigned)wid * 1024u;
    const int aoff = lds_byte(wr * 64 + fr, fq * 8), boff = lds_byte(wc * 32 + fr, fq * 8);
#define PG8_SA(b, h) (((b) * 2 + (h)) * HTB)
#define PG8_SB(b, h) ((4 + (b) * 2 + (h)) * HTB)
#define PG8_STAGE(bufoff, gbase, voff) do { _Pragma("unroll") for (int _i = 0; _i < 2; ++_i) \
        __builtin_amdgcn_global_load_lds((const unsigned*)((const char*)(gbase) + (voff)[_i]), (PG8_LAS unsigned*)(lds + (bufoff) + ldsw + _i * 8192), 16, 0, 0); } while (0)
#define PG8_LDA(dst, b, h) do { _Pragma("unroll") for (int m = 0; m < 4; ++m) _Pragma("unroll") for (int k = 0; k < 2; ++k) dst[m][k] = *(const PG8_LAS bf16x8*)(lds + PG8_SA(b, h) + aoff + m * 2048 + k * 1024); } while (0)
#define PG8_LDB(dst, b, h) do { _Pragma("unroll") for (int n = 0; n < 2; ++n) _Pragma("unroll") for (int k = 0; k < 2; ++k) dst[n][k] = *(const PG8_LAS bf16x8*)(lds + PG8_SB(b, h) + boff + n * 2048 + k * 1024); } while (0)
#define PG8_MMA(ai, bj, At, Bt) do { __builtin_amdgcn_s_setprio(1); _Pragma("unroll") for (int m = 0; m < 4; ++m) _Pragma("unroll") for (int n = 0; n < 2; ++n) _Pragma("unroll") for (int k = 0; k < 2; ++k) \
        acc[ai][bj][m][n] = __builtin_amdgcn_mfma_f32_16x16x32_bf16(Bt[n][k], At[m][k], acc[ai][bj][m][n], 0, 0, 0); __builtin_amdgcn_s_setprio(0); } while (0)
#define PG8_WAIT_V(n) asm volatile("s_waitcnt vmcnt(" #n ")" ::: "memory")
#define PG8_WAIT_L(n) asm volatile("s_waitcnt lgkmcnt(" #n ")" ::: "memory")
#define PG8_BAR __builtin_amdgcn_s_barrier()
#define PG8_SCHED __builtin_amdgcn_sched_barrier(0)
    Unit cur, nxt; int ui = 0;
    if (!S.next(0, cur)) return;
    f32x4 acc[2][2][4][2];
#pragma unroll
    for (int a = 0; a < 2; ++a)
#pragma unroll
        for (int b = 0; b < 2; ++b)
#pragma unroll
            for (int m = 0; m < 4; ++m)
#pragma unroll
                for (int n = 0; n < 2; ++n) acc[a][b][m][n] = (f32x4){0.f, 0.f, 0.f, 0.f};
    bf16x8 At[4][2], B0[2][2], B1[2][2];
    const char* cA = S.a_ptr(cur); const char* cB = S.b_ptr(cur);
    S.a_ready(cur);
    if constexpr (SP2) {
        PG8_STAGE(PG8_SB(0, 0), cB, voffB); PG8_STAGE(PG8_SB(0, 1), cB + hstep, voffB); PG8_STAGE(PG8_SA(0, 0), cA, voffA); PG8_STAGE(PG8_SA(0, 1), cA + hstep, voffA);
        if (wr == 1) PG8_BAR;
        PG8_WAIT_V(2); PG8_BAR;
        PG8_STAGE(PG8_SB(1, 0), cB + kstep, voffB); PG8_STAGE(PG8_SA(1, 0), cA + kstep, voffA); PG8_STAGE(PG8_SB(1, 1), cB + hstep + kstep, voffB);
        PG8_WAIT_V(6); PG8_BAR;
    } else {
        PG8_STAGE(PG8_SB(0, 0), cB, voffB); PG8_STAGE(PG8_SA(0, 0), cA, voffA); PG8_STAGE(PG8_SB(0, 1), cB + hstep, voffB); PG8_STAGE(PG8_SA(0, 1), cA + hstep, voffA);
        if (wr == 1) PG8_BAR;
        PG8_WAIT_V(4); PG8_BAR;
        PG8_STAGE(PG8_SB(1, 0), cB + kstep, voffB); PG8_STAGE(PG8_SA(1, 0), cA + kstep, voffA); PG8_STAGE(PG8_SB(1, 1), cB + hstep + kstep, voffB);
        PG8_WAIT_V(6); PG8_BAR;
    }
    for (;;) {
        const bool has_next = S.next(ui + 1, nxt);
        const char* nA = has_next ? S.a_ptr(nxt) : cA; const char* nB = has_next ? S.b_ptr(nxt) : cB;
        for (int t = 0; t < nt; t += 2) {
            const bool last = (t == nt - 2);
            const char* a1 = cA + (size_t)(t + 1) * kstep;
            const char* a2 = last ? nA : cA + (size_t)(t + 2) * kstep; const char* b2 = last ? nB : cB + (size_t)(t + 2) * kstep;
            const char* a3 = a2 + kstep; const char* b3 = b2 + kstep;
            if (last && has_next) S.a_ready(nxt);
            if constexpr (SP2) {
            PG8_LDB(B0, 0, 0); PG8_LDB(B1, 0, 1); PG8_SCHED; PG8_LDA(At, 0, 0); PG8_STAGE(PG8_SA(1, 1), a1 + hstep, voffA);
            PG8_WAIT_V(8); PG8_WAIT_L(0); PG8_BAR; PG8_MMA(0, 0, At, B0); PG8_MMA(0, 1, At, B1); PG8_BAR; PG8_SCHED;
            PG8_LDA(At, 0, 1); PG8_STAGE(PG8_SB(0, 0), b2, voffB); PG8_STAGE(PG8_SB(0, 1), b2 + hstep, voffB); PG8_STAGE(PG8_SA(0, 0), a2, voffA);
            PG8_WAIT_V(8); PG8_WAIT_L(0); PG8_BAR; PG8_MMA(1, 0, At, B0); PG8_MMA(1, 1, At, B1); PG8_BAR; PG8_SCHED;
            PG8_LDB(B0, 1, 0); PG8_LDB(B1, 1, 1); PG8_SCHED; PG8_LDA(At, 1, 0); PG8_STAGE(PG8_SA(0, 1), a2 + hstep, voffA);
            PG8_WAIT_V(8); PG8_WAIT_L(0); PG8_BAR; PG8_MMA(0, 0, At, B0); PG8_MMA(0, 1, At, B1); PG8_BAR; PG8_SCHED;
            PG8_LDA(At, 1, 1); PG8_STAGE(PG8_SB(1, 0), b3, voffB); PG8_STAGE(PG8_SB(1, 1), b3 + hstep, voffB); PG8_STAGE(PG8_SA(1, 0), a3, voffA);
            PG8_WAIT_V(8); PG8_WAIT_L(0); PG8_BAR; PG8_MMA(1, 0, At, B0); PG8_MMA(1, 1, At, B1); PG8_BAR; PG8_SCHED;
            } else {
            PG8_LDB(B0, 0, 0); PG8_SCHED; PG8_LDA(At, 0, 0); PG8_STAGE(PG8_SA(1, 1), a1 + hstep, voffA);
            PG8_WAIT_L(8); PG8_BAR; PG8_WAIT_L(0); PG8_MMA(0, 0, At, B0); PG8_BAR; PG8_SCHED;
            PG8_LDB(B1, 0, 1); PG8_STAGE(PG8_SB(0, 0), b2, voffB);
            PG8_BAR; PG8_WAIT_L(0); PG8_MMA(0, 1, At, B1); PG8_BAR;
            PG8_LDA(At, 0, 1); PG8_STAGE(PG8_SA(0, 0), a2, voffA);
            PG8_BAR; PG8_WAIT_L(0); PG8_MMA(1, 0, At, B0); PG8_BAR; PG8_SCHED;
            PG8_STAGE(PG8_SB(0, 1), b2 + hstep, voffB);
            PG8_WAIT_V(6); PG8_BAR; PG8_MMA(1, 1, At, B1); PG8_BAR;
            PG8_LDB(B0, 1, 0); PG8_SCHED; PG8_LDA(At, 1, 0); PG8_STAGE(PG8_SA(0, 1), a2 + hstep, voffA);
            PG8_WAIT_L(8); PG8_BAR; PG8_WAIT_L(0); PG8_MMA(0, 0, At, B0); PG8_BAR; PG8_SCHED;
            PG8_LDB(B1, 1, 1); PG8_STAGE(PG8_SB(1, 0), b3, voffB);
            PG8_BAR; PG8_WAIT_L(0); PG8_MMA(0, 1, At, B1); PG8_BAR;
            PG8_LDA(At, 1, 1); PG8_STAGE(PG8_SA(1, 0), a3, voffA);
            PG8_BAR; PG8_WAIT_L(0); PG8_MMA(1, 0, At, B0); PG8_BAR; PG8_SCHED;
            PG8_STAGE(PG8_SB(1, 1), b3 + hstep, voffB);
            PG8_WAIT_V(6); PG8_BAR; PG8_MMA(1, 1, At, B1); PG8_BAR;
            }
        }
        if constexpr (ALIGN_EPI) { if (wr == 0) PG8_BAR; }
        if constexpr (!Epi::AFTER_DRAIN) { E(acc, cur, wr, wc, fr, fq); S.done(cur); }
        if (!has_next) break;
#pragma unroll
        for (int a = 0; a < 2; ++a)
#pragma unroll
            for (int b = 0; b < 2; ++b)
#pragma unroll
                for (int m = 0; m < 4; ++m)
#pragma unroll
                    for (int n = 0; n < 2; ++n) acc[a][b][m][n] = (f32x4){0.f, 0.f, 0.f, 0.f};
        cur = nxt; cA = nA; cB = nB; ++ui;
        if constexpr (ALIGN_EPI) { if (wr == 1) PG8_BAR; }
    }
    PG8_WAIT_V(0);
    if constexpr (!ALIGN_EPI) { if (wr == 0) PG8_BAR; }
    PG8_BAR;
    if constexpr (Epi::AFTER_DRAIN) { E.fused(acc, cur, wr, wc, fr, fq, lds, wid, lane); S.done(cur); }
#undef PG8_SA
#undef PG8_SB
#undef PG8_STAGE
#undef PG8_LDA
#undef PG8_LDB
#undef PG8_MMA
#undef PG8_WAIT_V
#undef PG8_WAIT_L
#undef PG8_BAR
#undef PG8_SCHED
}
}

constexpr int D_MODEL = 1024, BATCH = 8, SEQ = 2048, DEPTH = 4, CHUNK = 64, NLEFT = 8, HD = 64;
constexpr int D_ATT = 384, D_RET = 384, D_CONV = 256, H_ATT = 6, H_RET = 6, CONV_K = 31, REL_CLIP = 128;
constexpr int D_FF = 4096, D_PLE = 256, D_IN = 3200, M = BATCH * SEQ, NC = SEQ / CHUNK;
constexpr int NIN_ROWS = 15 * 256;
constexpr float EPS = 1e-6f;
constexpr int C_QA = 0, C_KA = 384, C_VA = 768, C_UC = 1152, C_QR = 1664, C_KR = 2048, C_VR = 2432, C_GR = 2816;
constexpr int NWAVES = 8;

constexpr size_t MiB = 1u << 20;
constexpr size_t WS_CTL = 0, CTL_ZERO_BYTES = 1 * MiB;
constexpr size_t WS_SS = 1 * MiB;
constexpr size_t WS_WBUF = 4 * MiB, WBUF_BYTES = 29 * MiB;
constexpr size_t WS_HB = 62 * MiB, HB_BYTES = 32 * MiB;
constexpr size_t WS_PLE = 126 * MiB;
constexpr size_t WS_KV = 126 * MiB;
constexpr size_t WS_PROJ = 158 * MiB;
constexpr size_t WS_MIX = 262 * MiB;
constexpr size_t WS_HID = 158 * MiB;
constexpr size_t WS_PB = 294 * MiB;
constexpr size_t WS_CS = 302 * MiB;
constexpr size_t WS_CST = WS_CS + 512 * 1024;
constexpr size_t WS_BT = 303 * MiB;
constexpr size_t WS_DK = 304 * MiB;
constexpr size_t WS_END = 305 * MiB;
constexpr size_t WO_WIN = 0, WO_WO = WO_WIN + (size_t)NIN_ROWS * 1024, WO_W1 = WO_WO + 1024 * 1024, WO_W2 = WO_W1 + 4096 * 1024, WO_WPG = WO_W2 + 4096 * 1024,
                 WO_WPLE = WO_WPG + 1024 * 1024, WO_PW = WO_WPLE + 1024 * 256, WO_END = WO_PW + 256 * 256;
static_assert(WO_END * 2 <= WBUF_BYTES, "weight buffer");
constexpr int CW_BAR = 4096;

constexpr int RING_OFF = 0, RING_BYTES = 131072;
constexpr int LDSCTL_OFF = RING_BYTES, MISC_OFF = LDSCTL_OFF + 320;
constexpr int LDS_BYTES = 147456, PTR_OFF = LDSCTL_OFF + 1024;

#define GAS __attribute__((address_space(1)))
#define LAS __attribute__((address_space(3)))
typedef unsigned short bf16;
typedef unsigned v4u __attribute__((ext_vector_type(4)));
typedef float f32x4 __attribute__((ext_vector_type(4)));
typedef GAS unsigned gu32;
#define LDS_WAIT() asm volatile("s_waitcnt lgkmcnt(0)" ::: "memory")
__device__ __forceinline__ unsigned f2bf(float f) { unsigned u = __builtin_bit_cast(unsigned, f); return (u + 0x7fffu + ((u >> 16) & 1u)) >> 16; }
__device__ __forceinline__ unsigned pk2(float lo, float hi) { return f2bf(lo) | (f2bf(hi) << 16); }
__device__ __forceinline__ float bf2f(bf16 v) { return __uint_as_float((unsigned)v << 16); }

#define XB_TMO      128
#define XB_XCNT(j)  (256  + 64 * (j))
#define XB_XSUB(j)  (1280 + 64 * (j))
#define XB_XGEN(j)  (2304 + 64 * (j))
#define XB_TOP      3328
#define XB_TOPGEN   3392
#define XCD_BAR_WORDS 3456
#define XB_SPIN_CAP (1u << 18)

__device__ __forceinline__ unsigned xb_ld(unsigned* p)              { return __hip_atomic_load(p, __ATOMIC_RELAXED, __HIP_MEMORY_SCOPE_AGENT); }
__device__ __forceinline__ unsigned xb_add(unsigned* p, unsigned v) { return __hip_atomic_fetch_add(p, v, __ATOMIC_RELAXED, __HIP_MEMORY_SCOPE_AGENT); }
__device__ __forceinline__ unsigned xb_xcc_id() { return (unsigned)__builtin_amdgcn_s_getreg((3 << 11) | 20) & 0xFu; }
#define XB_SPIN(cond, bar) do { unsigned _sp = 0; while (cond) { __builtin_amdgcn_s_sleep(1); \
    if ((++_sp & 255u) == 0u) { if (xb_ld(&(bar)[XB_TMO])) break; if (_sp > XB_SPIN_CAP) { atomicAdd(&(bar)[XB_TMO], 1u); break; } } } } while (0)

struct XcdBarrier {
    unsigned* bar; unsigned x;
    volatile LAS unsigned* st;
};

__device__ __forceinline__ XcdBarrier xcd_barrier_post(unsigned* bar, volatile LAS unsigned* st) {
    XcdBarrier b; b.bar = bar; b.x = xb_xcc_id(); b.st = st;
    if (threadIdx.x == 0) (void)xb_add(&bar[XB_XCNT(b.x)], 1u);
    return b;
}
__device__ __forceinline__ void xcd_barrier_complete(unsigned* bar, unsigned x, unsigned& nloc, unsigned& nx) {
    const unsigned G = gridDim.x * gridDim.y * gridDim.z;
    unsigned sum, cnt, mine, sp = 0u;
    for (;;) {
        sum = 0u; cnt = 0u; mine = 0u;
#pragma unroll
        for (unsigned j = 0; j < 16; ++j) { const unsigned c = xb_ld(&bar[XB_XCNT(j)]); sum += c; cnt += (c > 0u) ? 1u : 0u; mine = (j == x) ? c : mine; }
        if (sum == G) break;
        __builtin_amdgcn_s_sleep(1);
        if ((++sp & 255u) == 0u) { if (xb_ld(&bar[XB_TMO])) break; if (sp > XB_SPIN_CAP) { atomicAdd(&bar[XB_TMO], 1u); break; } }
    }
    nloc = mine > 0u ? mine : 1u; nx = cnt > 0u ? cnt : 1u;
}

__device__ __forceinline__ void xcd_barrier(const XcdBarrier& b) {
    asm volatile("s_waitcnt vmcnt(0)" ::: "memory");
    __syncthreads();
    if (threadIdx.x == 0) {
        unsigned* bar = b.bar;
        __builtin_amdgcn_s_waitcnt(0);
        unsigned nloc = b.st[0], nx = b.st[1];
        if (nloc == 0u) { xcd_barrier_complete(bar, b.x, nloc, nx); b.st[0] = nloc; b.st[1] = nx; }
        const unsigned old = xb_add(&bar[XB_XSUB(b.x)], 1u);
        const unsigned gen = old / nloc;
        if (old + 1u == (gen + 1u) * nloc) {
            __builtin_amdgcn_fence(__ATOMIC_RELEASE, "agent");
            asm volatile("s_waitcnt vmcnt(0)" ::: "memory");
            const unsigned og = xb_add(&bar[XB_TOP], 1u);
            const unsigned tg = og / nx;
            if (og + 1u == (tg + 1u) * nx) xb_add(&bar[XB_TOPGEN], 1u);
            else XB_SPIN(xb_ld(&bar[XB_TOPGEN]) == tg, bar);
            __builtin_amdgcn_fence(__ATOMIC_ACQUIRE, "agent");
            xb_add(&bar[XB_XGEN(b.x)], 1u);
            asm volatile("s_waitcnt vmcnt(0)" ::: "memory");
        } else {
            XB_SPIN(xb_ld(&bar[XB_XGEN(b.x)]) == gen, bar);
            __builtin_amdgcn_fence(__ATOMIC_ACQUIRE, "agent");
            asm volatile("s_waitcnt vmcnt(0)" ::: "memory");
        }
    }
    __syncthreads();
}

__device__ __forceinline__ unsigned long long rfl64(unsigned long long v) { const unsigned lo = __builtin_amdgcn_readfirstlane((unsigned)v), hi = __builtin_amdgcn_readfirstlane((unsigned)(v >> 32)); return ((unsigned long long)hi << 32) | lo; }
struct Args { const float* in[21]; float* out; unsigned char* ws; int ph_lo, ph_hi; };
struct Frame {
    LAS unsigned char* lds; int tid, lane, wave, G, bid, gw, ngw;
    float* H; unsigned char* ws;
    __device__ __forceinline__ const float* in(int k) const { return (const float*)(uintptr_t)rfl64(((LAS unsigned long long*)(lds + PTR_OFF))[k]); }
};
__device__ __forceinline__ float wave_sum(float v) {
#pragma unroll
    for (int o = 1; o < 64; o <<= 1) v += __shfl_xor(v, o);
    return v;
}
__device__ __forceinline__ float sigmoidf_(float x) { return 1.0f / (1.0f + expf(-x)); }

__host__ __device__ __forceinline__ int in_src_col(int nb) {
    const int T = nb >> 3, r = nb & 7;
    if (T < 3) { const int bj = r >> 2, g = 4 * T + (r & 3); return (g < 6 ? C_QA + 64 * g : C_KA + 64 * (g - 6)) + 32 * bj; }
    if (T < 5) { const int bj = r >> 2; return C_UC + 256 * bj + 128 * (T - 3) + 32 * (r & 3); }
    if (T < 10) { const int bj = r >> 2, g = 4 * (T - 5) + (r & 3); if (g >= 18) return -1; return (g < 6 ? C_QR + 64 * g : (g < 12 ? C_KR + 64 * (g - 6) : C_GR + 64 * (g - 12))) + 32 * bj; }
    { const int g = 4 * (T - 10) + (r >> 1); if (g >= 18) return -1; return (g < 6 ? C_VA + 64 * g : (g < 12 ? C_VR + 64 * (g - 6) : C_KR + 64 * (g - 12))) + 32 * (r & 1); }
}
__device__ __forceinline__ void transpose_item(const float* W, int K, int N, const float* gain, bf16* WT, LAS float* scr, int k0, int n0src, int n0dst, int lane) {
    if (n0src >= 0) {
#pragma unroll 8
        for (int i = 0; i < 32; ++i) { const int kk = 2 * i + (lane >> 5); float v = W[(size_t)(k0 + kk) * N + n0src + (lane & 31)]; if (gain) v *= gain[k0 + kk]; scr[kk * 33 + (lane & 31)] = v; }
    } else {
#pragma unroll 8
        for (int i = 0; i < 32; ++i) scr[(2 * i + (lane >> 5)) * 33 + (lane & 31)] = 0.f;
    }
    LDS_WAIT(); asm volatile("" ::: "memory");
    const int c = lane & 7;
#pragma unroll
    for (int j = 0; j < 4; ++j) { const int n = (lane >> 3) + 8 * j; const LAS float* s = scr + (8 * c) * 33 + n;
        v4u o; o.x = pk2(s[0 * 33], s[1 * 33]); o.y = pk2(s[2 * 33], s[3 * 33]); o.z = pk2(s[4 * 33], s[5 * 33]); o.w = pk2(s[6 * 33], s[7 * 33]);
        *(GAS v4u*)(WT + (size_t)(n0dst + n) * K + k0 + 8 * c) = o; }
    LDS_WAIT(); asm volatile("" ::: "memory");
}
__device__ __forceinline__ void convert_layer(Frame& F, int L) {
    bf16* WB = (bf16*)(F.ws + WS_WBUF + (size_t)(L & 1) * WBUF_BYTES);
    LAS float* scr = (LAS float*)(F.lds + RING_OFF + F.wave * 16384);
    const float* w_in = F.in(3) + (size_t)L * 1024 * D_IN; const float* w_o = F.in(14) + (size_t)L * 1024 * 1024; const float* w1 = F.in(16) + (size_t)L * 1024 * 4096;
    const float* w2 = F.in(17) + (size_t)L * 4096 * 1024; const float* w_pg = F.in(19) + (size_t)L * 1024 * 1024; const float* w_ple = F.in(20) + (size_t)L * 256 * 1024;
    const float* pw = F.in(11) + (size_t)L * 256 * 256;
    const float* g_mix = F.in(2) + L * 1024; const float* g_ffn = F.in(15) + L * 1024; const float* g_ple = F.in(18) + L * 1024;
    constexpr int I_IN = 16 * (NIN_ROWS / 32), I_O = 16 * 32, I_1 = 16 * 128, I_2 = 64 * 32, I_PG = 16 * 32, I_PLE = 4 * 32, I_PW = 4 * 8;
    constexpr int NIT = I_IN + I_O + I_1 + I_2 + I_PG + I_PLE + I_PW;
    for (int it = F.gw; it < NIT; it += F.ngw) {
        int r = it;
        if (r < I_IN) { const int nb = r % (NIN_ROWS / 32), kb = r / (NIN_ROWS / 32); transpose_item(w_in, 1024, D_IN, g_mix, WB + WO_WIN, scr, 64 * kb, in_src_col(nb), 32 * nb, F.lane); continue; } r -= I_IN;
        if (r < I_O) { transpose_item(w_o, 1024, 1024, nullptr, WB + WO_WO, scr, 64 * (r / 32), 32 * (r % 32), 32 * (r % 32), F.lane); continue; } r -= I_O;
        if (r < I_1) { transpose_item(w1, 1024, 4096, g_ffn, WB + WO_W1, scr, 64 * (r / 128), 32 * (r % 128), 32 * (r % 128), F.lane); continue; } r -= I_1;
        if (r < I_2) { transpose_item(w2, 4096, 1024, nullptr, WB + WO_W2, scr, 64 * (r / 32), 32 * (r % 32), 32 * (r % 32), F.lane); continue; } r -= I_2;
        if (r < I_PG) { transpose_item(w_pg, 1024, 1024, g_ple, WB + WO_WPG, scr, 64 * (r / 32), 32 * (r % 32), 32 * (r % 32), F.lane); continue; } r -= I_PG;
        if (r < I_PLE) { transpose_item(w_ple, 256, 1024, nullptr, WB + WO_WPLE, scr, 64 * (r / 32), 32 * (r % 32), 32 * (r % 32), F.lane); continue; } r -= I_PLE;
        transpose_item(pw, 256, 256, nullptr, WB + WO_PW, scr, 64 * (r / 8), 32 * (r % 8), 32 * (r % 8), F.lane);
    }
}
__device__ __forceinline__ void sincos_acc(float ang, float& s, float& c) {
    const double x = (double)ang; const double kd = rint(x * 0.63661977236758134);
    const double r = (x - kd * 1.5707963267948966) - kd * 6.123233995736766e-17; const int q = ((int)kd) & 3; const double r2 = r * r;
    const double sp = r * (1.0 + r2 * (-1.0 / 6 + r2 * (1.0 / 120 + r2 * (-1.0 / 5040 + r2 * (1.0 / 362880 + r2 * (-1.0 / 39916800))))));
    const double cp = 1.0 + r2 * (-0.5 + r2 * (1.0 / 24 + r2 * (-1.0 / 720 + r2 * (1.0 / 40320 + r2 * (-1.0 / 3628800 + r2 * (1.0 / 479001600))))));
    double ss, cc;
    if (q == 0) { ss = sp; cc = cp; } else if (q == 1) { ss = cp; cc = -sp; } else if (q == 2) { ss = -sp; cc = -cp; } else { ss = -cp; cc = sp; }
    s = (float)ss; c = (float)cc;
}
__device__ __forceinline__ float log_gamma(int h) { return logf(1.0f - exp2f(-5.0f - (float)h)); }
__device__ __forceinline__ void prologue(Frame& F) {
    convert_layer(F, 0);
    const float* x = F.in(0); bf16* HB = (bf16*)(F.ws + WS_HB); float* SS = (float*)(F.ws + WS_SS);
    for (int m = F.gw; m < M; m += F.ngw) {
        const GAS f32x4* xr = (const GAS f32x4*)(x + (size_t)m * 1024) + F.lane; GAS f32x4* hr = (GAS f32x4*)(F.H + (size_t)m * 1024) + F.lane;
        GAS unsigned long long* o8 = (GAS unsigned long long*)(HB + (size_t)m * 1024) + F.lane; float s = 0.f;
#pragma unroll
        for (int j = 0; j < 4; ++j) { const f32x4 v = xr[64 * j]; hr[64 * j] = v; s += (v.x * v.x + v.y * v.y) + (v.z * v.z + v.w * v.w);
            o8[64 * j] = (unsigned long long)pk2(v.x, v.y) | ((unsigned long long)pk2(v.z, v.w) << 32); }
        s = wave_sum(s);
        if (F.lane < 16) SS[(size_t)m * 16 + F.lane] = F.lane == 0 ? s : 0.f;
    }
    { float2* cs = (float2*)(F.ws + WS_CS); float2* cst = (float2*)(F.ws + WS_CST);
      for (int idx = F.bid * 512 + F.tid; idx < SEQ * 32; idx += F.G * 512) { const int pos = idx >> 5, i = idx & 31; const float inv_freq = powf(10000.0f, -(float)(2 * i) / 64.0f);
          float s, c; sincos_acc((float)pos * inv_freq, s, c); cs[idx] = make_float2(c, s); cst[i * SEQ + pos] = make_float2(c, s); } }
    { float* bt = (float*)(F.ws + WS_BT); const float* rbp = F.in(6);
      for (int idx = F.bid * 512 + F.tid; idx < DEPTH * H_ATT * 6 * 1024; idx += F.G * 512) { const int reg = idx & 15, ln = (idx >> 4) & 63, di = (idx >> 10) % 6, lh = idx / 6144;
          int rel = 32 * di - 32 + (ln & 31) - ((reg & 3) + 8 * (reg >> 2) + 4 * (ln >> 5)); rel = rel < -REL_CLIP ? -REL_CLIP : (rel > REL_CLIP ? REL_CLIP : rel);
          bt[idx] = rbp[lh * 257 + rel + REL_CLIP] * 1.4426950408889634f; } }
    { float* dk = (float*)(F.ws + WS_DK);
      for (int idx = F.bid * 512 + F.tid; idx < H_RET * 64; idx += F.G * 512) dk[idx] = expf(log_gamma(idx >> 6) * (float)(63 - (idx & 63))); }
}
__device__ __forceinline__ void convert_p(Frame& F, int L) {
    const GAS f32x4* p4 = (const GAS f32x4*)(F.in(1) + (size_t)L * M * D_PLE); GAS unsigned long long* o8 = (GAS unsigned long long*)(F.ws + WS_PB); const int n4 = M * D_PLE / 4;
    for (int i = F.bid * 512 + F.tid; i < n4; i += F.G * 512) { const f32x4 v = p4[i]; o8[i] = (unsigned long long)pk2(v.x, v.y) | ((unsigned long long)pk2(v.z, v.w) << 32); }
}
typedef float f32x16 __attribute__((ext_vector_type(16)));
typedef short bf16x8 __attribute__((ext_vector_type(8)));
typedef unsigned u32x2 __attribute__((ext_vector_type(2)));
#define MFMA32(a, b, c) __builtin_amdgcn_mfma_f32_32x32x16_bf16((a), (b), (c), 0, 0, 0)
constexpr float LOG2E = 1.4426950408889634f;
__device__ __forceinline__ int crow(int r, int hi) { return (r & 3) + 8 * (r >> 2) + 4 * hi; }
typedef float f32x2_t __attribute__((ext_vector_type(2))); typedef __bf16 bf16x2_t __attribute__((ext_vector_type(2)));
__device__ __forceinline__ unsigned cvtpk(float lo, float hi) { f32x2_t v = {lo, hi}; bf16x2_t b = __builtin_convertvector(v, bf16x2_t); return __builtin_bit_cast(unsigned, b); }
template <int T8> __device__ __forceinline__ bf16x8 packfrag(const f32x16& x) {
    v4u p; p.x = cvtpk(x[8 * T8 + 0], x[8 * T8 + 1]); p.y = cvtpk(x[8 * T8 + 2], x[8 * T8 + 3]); p.z = cvtpk(x[8 * T8 + 4], x[8 * T8 + 5]); p.w = cvtpk(x[8 * T8 + 6], x[8 * T8 + 7]);
    return __builtin_bit_cast(bf16x8, p);
}
__device__ __forceinline__ f32x16 splat16(float v) { f32x16 r;
#pragma unroll
    for (int i = 0; i < 16; ++i) r[i] = v;
    return r; }
__device__ __forceinline__ float ex2(float x) { return __builtin_amdgcn_exp2f(x); }
constexpr size_t FRAG_T = 6291456;
__device__ __forceinline__ const bf16x8* ftok(const bf16* base, int bh, int blk, int lane) { return (const bf16x8*)(base + ((size_t)(bh * 64 + blk) * 4) * 512) + lane; }
__device__ __forceinline__ const bf16x8* fdim(const bf16* base, int bh, int kb16, int lane) { return (const bf16x8*)(base + ((size_t)(bh * 128 + kb16) * 2) * 512) + lane; }

__device__ __forceinline__ void attn_unit(const bf16* QF, const bf16* KF, const bf16* VF, const float* BT, const float* rb, bf16* MIX, int b, int h, int n, int qh, int lane) {
    const int bh = b * 6 + h, hi = lane >> 5, q = lane & 31;
    bf16x8 qf[4];
    { const bf16x8* qp = ftok(QF, bh, n * 2 + qh, lane);
#pragma unroll
      for (int s = 0; s < 4; ++s) qf[s] = qp[64 * s]; }
    f32x16 o0 = splat16(0.f), o1 = splat16(0.f); float mrun = -1e30f, lsum = 0.f;
    const float cbias = rb[h * 257 + 256] * LOG2E;
    const int c0 = n - 8 < 0 ? 0 : n - 8;
    for (int c = c0; c <= n; ++c) {
        f32x16 p0, p1;
        { const int D = 64 * (n - c) + 32 * qh;
          if (D >= 160) p0 = splat16(cbias); else { const f32x4* bp = (const f32x4*)(BT + ((size_t)(h * 6 + ((D + 32) >> 5)) * 64 + lane) * 16);
              const f32x4 t0 = bp[0], t1 = bp[1], t2 = bp[2], t3 = bp[3];
#pragma unroll
              for (int i = 0; i < 4; ++i) { p0[i] = t0[i]; p0[4 + i] = t1[i]; p0[8 + i] = t2[i]; p0[12 + i] = t3[i]; } }
          const bf16x8* kp = ftok(KF, bh, c * 2, lane);
#pragma unroll
          for (int s = 0; s < 4; ++s) p0 = MFMA32(kp[64 * s], qf[s], p0); }
        { const int D = 64 * (n - c) + 32 * (qh - 1);
          if (D >= 160) p1 = splat16(cbias); else { const f32x4* bp = (const f32x4*)(BT + ((size_t)(h * 6 + ((D + 32) >> 5)) * 64 + lane) * 16);
              const f32x4 t0 = bp[0], t1 = bp[1], t2 = bp[2], t3 = bp[3];
#pragma unroll
              for (int i = 0; i < 4; ++i) { p1[i] = t0[i]; p1[4 + i] = t1[i]; p1[8 + i] = t2[i]; p1[12 + i] = t3[i]; } }
          const bf16x8* kp = ftok(KF, bh, c * 2 + 1, lane);
#pragma unroll
          for (int s = 0; s < 4; ++s) p1 = MFMA32(kp[64 * s], qf[s], p1); }
        float rm = fmaxf(p0[0], p1[0]);
#pragma unroll
        for (int r = 1; r < 16; ++r) rm = fmaxf(rm, fmaxf(p0[r], p1[r]));
        rm = fmaxf(rm, __shfl_xor(rm, 32));
        const float mn = fmaxf(mrun, rm), alpha = ex2(mrun - mn); mrun = mn;
        float ps = 0.f;
#pragma unroll
        for (int r = 0; r < 16; ++r) { p0[r] = ex2(p0[r] - mn); p1[r] = ex2(p1[r] - mn); ps += p0[r] + p1[r]; }
        lsum = lsum * alpha + ps;
#pragma unroll
        for (int r = 0; r < 16; ++r) { o0[r] *= alpha; o1[r] *= alpha; }
        { const bf16x8* vp = fdim(VF, bh, 4 * c, lane);
          bf16x8 pf;
          pf = packfrag<0>(p0); o0 = MFMA32(vp[0], pf, o0);   o1 = MFMA32(vp[64], pf, o1);
          pf = packfrag<1>(p0); o0 = MFMA32(vp[128], pf, o0); o1 = MFMA32(vp[192], pf, o1);
          pf = packfrag<0>(p1); o0 = MFMA32(vp[256], pf, o0); o1 = MFMA32(vp[320], pf, o1);
          pf = packfrag<1>(p1); o0 = MFMA32(vp[384], pf, o0); o1 = MFMA32(vp[448], pf, o1); }
    }
    lsum += __shfl_xor(lsum, 32);
    const float inv = 1.0f / lsum;
    bf16* op = MIX + (size_t)(b * SEQ + n * CHUNK + qh * 32 + q) * 1024 + h * 64 + 4 * hi;
#pragma unroll
    for (int g = 0; g < 4; ++g) { u32x2 w;
        w.x = cvtpk(o0[4 * g] * inv, o0[4 * g + 1] * inv); w.y = cvtpk(o0[4 * g + 2] * inv, o0[4 * g + 3] * inv); *(u32x2*)(op + 8 * g) = w;
        w.x = cvtpk(o1[4 * g] * inv, o1[4 * g + 1] * inv); w.y = cvtpk(o1[4 * g + 2] * inv, o1[4 * g + 3] * inv); *(u32x2*)(op + 32 + 8 * g) = w; }
}
__device__ __forceinline__ void rkv_unit(const bf16* VFr, const bf16* KTr, float* KV, int bh, int n, int lane) {
    f32x16 a00 = splat16(0.f), a01 = splat16(0.f), a10 = splat16(0.f), a11 = splat16(0.f);
    const bf16x8* vp = fdim(VFr, bh, 4 * n, lane); const bf16x8* kp = fdim(KTr, bh, 4 * n, lane);
#pragma unroll
    for (int s = 0; s < 4; ++s) { const bf16x8 v0 = vp[128 * s], v1 = vp[128 * s + 64], k0 = kp[128 * s], k1 = kp[128 * s + 64];
        a00 = MFMA32(v0, k0, a00); a01 = MFMA32(v0, k1, a01); a10 = MFMA32(v1, k0, a10); a11 = MFMA32(v1, k1, a11); }
    float* out = KV + ((size_t)(bh * 32 + n)) * 4096 + (lane & 31); const int hi = lane >> 5;
#pragma unroll
    for (int r = 0; r < 16; ++r) { const int e = crow(r, hi);
        out[e * 64] = a00[r]; out[e * 64 + 32] = a01[r]; out[(e + 32) * 64] = a10[r]; out[(e + 32) * 64 + 32] = a11[r]; }
}
__device__ __forceinline__ void scan_unit(float* KV, int bh, int sl, float dec, int lane) {
    f32x4 s0 = {0.f, 0.f, 0.f, 0.f}, s1 = s0; float* p = KV + (size_t)bh * 32 * 4096 + sl * 512 + lane * 8;
#pragma unroll 4
    for (int n = 0; n < 32; ++n) { const f32x4 x0 = *(const f32x4*)(p + (size_t)n * 4096), x1 = *(const f32x4*)(p + (size_t)n * 4096 + 4);
        *(f32x4*)(p + (size_t)n * 4096) = s0; *(f32x4*)(p + (size_t)n * 4096 + 4) = s1; s0 = s0 * dec + x0; s1 = s1 * dec + x1; }
}
__device__ __forceinline__ void rout_unit(const bf16* QFr, const bf16* KFr, const bf16* VFr, const float* KV, const bf16* G, const float* gn_g, bf16* MIX, int b, int h, int n, int ch, int lane) {
    const int bh = b * 6 + h, hi = lane >> 5, cq = lane & 31, cc = 32 * ch + cq;
    const float lg2 = log2f(1.0f - exp2f(-5.0f - (float)h));
    bf16x8 qf[4];
    { const bf16x8* qp = ftok(QFr, bh, n * 2 + ch, lane);
#pragma unroll
      for (int s = 0; s < 4; ++s) qf[s] = qp[64 * s]; }
    f32x16 s0 = splat16(0.f), s1 = splat16(0.f);
    { const bf16x8* kp = ftok(KFr, bh, n * 2, lane);
#pragma unroll
      for (int s = 0; s < 4; ++s) { s0 = MFMA32(kp[64 * s], qf[s], s0); s1 = MFMA32(kp[256 + 64 * s], qf[s], s1); } }
#pragma unroll
    for (int r = 0; r < 16; ++r) { const int m0 = crow(r, hi); const int d0 = cc - m0, d1 = cc - m0 - 32;
        s0[r] *= ex2(lg2 * (float)(d0 < 0 ? -d0 : d0)); s1[r] *= ex2(lg2 * (float)(d1 < 0 ? -d1 : d1)); }
    f32x16 o0 = splat16(0.f), o1 = splat16(0.f);
    { const float* st = KV + ((size_t)(bh * 32 + n)) * 4096 + cq * 64 + 8 * hi;
#pragma unroll
      for (int s = 0; s < 4; ++s) {
          const f32x4 x0 = *(const f32x4*)(st + 16 * s), x1 = *(const f32x4*)(st + 16 * s + 4), y0 = *(const f32x4*)(st + 2048 + 16 * s), y1 = *(const f32x4*)(st + 2048 + 16 * s + 4);
          v4u fa, fb; fa.x = cvtpk(x0[0], x0[1]); fa.y = cvtpk(x0[2], x0[3]); fa.z = cvtpk(x1[0], x1[1]); fa.w = cvtpk(x1[2], x1[3]);
          fb.x = cvtpk(y0[0], y0[1]); fb.y = cvtpk(y0[2], y0[3]); fb.z = cvtpk(y1[0], y1[1]); fb.w = cvtpk(y1[2], y1[3]);
          o0 = MFMA32(__builtin_bit_cast(bf16x8, fa), qf[s], o0); o1 = MFMA32(__builtin_bit_cast(bf16x8, fb), qf[s], o1); } }
    { const float qd = ex2(lg2 * (float)(cc + 1));
#pragma unroll
      for (int r = 0; r < 16; ++r) { o0[r] *= qd; o1[r] *= qd; } }
    { const bf16x8* vp = fdim(VFr, bh, 4 * n, lane); bf16x8 pf;
      pf = packfrag<0>(s0); o0 = MFMA32(vp[0], pf, o0);   o1 = MFMA32(vp[64], pf, o1);
      pf = packfrag<1>(s0); o0 = MFMA32(vp[128], pf, o0); o1 = MFMA32(vp[192], pf, o1);
      pf = packfrag<0>(s1); o0 = MFMA32(vp[256], pf, o0); o1 = MFMA32(vp[320], pf, o1);
      pf = packfrag<1>(s1); o0 = MFMA32(vp[384], pf, o0); o1 = MFMA32(vp[448], pf, o1); }
    float sm = 0.f;
#pragma unroll
    for (int r = 0; r < 16; ++r) sm += o0[r] + o1[r];
    sm += __shfl_xor(sm, 32); const float mu = sm * (1.0f / 64.0f);
    float vr = 0.f;
#pragma unroll
    for (int r = 0; r < 16; ++r) { o0[r] -= mu; o1[r] -= mu; vr += o0[r] * o0[r] + o1[r] * o1[r]; }
    vr += __shfl_xor(vr, 32); const float rstd = rsqrtf(vr * (1.0f / 64.0f) + EPS);
    const size_t token = (size_t)b * SEQ + n * CHUNK + cc;
    const bf16* gp = G + token * 384 + h * 64 + 4 * hi; const float* gg = gn_g + h * 64 + 4 * hi; bf16* op = MIX + token * 1024 + D_ATT + D_CONV + h * 64 + 4 * hi;
#pragma unroll
    for (int g = 0; g < 4; ++g) {
        { const u32x2 gw = *(const u32x2*)(gp + 8 * g); const f32x4 gn = *(const f32x4*)(gg + 8 * g); u32x2 w;
          w.x = cvtpk(o0[4 * g] * rstd * gn[0] * __uint_as_float(gw.x << 16), o0[4 * g + 1] * rstd * gn[1] * __uint_as_float(gw.x & 0xffff0000u));
          w.y = cvtpk(o0[4 * g + 2] * rstd * gn[2] * __uint_as_float(gw.y << 16), o0[4 * g + 3] * rstd * gn[3] * __uint_as_float(gw.y & 0xffff0000u)); *(u32x2*)(op + 8 * g) = w; }
        { const u32x2 gw = *(const u32x2*)(gp + 32 + 8 * g); const f32x4 gn = *(const f32x4*)(gg + 32 + 8 * g); u32x2 w;
          w.x = cvtpk(o1[4 * g] * rstd * gn[0] * __uint_as_float(gw.x << 16), o1[4 * g + 1] * rstd * gn[1] * __uint_as_float(gw.x & 0xffff0000u));
          w.y = cvtpk(o1[4 * g + 2] * rstd * gn[2] * __uint_as_float(gw.y << 16), o1[4 * g + 3] * rstd * gn[3] * __uint_as_float(gw.y & 0xffff0000u)); *(u32x2*)(op + 32 + 8 * g) = w; }
    }
}
__device__ __forceinline__ void conv_unit(Frame& F, int L, int unit, const bf16* GLU, const bf16* PWT, bf16* MIX) {
    const float* cw = F.in(7) + L * CONV_K * 256; const float* cb = F.in(8) + L * 256; const float* lng = F.in(9) + L * 256; const float* lnb = F.in(10) + L * 256; const float* pwb = F.in(12) + L * 256;
    LAS unsigned char* lds = F.lds + RING_OFF; LAS float* Y = (LAS float*)(lds + 49152);
    const int t0 = unit * 64, s0 = t0 & 2047, tid = F.tid, lane = F.lane, w = F.wave;
    for (int i = tid; i < 94 * 32; i += 512) { const int r = i >> 5, c16 = i & 31; v4u v = {0u, 0u, 0u, 0u};
        if (s0 - 30 + r >= 0) v = *(const v4u*)(GLU + (size_t)(t0 - 30 + r) * 256 + c16 * 8);
        *(LAS v4u*)(lds + r * 512 + c16 * 16) = v; }
    __syncthreads();
    { const int cp = tid & 127, tg = tid >> 7;
      float w0[31], w1[31];
#pragma unroll
      for (int j = 0; j < 31; ++j) { const float2 ww = *(const float2*)(cw + j * 256 + 2 * cp); w0[j] = ww.x; w1[j] = ww.y; }
      unsigned win[46];
#pragma unroll
      for (int i = 0; i < 46; ++i) win[i] = *(const LAS unsigned*)(lds + (tg * 16 + i) * 512 + cp * 4);
      const float2 bb = *(const float2*)(cb + 2 * cp);
#pragma unroll
      for (int tt = 0; tt < 16; ++tt) { float a0 = bb.x, a1 = bb.y;
#pragma unroll
          for (int j = 0; j < 31; ++j) { a0 = fmaf(__uint_as_float(win[tt + j] << 16), w0[j], a0); a1 = fmaf(__uint_as_float(win[tt + j] & 0xffff0000u), w1[j], a1); }
          *(LAS f32x2_t*)(Y + (tg * 16 + tt) * 256 + 2 * cp) = (f32x2_t){a0, a1}; } }
    __syncthreads();
    { const f32x4 gg = *(const f32x4*)(lng + 4 * lane), bt = *(const f32x4*)(lnb + 4 * lane);
#pragma unroll 2
      for (int tk = 0; tk < 8; ++tk) { const int t = 8 * w + tk; f32x4 v = *(const LAS f32x4*)(Y + t * 256 + 4 * lane);
          const float mu = wave_sum((v.x + v.y) + (v.z + v.w)) * (1.f / 256.f); v = v - mu;
          const float r = rsqrtf(wave_sum((v.x * v.x + v.y * v.y) + (v.z * v.z + v.w * v.w)) * (1.f / 256.f) + EPS);
          f32x4 o = v * r * gg + bt; o.x *= sigmoidf_(o.x); o.y *= sigmoidf_(o.y); o.z *= sigmoidf_(o.z); o.w *= sigmoidf_(o.w);
          u32x2 pk; pk.x = cvtpk(o.x, o.y); pk.y = cvtpk(o.z, o.w);
          *(LAS u32x2*)(lds + ((((t >> 5) * 16 + (lane >> 2)) * 64 + ((lane >> 1) & 1) * 32 + (t & 31)) * 16 + 8 * (lane & 1))) = pk; } }
    __syncthreads();
    { const int hi = lane >> 5; f32x16 a0 = splat16(0.f), a1 = splat16(0.f);
      const bf16* ap = PWT + (size_t)(32 * w + (lane & 31)) * 256 + 8 * hi;
#pragma unroll 4
      for (int s = 0; s < 16; ++s) { const bf16x8 A = *(const bf16x8*)(ap + 16 * s);
          const bf16x8 B0 = *(const LAS bf16x8*)(lds + (s * 64 + lane) * 16), B1 = *(const LAS bf16x8*)(lds + ((16 + s) * 64 + lane) * 16);
          a0 = MFMA32(A, B0, a0); a1 = MFMA32(A, B1, a1); }
      bf16* op = MIX + (size_t)(t0 + (lane & 31)) * 1024 + D_ATT + 32 * w + 4 * hi; const float* bp = pwb + 32 * w + 4 * hi;
#pragma unroll
      for (int g = 0; g < 4; ++g) { const f32x4 bv = *(const f32x4*)(bp + 8 * g); u32x2 x;
          x.x = cvtpk(a0[4 * g] + bv[0], a0[4 * g + 1] + bv[1]); x.y = cvtpk(a0[4 * g + 2] + bv[2], a0[4 * g + 3] + bv[3]); *(u32x2*)(op + 8 * g) = x;
          x.x = cvtpk(a1[4 * g] + bv[0], a1[4 * g + 1] + bv[1]); x.y = cvtpk(a1[4 * g + 2] + bv[2], a1[4 * g + 3] + bv[3]); *(u32x2*)(op + 32 * 1024 + 8 * g) = x; } }
    __syncthreads();
}

template <int SUB> __device__ __forceinline__ void layer_phase(Frame& F, const int L) {
    bf16* HBP = (bf16*)(F.ws + WS_HB + (size_t)(L & 1) * HB_BYTES); bf16* HBQ = (bf16*)(F.ws + WS_HB + (size_t)((L + 1) & 1) * HB_BYTES);
    float* SS0 = (float*)(F.ws + WS_SS); float* SS1 = SS0 + (size_t)M * 16; float* SS2 = SS1 + (size_t)M * 16;
    bf16* PJ = (bf16*)(F.ws + WS_PROJ); bf16* MIX = (bf16*)(F.ws + WS_MIX);
    bf16 *QFa = PJ, *KFa = PJ + FRAG_T, *VFa = PJ + 2 * FRAG_T, *QFr = PJ + 3 * FRAG_T, *KFr = PJ + 4 * FRAG_T, *KTr = PJ + 5 * FRAG_T, *VFr = PJ + 6 * FRAG_T, *GG = PJ + 7 * FRAG_T, *GLU = PJ + 8 * FRAG_T;
    bf16* HID = (bf16*)(F.ws + WS_HID); bf16* PLE = (bf16*)(F.ws + WS_PLE); float* KV = (float*)(F.ws + WS_KV);
    const bf16* WB = (const bf16*)(F.ws + WS_WBUF + (size_t)(L & 1) * WBUF_BYTES);
    if constexpr (SUB == 0) {
        pg8::InProjOrder S; S.init(M, NIN_ROWS, 1024, F.G, F.bid, HBP, WB + WO_WIN);
        pg8::EpiInProj E{{QFa, KFa, VFa, QFr, KFr, KTr, VFr, GG, GLU, SS0, F.in(4) + L * 64, F.in(5) + L * 64, (const float*)(F.ws + WS_CS), (const float*)(F.ws + WS_CST), (const float*)(F.ws + WS_DK)}};
        pg8::gemm_phase<pg8::EpiInProj, pg8::InProjOrder, true, true>(F.lds + RING_OFF, 1024, S, E, F.tid);
    } else if constexpr (SUB == 1) {
        for (int u = F.bid; u < M / 64; u += F.G) conv_unit(F, L, u, GLU, WB + WO_PW, MIX);
        for (int u = F.gw; u < BATCH * H_RET * NC; u += F.ngw) rkv_unit(VFr, KTr, KV, u >> 5, u & 31, F.lane);
        { const float* bt = (const float*)(F.ws + WS_BT) + (size_t)L * H_ATT * 6 * 1024; const float* rb = F.in(6) + L * H_ATT * 257;
          for (int u = F.gw; u < BATCH * H_ATT * NC * 2; u += F.ngw) { const int qh = u & 1, n = (u >> 1) & 31, bh = u >> 6; attn_unit(QFa, KFa, VFa, bt, rb, MIX, bh / 6, bh % 6, n, qh, F.lane); } }
        convert_p(F, L);
        if (L + 1 < DEPTH) convert_layer(F, L + 1);
    } else if constexpr (SUB == 2) {
        for (int u = F.gw; u < BATCH * H_RET * 8; u += F.ngw) scan_unit(KV, u >> 3, u & 7, expf(log_gamma((u >> 3) % 6) * 64.0f), F.lane);
    } else if constexpr (SUB == 3) {
        const float* gn = F.in(13) + L * D_RET;
        for (int u = F.gw; u < BATCH * H_RET * NC * 2; u += F.ngw) { const int ch = u & 1, n = (u >> 1) & 31, bh = u >> 6; rout_unit(QFr, KFr, VFr, KV, GG, gn, MIX, bh / 6, bh % 6, n, ch, F.lane); }
    } else if constexpr (SUB == 4) {
        pg8::StaticOrder S; S.init(M, 1024, 1024, F.G, F.bid, MIX, WB + WO_WO);
        pg8::EpiRes<false> E{F.H, HBQ, SS1, nullptr, nullptr};
        pg8::gemm_phase<pg8::EpiRes<false>, pg8::StaticOrder, false, true>(F.lds + RING_OFF, 1024, S, E, F.tid);
    } else if constexpr (SUB == 5) {
        pg8::StaticOrder S; S.init(M, 4096, 1024, F.G, F.bid, HBQ, WB + WO_W1);
        pg8::EpiBf16<1, true> E{HID, 4096, SS1};
        pg8::gemm_phase<pg8::EpiBf16<1, true>, pg8::StaticOrder, true, true>(F.lds + RING_OFF, 1024, S, E, F.tid);
    } else if constexpr (SUB == 6) {
        pg8::StaticOrder S; S.init(M, 1024, 4096, F.G, F.bid, HID, WB + WO_W2);
        pg8::EpiRes<false> E{F.H, HBP, SS2, nullptr, nullptr};
        pg8::gemm_phase<pg8::EpiRes<false>, pg8::StaticOrder, false, true>(F.lds + RING_OFF, 4096, S, E, F.tid);
    } else {
        { pg8::StaticOrder S; S.init(M, 1024, 256, F.G, F.bid, (const bf16*)(F.ws + WS_PB), WB + WO_WPLE);
          pg8::EpiBf16<0, false> E{PLE, 1024, nullptr};
          pg8::gemm_phase<pg8::EpiBf16<0, false>, pg8::StaticOrder, false, true>(F.lds + RING_OFF, 256, S, E, F.tid); }
        __syncthreads();
        { pg8::StaticOrder S; S.init(M, 1024, 1024, F.G, F.bid, HBP, WB + WO_WPG);
          pg8::EpiRes<true> E{F.H, HBQ, SS0, SS2, PLE};
          pg8::gemm_phase<pg8::EpiRes<true>, pg8::StaticOrder, false, true>(F.lds + RING_OFF, 1024, S, E, F.tid); }
    }
}
constexpr int PH_PER_LAYER = 8, N_PHASES = 1 + PH_PER_LAYER * DEPTH;
__global__ void __launch_bounds__(NWAVES * 64, 2) mk_fwd(Args args) {
    extern __shared__ __attribute__((aligned(16))) unsigned char lds[];
    LAS unsigned char* const ldsb = (LAS unsigned char*)lds;
    for (int u = threadIdx.x; u < (LDS_BYTES - LDSCTL_OFF) / 4; u += NWAVES * 64) ((LAS unsigned*)(ldsb + LDSCTL_OFF))[u] = 0u;
    __syncthreads();
    if (threadIdx.x == 0) {
        LAS unsigned long long* P = (LAS unsigned long long*)(ldsb + PTR_OFF);
#pragma unroll
        for (int i = 0; i < 21; ++i) P[i] = (unsigned long long)(uintptr_t)args.in[i];
        P[21] = (unsigned long long)(uintptr_t)args.out; P[22] = (unsigned long long)(uintptr_t)args.ws;
    }
    __syncthreads();
    XcdBarrier bar; { unsigned char* ws0 = args.ws; bar.bar = (unsigned*)(ws0 + WS_CTL) + CW_BAR; bar.x = 0; bar.st = nullptr;
    const bool multi = (args.ph_hi - args.ph_lo) > 1;
    if (multi) bar = xcd_barrier_post((unsigned*)(ws0 + WS_CTL) + CW_BAR, (volatile LAS unsigned*)(ldsb + MISC_OFF) + 8); }
    const int lo = args.ph_lo, hi = args.ph_hi;
    const int wave0 = __builtin_amdgcn_readfirstlane(threadIdx.x >> 6);
#define FRAME_INIT() \
        int wv_ = wave0, bid_ = blockIdx.x; asm volatile("" : "+s"(wv_)); asm volatile("" : "+s"(bid_)); \
        int tid_ = wv_ * 64 + (int)__builtin_amdgcn_mbcnt_hi(~0u, __builtin_amdgcn_mbcnt_lo(~0u, 0u)); \
        Frame F; F.lds = ldsb; F.tid = tid_; F.lane = tid_ & 63; F.wave = __builtin_amdgcn_readfirstlane(tid_ >> 6); \
        F.G = gridDim.x; F.bid = bid_; F.gw = F.bid * NWAVES + F.wave; F.ngw = F.G * NWAVES; \
        { LAS unsigned long long* P = (LAS unsigned long long*)(ldsb + PTR_OFF); \
          F.H = (float*)(uintptr_t)rfl64(P[21]); F.ws = (unsigned char*)(uintptr_t)rfl64(P[22]); }
#define GRID_BAR() do { XcdBarrier b2; b2.bar = (unsigned*)(F.ws + WS_CTL) + CW_BAR; b2.x = xb_xcc_id(); b2.st = (volatile LAS unsigned*)(F.lds + MISC_OFF) + 8; xcd_barrier(b2); } while (0)
#define RUN_PHASE(ph, call) if (lo <= (ph) && (ph) < hi) { FRAME_INIT(); call; if ((ph) + 1 < hi) GRID_BAR(); }
    RUN_PHASE(0, prologue(F))
#define RUN_LAYER(L) \
    RUN_PHASE(1 + 8 * (L) + 0, (layer_phase<0>(F, (L)))) RUN_PHASE(1 + 8 * (L) + 1, (layer_phase<1>(F, (L)))) RUN_PHASE(1 + 8 * (L) + 2, (layer_phase<2>(F, (L)))) \
    RUN_PHASE(1 + 8 * (L) + 3, (layer_phase<3>(F, (L)))) RUN_PHASE(1 + 8 * (L) + 4, (layer_phase<4>(F, (L)))) RUN_PHASE(1 + 8 * (L) + 5, (layer_phase<5>(F, (L)))) \
    RUN_PHASE(1 + 8 * (L) + 6, (layer_phase<6>(F, (L)))) RUN_PHASE(1 + 8 * (L) + 7, (layer_phase<7>(F, (L))))
    RUN_LAYER(0) RUN_LAYER(1) RUN_LAYER(2) RUN_LAYER(3)
}

extern "C" void kernel_launch(void* const* d_in, const int* in_sizes, int n_in, void* d_out, int out_size, void* d_ws, size_t ws_size, hipStream_t stream) {
    static int grid = 0;
    if (grid == 0) {
        if (n_in != 21 || out_size != M * D_MODEL || ws_size < WS_END) { fprintf(stderr, "kernel_launch: unexpected shapes / workspace (%d inputs, out %d, ws %zu)\n", n_in, out_size, ws_size); grid = -1; return; }
        int dev = 0, cus = 0, per_cu = 0;
        if (hipGetDevice(&dev) != hipSuccess || hipDeviceGetAttribute(&cus, hipDeviceAttributeMultiprocessorCount, dev) != hipSuccess) { grid = -1; return; }
        if (hipFuncSetAttribute((const void*)mk_fwd, hipFuncAttributeMaxDynamicSharedMemorySize, LDS_BYTES) != hipSuccess) { fprintf(stderr, "kernel_launch: hipFuncSetAttribute failed\n"); grid = -1; return; }
        if (hipOccupancyMaxActiveBlocksPerMultiprocessor(&per_cu, (const void*)mk_fwd, NWAVES * 64, LDS_BYTES) != hipSuccess || per_cu < 1) { fprintf(stderr, "kernel_launch: occupancy query says %d\n", per_cu); per_cu = 1; }
        (void)hipGetLastError();
        grid = cus;
    }
    if (grid < 0) return;
    if (hipMemsetAsync((char*)d_ws + WS_CTL, 0, CTL_ZERO_BYTES, stream) != hipSuccess) return;
    Args a{};
    for (int i = 0; i < 21; ++i) a.in[i] = (const float*)d_in[i];
    a.out = (float*)d_out; a.ws = (unsigned char*)d_ws;
#if MK_PER_PHASE
    for (int ph = 0; ph < N_PHASES; ++ph) { a.ph_lo = ph; a.ph_hi = ph + 1; hipLaunchKernelGGL(mk_fwd, dim3(grid), dim3(NWAVES * 64), LDS_BYTES, stream, a); }
#else
    a.ph_lo = 0; a.ph_hi = N_PHASES;
    void* kargs[] = {&a};
    hipError_t e = hipLaunchCooperativeKernel((const void*)mk_fwd, dim3(grid), dim3(NWAVES * 64), kargs, LDS_BYTES, stream);
    if (e != hipSuccess) fprintf(stderr, "kernel_launch: cooperative launch failed: %s (grid %d)\n", hipGetErrorString(e), grid);
#endif
}
```

```cpp
#include <hip/hip_runtime.h>
#include <cstdio>
#include <cstdint>

#ifndef MK_PER_PHASE
#define MK_PER_PHASE 0
#endif

namespace pg8 {
#define PG8_LAS __attribute__((address_space(3)))
typedef unsigned short bf16_t;
typedef short bf16x8 __attribute__((ext_vector_type(8)));
typedef float f32x4 __attribute__((ext_vector_type(4)));
typedef unsigned u32x4 __attribute__((ext_vector_type(4)));
constexpr int BM = 256, BK = 64, HALF = 128, HTB = HALF * BK * 2, STAGE_BYTES = 8 * HTB, NXCD = 8, WGM = 8;
__host__ __device__ __forceinline__ int lds_byte(int r, int c) { const int st = (r >> 4) * 2 + (c >> 5), rr = r & 15, cc = c & 31, ob = rr * 64 + cc * 2; return st * 1024 + (ob ^ (((ob >> 9) & 1) << 5)); }
__host__ __device__ __forceinline__ void stage_rc(int b, int& R, int& C) { const int st = b / 1024, sb = b % 1024, swz = sb ^ (((sb >> 9) & 1) << 5); R = (st >> 1) * 16 + swz / 64; C = (st & 1) * 32 + (swz % 64) / 2; }
__host__ __device__ __forceinline__ int perm32(int rho) { const int n = rho >> 4, i = rho & 15; return 8 * (i >> 2) + 4 * n + (i & 3); }
struct Unit { int pm, pn; };
struct StaticOrder {
    int nM, nN, nwg, G, c; const char* A; const char* Bt; size_t tstep;
    __device__ void init(int M, int N, int K, int G_, int c_, const void* A_, const void* Bt_) { nM = M / BM; nN = N / BM; nwg = nM * nN; G = G_; c = c_; A = (const char*)A_; Bt = (const char*)Bt_; tstep = (size_t)BM * K * 2; }
    __device__ bool next(int i, Unit& u) const {
        const long L = (long)i * G + c; if (L >= nwg) return false;
        int wgid = (int)L; { const int q = nwg / NXCD, r = nwg % NXCD, xcd = wgid % NXCD, off = wgid / NXCD; wgid = (xcd < r ? xcd * (q + 1) : r * (q + 1) + (xcd - r) * q) + off; }
        const int nig = WGM * nN, gid = wgid / nig, fm = gid * WGM, gsz = (nM - fm) < WGM ? (nM - fm) : WGM;
        u.pm = fm + ((wgid % nig) % gsz); u.pn = (wgid % nig) / gsz; return true;
    }
    __device__ __forceinline__ const char* a_ptr(const Unit& u) const { return A + (size_t)u.pm * tstep; }
    __device__ __forceinline__ const char* b_ptr(const Unit& u) const { return Bt + (size_t)u.pn * tstep; }
    __device__ __forceinline__ void a_ready(const Unit&) const {}
    __device__ __forceinline__ void done(const Unit&) const {}
};
__device__ __forceinline__ unsigned cvt_pk_bf16(float lo, float hi) { unsigned r; asm volatile("v_cvt_pk_bf16_f32 %0, %1, %2" : "=v"(r) : "v"(lo), "v"(hi)); return r; }
__device__ __forceinline__ u32x4 pack8(f32x4 v0, f32x4 v1) { u32x4 w; w.x = cvt_pk_bf16(v0[0], v0[1]); w.y = cvt_pk_bf16(v0[2], v0[3]); w.z = cvt_pk_bf16(v1[0], v1[1]); w.w = cvt_pk_bf16(v1[2], v1[3]); return w; }
__device__ __forceinline__ float bfl(unsigned w) { return __uint_as_float(w << 16); }
__device__ __forceinline__ float bfh(unsigned w) { return __uint_as_float(w & 0xffff0000u); }

__device__ __forceinline__ float row_rstd(const float* SS, int row) {
    const f32x4* p = (const f32x4*)(SS + (size_t)row * 16); const f32x4 a = p[0], b = p[1], c = p[2], d = p[3];
    const float s = ((a[0] + a[1]) + (a[2] + a[3])) + ((b[0] + b[1]) + (b[2] + b[3])) + ((c[0] + c[1]) + (c[2] + c[3])) + ((d[0] + d[1]) + (d[2] + d[3]));
    return rsqrtf(s * (1.0f / 1024.0f) + 1e-6f);
}
template <int ACT, bool SCALE> struct EpiBf16 {
    static constexpr bool PERM = true, AFTER_DRAIN = false;
    bf16_t* O; int ldc; const float* SS;
    __device__ __forceinline__ void operator()(const f32x4 (&acc)[2][2][4][2], const Unit& u, int wr, int wc, int fr, int fq) const {
#pragma unroll
        for (int ai = 0; ai < 2; ++ai)
#pragma unroll
            for (int m = 0; m < 4; ++m) { const int row = u.pm * BM + ai * HALF + wr * 64 + m * 16 + fr; const float r = SCALE ? row_rstd(SS, row) : 1.0f;
#pragma unroll
                for (int bj = 0; bj < 2; ++bj) { const int col = u.pn * BM + bj * HALF + wc * 32 + 8 * fq; f32x4 v0 = acc[ai][bj][m][0] * r, v1 = acc[ai][bj][m][1] * r;
                    if (ACT == 1) {
#pragma unroll
                        for (int j = 0; j < 4; ++j) { const float a = fmaxf(v0[j], 0.f), b = fmaxf(v1[j], 0.f); v0[j] = a * a; v1[j] = b * b; } }
                    *(u32x4*)(O + (size_t)row * ldc + col) = pack8(v0, v1); } }
    }
};
struct EpiBias {
    static constexpr bool PERM = true, AFTER_DRAIN = false;
    bf16_t* O; int ldc; const float* bias;
    __device__ __forceinline__ void operator()(const f32x4 (&acc)[2][2][4][2], const Unit& u, int wr, int wc, int fr, int fq) const {
#pragma unroll
        for (int ai = 0; ai < 2; ++ai)
#pragma unroll
            for (int m = 0; m < 4; ++m) { const int row = u.pm * BM + ai * HALF + wr * 64 + m * 16 + fr;
#pragma unroll
                for (int bj = 0; bj < 2; ++bj) { const int col = u.pn * BM + bj * HALF + wc * 32 + 8 * fq; const f32x4 b0 = *(const f32x4*)(bias + col), b1 = *(const f32x4*)(bias + col + 4);
                    *(u32x4*)(O + (size_t)row * ldc + col) = pack8(acc[ai][bj][m][0] + b0, acc[ai][bj][m][1] + b1); } }
    }
};
template <bool GATE> struct EpiRes {
    static constexpr bool PERM = true, AFTER_DRAIN = false;
    float* H; bf16_t* HB; float* SSout; const float* SSin; const bf16_t* PLE;
    __device__ __forceinline__ void operator()(const f32x4 (&acc)[2][2][4][2], const Unit& u, int wr, int wc, int fr, int fq) const {
#pragma unroll
        for (int ai = 0; ai < 2; ++ai)
#pragma unroll
            for (int m = 0; m < 4; ++m) { const int row = u.pm * BM + ai * HALF + wr * 64 + m * 16 + fr; float ssq = 0.f; const float r = GATE ? row_rstd(SSin, row) : 1.0f;
#pragma unroll
                for (int bj = 0; bj < 2; ++bj) { const int col = u.pn * BM + bj * HALF + wc * 32 + 8 * fq; float* hp = H + (size_t)row * 1024 + col;
                    f32x4 v0 = acc[ai][bj][m][0], v1 = acc[ai][bj][m][1];
                    if (GATE) { const u32x4 pw = *(const u32x4*)(PLE + (size_t)row * 1024 + col);
                        const f32x4 p0 = {bfl(pw.x), bfh(pw.x), bfl(pw.y), bfh(pw.y)}, p1 = {bfl(pw.z), bfh(pw.z), bfl(pw.w), bfh(pw.w)};
#pragma unroll
                        for (int j = 0; j < 4; ++j) { v0[j] = p0[j] / (1.0f + __expf(-v0[j] * r)); v1[j] = p1[j] / (1.0f + __expf(-v1[j] * r)); } }
                    v0 = v0 + *(const f32x4*)hp; v1 = v1 + *(const f32x4*)(hp + 4);
                    *(f32x4*)hp = v0; *(f32x4*)(hp + 4) = v1;
                    *(u32x4*)(HB + (size_t)row * 1024 + col) = pack8(v0, v1);
                    ssq += (v0[0] * v0[0] + v0[1] * v0[1]) + (v0[2] * v0[2] + v0[3] * v0[3]) + (v1[0] * v1[0] + v1[1] * v1[1]) + (v1[2] * v1[2] + v1[3] * v1[3]); }
                ssq += __shfl_xor(ssq, 16); ssq += __shfl_xor(ssq, 32);
                if (fq == 0) SSout[(size_t)row * 16 + u.pn * 4 + wc] = ssq; }
    }
};

typedef float f32x2v __attribute__((ext_vector_type(2)));
typedef unsigned u32x2 __attribute__((ext_vector_type(2)));
struct InProjOut {
    bf16_t *QFa, *KFa, *VFa, *QFr, *KFr, *KTr, *VFr, *G, *GLU;
    const float* SS; const float* qn_g; const float* kn_g; const float* CS; const float* CST; const float* DK;
};
struct InProjOrder : StaticOrder {
    __device__ __forceinline__ const char* a_ptr(const Unit& u) const { return u.pn < 10 ? A + (size_t)u.pm * tstep : Bt + (size_t)u.pn * tstep; }
    __device__ __forceinline__ const char* b_ptr(const Unit& u) const { return u.pn < 10 ? Bt + (size_t)u.pn * tstep : A + (size_t)u.pm * tstep; }
};
__device__ __forceinline__ float sigm(float x) { return 1.0f / (1.0f + __expf(-x)); }
__device__ __forceinline__ u32x2 pack4(f32x4 v) { u32x2 w; w.x = cvt_pk_bf16(v[0], v[1]); w.y = cvt_pk_bf16(v[2], v[3]); return w; }
struct EpiInProj {
    static constexpr bool PERM = true, AFTER_DRAIN = false;
    InProjOut o;
    __device__ __forceinline__ void operator()(const f32x4 (&acc)[2][2][4][2], const Unit& u, int wr, int wc, int fr, int fq) const {
        asm volatile("" : "+v"(fr), "+v"(fq));
        const int T = u.pn;
        if (T < 10) {
            int kind, head;
            if (T < 3) { const int g = 4 * T + wc; kind = g < 6 ? 0 : 1; head = g < 6 ? g : g - 6; }
            else if (T < 5) { kind = 2; head = 0; }
            else { const int g = 4 * (T - 5) + wc; kind = g < 6 ? 3 : (g < 12 ? 4 : (g < 18 ? 5 : 6)); head = g % 6; }
            if (kind == 6) return;
#pragma unroll
            for (int ai = 0; ai < 2; ++ai)
#pragma unroll
                for (int m = 0; m < 4; ++m) {
                    const int token = u.pm * BM + ai * HALF + wr * 64 + m * 16 + fr; const float rstd = row_rstd(o.SS, token);
                    const int bb = token >> 11, s = token & 2047;
                    f32x4 a0 = acc[ai][0][m][0] * rstd, a1 = acc[ai][0][m][1] * rstd, b0 = acc[ai][1][m][0] * rstd, b1 = acc[ai][1][m][1] * rstd;
                    if (kind == 0 || kind == 1) {
                        float ss = (a0[0] * a0[0] + a0[1] * a0[1]) + (a0[2] * a0[2] + a0[3] * a0[3]) + (a1[0] * a1[0] + a1[1] * a1[1]) + (a1[2] * a1[2] + a1[3] * a1[3])
                                 + (b0[0] * b0[0] + b0[1] * b0[1]) + (b0[2] * b0[2] + b0[3] * b0[3]) + (b1[0] * b1[0] + b1[1] * b1[1]) + (b1[2] * b1[2] + b1[3] * b1[3]);
                        ss += __shfl_xor(ss, 16); ss += __shfl_xor(ss, 32);
                        const float r2 = rsqrtf(ss * (1.0f / 64.0f) + 1e-6f) * (kind == 0 ? 0.125f * 1.4426950408889634f : 1.0f);
                        const float* gp = (kind == 0 ? o.qn_g : o.kn_g) + 8 * fq;
                        const f32x4 g0 = *(const f32x4*)gp, g1 = *(const f32x4*)(gp + 4), g2 = *(const f32x4*)(gp + 32), g3 = *(const f32x4*)(gp + 36);
                        bf16_t* base = (kind == 0 ? o.QFa : o.KFa) + ((size_t)((bb * 6 + head) * 64 + (s >> 5)) * 4 + (fq >> 1)) * 512 + ((fq & 1) * 32 + (s & 31)) * 8;
                        *(u32x4*)base = pack8(a0 * g0 * r2, a1 * g1 * r2); *(u32x4*)(base + 1024) = pack8(b0 * g2 * r2, b1 * g3 * r2);
                    } else if (kind == 3 || kind == 4) {
                        const float sc = kind == 3 ? 0.125f : 1.0f;
                        const f32x4* cp = (const f32x4*)(o.CS + (size_t)s * 64 + 16 * fq);
                        const f32x4 c0 = cp[0], c1 = cp[1], c2 = cp[2], c3 = cp[3];
                        f32x4 x0, x1, y0, y1;
                        x0[0] = (a0[0] * c0[0] - b0[0] * c0[1]) * sc; y0[0] = (a0[0] * c0[1] + b0[0] * c0[0]) * sc; x0[1] = (a0[1] * c0[2] - b0[1] * c0[3]) * sc; y0[1] = (a0[1] * c0[3] + b0[1] * c0[2]) * sc;
                        x0[2] = (a0[2] * c1[0] - b0[2] * c1[1]) * sc; y0[2] = (a0[2] * c1[1] + b0[2] * c1[0]) * sc; x0[3] = (a0[3] * c1[2] - b0[3] * c1[3]) * sc; y0[3] = (a0[3] * c1[3] + b0[3] * c1[2]) * sc;
                        x1[0] = (a1[0] * c2[0] - b1[0] * c2[1]) * sc; y1[0] = (a1[0] * c2[1] + b1[0] * c2[0]) * sc; x1[1] = (a1[1] * c2[2] - b1[1] * c2[3]) * sc; y1[1] = (a1[1] * c2[3] + b1[1] * c2[2]) * sc;
                        x1[2] = (a1[2] * c3[0] - b1[2] * c3[1]) * sc; y1[2] = (a1[2] * c3[1] + b1[2] * c3[0]) * sc; x1[3] = (a1[3] * c3[2] - b1[3] * c3[3]) * sc; y1[3] = (a1[3] * c3[3] + b1[3] * c3[2]) * sc;
                        bf16_t* base = (kind == 3 ? o.QFr : o.KFr) + ((size_t)((bb * 6 + head) * 64 + (s >> 5)) * 4 + (fq >> 1)) * 512 + ((fq & 1) * 32 + (s & 31)) * 8;
                        *(u32x4*)base = pack8(x0, x1); *(u32x4*)(base + 1024) = pack8(y0, y1);
                    } else if (kind == 5) {
#pragma unroll
                        for (int j = 0; j < 4; ++j) { a0[j] *= sigm(a0[j]); a1[j] *= sigm(a1[j]); b0[j] *= sigm(b0[j]); b1[j] *= sigm(b1[j]); }
                        bf16_t* base = o.G + (size_t)token * 384 + head * 64 + 8 * fq;
                        *(u32x4*)base = pack8(a0, a1); *(u32x4*)(base + 32) = pack8(b0, b1);
                    } else {
#pragma unroll
                        for (int j = 0; j < 4; ++j) { a0[j] *= sigm(b0[j]); a1[j] *= sigm(b1[j]); }
                        *(u32x4*)(o.GLU + (size_t)token * 256 + 128 * (T - 3) + 32 * wc + 8 * fq) = pack8(a0, a1);
                    }
                }
        } else {
#pragma unroll
            for (int bj = 0; bj < 2; ++bj) {
                const int tok0 = u.pm * BM + bj * HALF + wc * 32 + 8 * fq, bb = tok0 >> 11, s0 = tok0 & 2047, kb16 = s0 >> 4, uu = (s0 >> 3) & 1;
                f32x4 rs0, rs1;
#pragma unroll
                for (int j = 0; j < 4; ++j) { rs0[j] = row_rstd(o.SS, tok0 + j); rs1[j] = row_rstd(o.SS, tok0 + 4 + j); }
#pragma unroll
                for (int ai = 0; ai < 2; ++ai) {
                    const int g = 4 * (T - 10) + 2 * ai + wr;
                    if (g >= 18) continue;
                    const int head = g % 6, bh = bb * 6 + head;
                    if (g < 12) {
                        bf16_t* dst = (g < 6 ? o.VFa : o.VFr) + ((size_t)(bh * 128 + kb16) * 2) * 512 + 4 * uu;
#pragma unroll
                        for (int m = 0; m < 4; ++m) { bf16_t* p = dst + ((m >> 1) * 64 + 16 * (m & 1) + fr) * 8;
                            *(u32x2*)p = pack4(acc[ai][bj][m][0] * rs0); *(u32x2*)(p + 256) = pack4(acc[ai][bj][m][1] * rs1); }
                    } else {
                        bf16_t* dst = o.KTr + ((size_t)(bh * 128 + kb16) * 2) * 512 + 4 * uu;
                        const f32x4 dk0 = *(const f32x4*)(o.DK + head * 64 + (s0 & 63)), dk1 = *(const f32x4*)(o.DK + head * 64 + (s0 & 63) + 4);
#pragma unroll
                        for (int m = 0; m < 2; ++m) { const int i = 16 * m + fr;
                            const f32x4* cp = (const f32x4*)(o.CST + ((size_t)i * 2048 + s0) * 2);
                            const f32x4 c0 = cp[0], c1 = cp[1], c2 = cp[2], c3 = cp[3];
                            const f32x4 t10 = acc[ai][bj][m][0] * rs0, t11 = acc[ai][bj][m][1] * rs1, t20 = acc[ai][bj][m + 2][0] * rs0, t21 = acc[ai][bj][m + 2][1] * rs1;
                            f32x4 x0, x1, y0, y1;
                            x0[0] = (t10[0] * c0[0] - t20[0] * c0[1]) * dk0[0]; y0[0] = (t10[0] * c0[1] + t20[0] * c0[0]) * dk0[0]; x0[1] = (t10[1] * c0[2] - t20[1] * c0[3]) * dk0[1]; y0[1] = (t10[1] * c0[3] + t20[1] * c0[2]) * dk0[1];
                            x0[2] = (t10[2] * c1[0] - t20[2] * c1[1]) * dk0[2]; y0[2] = (t10[2] * c1[1] + t20[2] * c1[0]) * dk0[2]; x0[3] = (t10[3] * c1[2] - t20[3] * c1[3]) * dk0[3]; y0[3] = (t10[3] * c1[3] + t20[3] * c1[2]) * dk0[3];
                            x1[0] = (t11[0] * c2[0] - t21[0] * c2[1]) * dk1[0]; y1[0] = (t11[0] * c2[1] + t21[0] * c2[0]) * dk1[0]; x1[1] = (t11[1] * c2[2] - t21[1] * c2[3]) * dk1[1]; y1[1] = (t11[1] * c2[3] + t21[1] * c2[2]) * dk1[1];
                            x1[2] = (t11[2] * c3[0] - t21[2] * c3[1]) * dk1[2]; y1[2] = (t11[2] * c3[1] + t21[2] * c3[0]) * dk1[2]; x1[3] = (t11[3] * c3[2] - t21[3] * c3[3]) * dk1[3]; y1[3] = (t11[3] * c3[3] + t21[3] * c3[2]) * dk1[3];
                            bf16_t* p = dst + i * 8;
                            *(u32x2*)p = pack4(x0); *(u32x2*)(p + 256) = pack4(x1); *(u32x2*)(p + 512) = pack4(y0); *(u32x2*)(p + 512 + 256) = pack4(y1); }
                    }
                }
            }
        }
    }
};

template <class Epi, class Sched, bool ALIGN_EPI = false, bool SP2 = false>
__device__ __forceinline__ void gemm_phase(PG8_LAS unsigned char* lds, const int K, const Sched& S, const Epi& E, const int tid) {
    const int wid = __builtin_amdgcn_readfirstlane(tid >> 6), lane = tid & 63, wr = wid >> 2, wc = wid & 3, fr = lane & 15, fq = lane >> 4;
    const int nt = K / BK;
    unsigned voffA[2], voffB[2];
#pragma unroll
    for (int i = 0; i < 2; ++i) { int R, C; stage_rc(tid * 16 + i * 8192, R, C); const int Rb = Epi::PERM ? ((R & ~31) + perm32(R & 31)) : R;
        voffA[i] = (unsigned)(R * K + C) * 2u; voffB[i] = (unsigned)(Rb * K + C) * 2u; }
    const size_t kstep = (size_t)(BK * 2);
    const size_t hstep = (size_t)HALF * K * 2;
    const unsigned ldsw = (unsigned)wid * 1024u;
    const int aoff = lds_byte(wr * 64 + fr, fq * 8), boff = lds_byte(wc * 32 + fr, fq * 8);
#define PG8_SA(b, h) (((b) * 2 + (h)) * HTB)
#define PG8_SB(b, h) ((4 + (b) * 2 + (h)) * HTB)
#define PG8_STAGE(bufoff, gbase, voff) do { _Pragma("unroll") for (int _i = 0; _i < 2; ++_i) \
        __builtin_amdgcn_global_load_lds((const unsigned*)((const char*)(gbase) + (voff)[_i]), (PG8_LAS unsigned*)(lds + (bufoff) + ldsw + _i * 8192), 16, 0, 0); } while (0)
#define PG8_LDA(dst, b, h) do { _Pragma("unroll") for (int m = 0; m < 4; ++m) _Pragma("unroll") for (int k = 0; k < 2; ++k) dst[m][k] = *(const PG8_LAS bf16x8*)(lds + PG8_SA(b, h) + aoff + m * 2048 + k * 1024); } while (0)
#define PG8_LDB(dst, b, h) do { _Pragma("unroll") for (int n = 0; n < 2; ++n) _Pragma("unroll") for (int k = 0; k < 2; ++k) dst[n][k] = *(const PG8_LAS bf16x8*)(lds + PG8_SB(b, h) + boff + n * 2048 + k * 1024); } while (0)
#define PG8_MMA(ai, bj, At, Bt) do { __builtin_amdgcn_s_setprio(1); _Pragma("unroll") for (int m = 0; m < 4; ++m) _Pragma("unroll") for (int n = 0; n < 2; ++n) _Pragma("unroll") for (int k = 0; k < 2; ++k) \
        acc[ai][bj][m][n] = __builtin_amdgcn_mfma_f32_16x16x32_bf16(Bt[n][k], At[m][k], acc[ai][bj][m][n], 0, 0, 0); __builtin_amdgcn_s_setprio(0); } while (0)
#define PG8_WAIT_V(n) asm volatile("s_waitcnt vmcnt(" #n ")" ::: "memory")
#define PG8_WAIT_L(n) asm volatile("s_waitcnt lgkmcnt(" #n ")" ::: "memory")
#define PG8_BAR __builtin_amdgcn_s_barrier()
#define PG8_SCHED __builtin_amdgcn_sched_barrier(0)
    Unit cur, nxt; int ui = 0;
    if (!S.next(0, cur)) return;
    f32x4 acc[2][2][4][2];
#pragma unroll
    for (int a = 0; a < 2; ++a)
#pragma unroll
        for (int b = 0; b < 2; ++b)
#pragma unroll
            for (int m = 0; m < 4; ++m)
#pragma unroll
                for (int n = 0; n < 2; ++n) acc[a][b][m][n] = (f32x4){0.f, 0.f, 0.f, 0.f};
    bf16x8 At[4][2], B0[2][2], B1[2][2];
    const char* cA = S.a_ptr(cur); const char* cB = S.b_ptr(cur);
    S.a_ready(cur);
    if constexpr (SP2) {
        PG8_STAGE(PG8_SB(0, 0), cB, voffB); PG8_STAGE(PG8_SB(0, 1), cB + hstep, voffB); PG8_STAGE(PG8_SA(0, 0), cA, voffA); PG8_STAGE(PG8_SA(0, 1), cA + hstep, voffA);
        if (wr == 1) PG8_BAR;
        PG8_WAIT_V(2); PG8_BAR;
        PG8_STAGE(PG8_SB(1, 0), cB + kstep, voffB); PG8_STAGE(PG8_SA(1, 0), cA + kstep, voffA); PG8_STAGE(PG8_SB(1, 1), cB + hstep + kstep, voffB);
        PG8_WAIT_V(6); PG8_BAR;
    } else {
        PG8_STAGE(PG8_SB(0, 0), cB, voffB); PG8_STAGE(PG8_SA(0, 0), cA, voffA); PG8_STAGE(PG8_SB(0, 1), cB + hstep, voffB); PG8_STAGE(PG8_SA(0, 1), cA + hstep, voffA);
        if (wr == 1) PG8_BAR;
        PG8_WAIT_V(4); PG8_BAR;
        PG8_STAGE(PG8_SB(1, 0), cB + kstep, voffB); PG8_STAGE(PG8_SA(1, 0), cA + kstep, voffA); PG8_STAGE(PG8_SB(1, 1), cB + hstep + kstep, voffB);
        PG8_WAIT_V(6); PG8_BAR;
    }
    for (;;) {
        const bool has_next = S.next(ui + 1, nxt);
        const char* nA = has_next ? S.a_ptr(nxt) : cA; const char* nB = has_next ? S.b_ptr(nxt) : cB;
        for (int t = 0; t < nt; t += 2) {
            const bool last = (t == nt - 2);
            const char* a1 = cA + (size_t)(t + 1) * kstep;
            const char* a2 = last ? nA : cA + (size_t)(t + 2) * kstep; const char* b2 = last ? nB : cB + (size_t)(t + 2) * kstep;
            const char* a3 = a2 + kstep; const char* b3 = b2 + kstep;
            if (last && has_next) S.a_ready(nxt);
            if constexpr (SP2) {
            PG8_LDB(B0, 0, 0); PG8_LDB(B1, 0, 1); PG8_SCHED; PG8_LDA(At, 0, 0); PG8_STAGE(PG8_SA(1, 1), a1 + hstep, voffA);
            PG8_WAIT_V(8); PG8_WAIT_L(0); PG8_BAR; PG8_MMA(0, 0, At, B0); PG8_MMA(0, 1, At, B1); PG8_BAR; PG8_SCHED;
            PG8_LDA(At, 0, 1); PG8_STAGE(PG8_SB(0, 0), b2, voffB); PG8_STAGE(PG8_SB(0, 1), b2 + hstep, voffB); PG8_STAGE(PG8_SA(0, 0), a2, voffA);
            PG8_WAIT_V(8); PG8_WAIT_L(0); PG8_BAR; PG8_MMA(1, 0, At, B0); PG8_MMA(1, 1, At, B1); PG8_BAR; PG8_SCHED;
            PG8_LDB(B0, 1, 0); PG8_LDB(B1, 1, 1); PG8_SCHED; PG8_LDA(At, 1, 0); PG8_STAGE(PG8_SA(0, 1), a2 + hstep, voffA);
            PG8_WAIT_V(8); PG8_WAIT_L(0); PG8_BAR; PG8_MMA(0, 0, At, B0); PG8_MMA(0, 1, At, B1); PG8_BAR; PG8_SCHED;
            PG8_LDA(At, 1, 1); PG8_STAGE(PG8_SB(1, 0), b3, voffB); PG8_STAGE(PG8_SB(1, 1), b3 + hstep, voffB); PG8_STAGE(PG8_SA(1, 0), a3, voffA);
            PG8_WAIT_V(8); PG8_WAIT_L(0); PG8_BAR; PG8_MMA(1, 0, At, B0); PG8_MMA(1, 1, At, B1); PG8_BAR; PG8_SCHED;
            } else {
            PG8_LDB(B0, 0, 0); PG8_SCHED; PG8_LDA(At, 0, 0); PG8_STAGE(PG8_SA(1, 1), a1 + hstep, voffA);
            PG8_WAIT_L(8); PG8_BAR; PG8_WAIT_L(0); PG8_MMA(0, 0, At, B0); PG8_BAR; PG8_SCHED;
            PG8_LDB(B1, 0, 1); PG8_STAGE(PG8_SB(0, 0), b2, voffB);
            PG8_BAR; PG8_WAIT_L(0); PG8_MMA(0, 1, At, B1); PG8_BAR;
            PG8_LDA(At, 0, 1); PG8_STAGE(PG8_SA(0, 0), a2, voffA);
            PG8_BAR; PG8_WAIT_L(0); PG8_MMA(1, 0, At, B0); PG8_BAR; PG8_SCHED;
            PG8_STAGE(PG8_SB(0, 1), b2 + hstep, voffB);
            PG8_WAIT_V(6); PG8_BAR; PG8_MMA(1, 1, At, B1); PG8_BAR;
            PG8_LDB(B0, 1, 0); PG8_SCHED; PG8_LDA(At, 1, 0); PG8_STAGE(PG8_SA(0, 1), a2 + hstep, voffA);
            PG8_WAIT_L(8); PG8_BAR; PG8_WAIT_L(0); PG8_MMA(0, 0, At, B0); PG8_BAR; PG8_SCHED;
            PG8_LDB(B1, 1, 1); PG8_STAGE(PG8_SB(1, 0), b3, voffB);
            PG8_BAR; PG8_WAIT_L(0); PG8_MMA(0, 1, At, B1); PG8_BAR;
            PG8_LDA(At, 1, 1); PG8_STAGE(PG8_SA(1, 0), a3, voffA);
            PG8_BAR; PG8_WAIT_L(0); PG8_MMA(1, 0, At, B0); PG8_BAR; PG8_SCHED;
            PG8_STAGE(PG8_SB(1, 1), b3 + hstep, voffB);
            PG8_WAIT_V(6); PG8_BAR; PG8_MMA(1, 1, At, B1); PG8_BAR;
            }
        }
        if constexpr (ALIGN_EPI) { if (wr == 0) PG8_BAR; }
        if constexpr (!Epi::AFTER_DRAIN) { E(acc, cur, wr, wc, fr, fq); S.done(cur); }
        if (!has_next) break;
#pragma unroll
        for (int a = 0; a < 2; ++a)
#pragma unroll
            for (int b = 0; b < 2; ++b)
#pragma unroll
                for (int m = 0; m < 4; ++m)
#pragma unroll
                    for (int n = 0; n < 2; ++n) acc[a][b][m][n] = (f32x4){0.f, 0.f, 0.f, 0.f};
        cur = nxt; cA = nA; cB = nB; ++ui;
        if constexpr (ALIGN_EPI) { if (wr == 1) PG8_BAR; }
    }
    PG8_WAIT_V(0);
    if constexpr (!ALIGN_EPI) { if (wr == 0) PG8_BAR; }
    PG8_BAR;
    if constexpr (Epi::AFTER_DRAIN) { E.fused(acc, cur, wr, wc, fr, fq, lds, wid, lane); S.done(cur); }
#undef PG8_SA
#undef PG8_SB
#undef PG8_STAGE
#undef PG8_LDA
#undef PG8_LDB
#undef PG8_MMA
#undef PG8_WAIT_V
#undef PG8_WAIT_L
#undef PG8_BAR
#undef PG8_SCHED
}
}

constexpr int D_MODEL = 1024, BATCH = 8, SEQ = 2048, DEPTH = 4, CHUNK = 64, NLEFT = 8, HD = 64;
constexpr int D_ATT = 384, D_RET = 384, D_CONV = 256, H_ATT = 6, H_RET = 6, CONV_K = 31, REL_CLIP = 128;
constexpr int D_FF = 4096, D_PLE = 256, D_IN = 3200, M = BATCH * SEQ, NC = SEQ / CHUNK;
constexpr int NIN_ROWS = 15 * 256;
constexpr float EPS = 1e-6f;
constexpr int C_QA = 0, C_KA = 384, C_VA = 768, C_UC = 1152, C_QR = 1664, C_KR = 2048, C_VR = 2432, C_GR = 2816;
constexpr int NWAVES = 8;

constexpr size_t MiB = 1u << 20;
constexpr size_t WS_CTL = 0, CTL_ZERO_BYTES = 1 * MiB;
constexpr size_t WS_SS = 1 * MiB;
constexpr size_t WS_WBUF = 4 * MiB, WBUF_BYTES = 29 * MiB;
constexpr size_t WS_HB = 62 * MiB, HB_BYTES = 32 * MiB;
constexpr size_t WS_PLE = 126 * MiB;
constexpr size_t WS_KV = 126 * MiB;
constexpr size_t WS_PROJ = 158 * MiB;
constexpr size_t WS_MIX = 262 * MiB;
constexpr size_t WS_HID = 158 * MiB;
constexpr size_t WS_PB = 294 * MiB;
constexpr size_t WS_CS = 302 * MiB;
constexpr size_t WS_CST = WS_CS + 512 * 1024;
constexpr size_t WS_BT = 303 * MiB;
constexpr size_t WS_DK = 304 * MiB;
constexpr size_t WS_END = 305 * MiB;
constexpr size_t WO_WIN = 0, WO_WO = WO_WIN + (size_t)NIN_ROWS * 1024, WO_W1 = WO_WO + 1024 * 1024, WO_W2 = WO_W1 + 4096 * 1024, WO_WPG = WO_W2 + 4096 * 1024,
                 WO_WPLE = WO_WPG + 1024 * 1024, WO_PW = WO_WPLE + 1024 * 256, WO_END = WO_PW + 256 * 256;
static_assert(WO_END * 2 <= WBUF_BYTES, "weight buffer");
constexpr int CW_BAR = 4096, CW_QUEUE = 8192;

constexpr int RING_OFF = 0, RING_BYTES = 131072;
constexpr int LDSCTL_OFF = RING_BYTES, MISC_OFF = LDSCTL_OFF + 320;
constexpr int LDS_BYTES = 147456, PTR_OFF = LDSCTL_OFF + 1024;

#define GAS __attribute__((address_space(1)))
#define LAS __attribute__((address_space(3)))
typedef unsigned short bf16;
typedef unsigned v4u __attribute__((ext_vector_type(4)));
typedef float f32x4 __attribute__((ext_vector_type(4)));
typedef GAS unsigned gu32;
#define LDS_WAIT() asm volatile("s_waitcnt lgkmcnt(0)" ::: "memory")
__device__ __forceinline__ unsigned f2bf(float f) { unsigned u = __builtin_bit_cast(unsigned, f); return (u + 0x7fffu + ((u >> 16) & 1u)) >> 16; }
__device__ __forceinline__ unsigned pk2(float lo, float hi) { return f2bf(lo) | (f2bf(hi) << 16); }
__device__ __forceinline__ float bf2f(bf16 v) { return __uint_as_float((unsigned)v << 16); }

#define XB_TMO      128
#define XB_XCNT(j)  (256  + 64 * (j))
#define XB_XSUB(j)  (1280 + 64 * (j))
#define XB_XGEN(j)  (2304 + 64 * (j))
#define XB_TOP      3328
#define XB_TOPGEN   3392
#define XCD_BAR_WORDS 3456
#define XB_SPIN_CAP (1u << 18)

__device__ __forceinline__ unsigned xb_ld(unsigned* p)              { return __hip_atomic_load(p, __ATOMIC_RELAXED, __HIP_MEMORY_SCOPE_AGENT); }
__device__ __forceinline__ unsigned xb_add(unsigned* p, unsigned v) { return __hip_atomic_fetch_add(p, v, __ATOMIC_RELAXED, __HIP_MEMORY_SCOPE_AGENT); }
__device__ __forceinline__ unsigned xb_xcc_id() { return (unsigned)__builtin_amdgcn_s_getreg((3 << 11) | 20) & 0xFu; }
#define XB_SPIN(cond, bar) do { unsigned _sp = 0; while (cond) { __builtin_amdgcn_s_sleep(1); \
    if ((++_sp & 255u) == 0u) { if (xb_ld(&(bar)[XB_TMO])) break; if (_sp > XB_SPIN_CAP) { atomicAdd(&(bar)[XB_TMO], 1u); break; } } } } while (0)

struct XcdBarrier {
    unsigned* bar; unsigned x;
    volatile LAS unsigned* st;
};

__device__ __forceinline__ XcdBarrier xcd_barrier_post(unsigned* bar, volatile LAS unsigned* st) {
    XcdBarrier b; b.bar = bar; b.x = xb_xcc_id(); b.st = st;
    if (threadIdx.x == 0) (void)xb_add(&bar[XB_XCNT(b.x)], 1u);
    return b;
}
__device__ __forceinline__ void xcd_barrier_complete(unsigned* bar, unsigned x, unsigned& nloc, unsigned& nx) {
    const unsigned G = gridDim.x * gridDim.y * gridDim.z;
    unsigned sum, cnt, mine, sp = 0u;
    for (;;) {
        sum = 0u; cnt = 0u; mine = 0u;
#pragma unroll
        for (unsigned j = 0; j < 16; ++j) { const unsigned c = xb_ld(&bar[XB_XCNT(j)]); sum += c; cnt += (c > 0u) ? 1u : 0u; mine = (j == x) ? c : mine; }
        if (sum == G) break;
        __builtin_amdgcn_s_sleep(1);
        if ((++sp & 255u) == 0u) { if (xb_ld(&bar[XB_TMO])) break; if (sp > XB_SPIN_CAP) { atomicAdd(&bar[XB_TMO], 1u); break; } }
    }
    nloc = mine > 0u ? mine : 1u; nx = cnt > 0u ? cnt : 1u;
}

__device__ __forceinline__ void xcd_barrier(const XcdBarrier& b) {
    asm volatile("s_waitcnt vmcnt(0)" ::: "memory");
    __syncthreads();
    if (threadIdx.x == 0) {
        unsigned* bar = b.bar;
        __builtin_amdgcn_s_waitcnt(0);
        unsigned nloc = b.st[0], nx = b.st[1];
        if (nloc == 0u) { xcd_barrier_complete(bar, b.x, nloc, nx); b.st[0] = nloc; b.st[1] = nx; }
        const unsigned old = xb_add(&bar[XB_XSUB(b.x)], 1u);
        const unsigned gen = old / nloc;
        if (old + 1u == (gen + 1u) * nloc) {
            __builtin_amdgcn_fence(__ATOMIC_RELEASE, "agent");
            asm volatile("s_waitcnt vmcnt(0)" ::: "memory");
            const unsigned og = xb_add(&bar[XB_TOP], 1u);
            const unsigned tg = og / nx;
            if (og + 1u == (tg + 1u) * nx) xb_add(&bar[XB_TOPGEN], 1u);
            else XB_SPIN(xb_ld(&bar[XB_TOPGEN]) == tg, bar);
            __builtin_amdgcn_fence(__ATOMIC_ACQUIRE, "agent");
            xb_add(&bar[XB_XGEN(b.x)], 1u);
            asm volatile("s_waitcnt vmcnt(0)" ::: "memory");
        } else {
            XB_SPIN(xb_ld(&bar[XB_XGEN(b.x)]) == gen, bar);
            __builtin_amdgcn_fence(__ATOMIC_ACQUIRE, "agent");
            asm volatile("s_waitcnt vmcnt(0)" ::: "memory");
        }
    }
    __syncthreads();
}

__device__ __forceinline__ unsigned long long rfl64(unsigned long long v) { const unsigned lo = __builtin_amdgcn_readfirstlane((unsigned)v), hi = __builtin_amdgcn_readfirstlane((unsigned)(v >> 32)); return ((unsigned long long)hi << 32) | lo; }
struct Args { const float* in[21]; float* out; unsigned char* ws; int ph_lo, ph_hi; };
struct Frame {
    LAS unsigned char* lds; int tid, lane, wave, G, bid, gw, ngw;
    float* H; unsigned char* ws;
    __device__ __forceinline__ const float* in(int k) const { return (const float*)(uintptr_t)rfl64(((LAS unsigned long long*)(lds + PTR_OFF))[k]); }
};
__device__ __forceinline__ float wave_sum(float v) {
#pragma unroll
    for (int o = 1; o < 64; o <<= 1) v += __shfl_xor(v, o);
    return v;
}
__device__ __forceinline__ float sigmoidf_(float x) { return 1.0f / (1.0f + expf(-x)); }

__host__ __device__ __forceinline__ int in_src_col(int nb) {
    const int T = nb >> 3, r = nb & 7;
    if (T < 3) { const int bj = r >> 2, g = 4 * T + (r & 3); return (g < 6 ? C_QA + 64 * g : C_KA + 64 * (g - 6)) + 32 * bj; }
    if (T < 5) { const int bj = r >> 2; return C_UC + 256 * bj + 128 * (T - 3) + 32 * (r & 3); }
    if (T < 10) { const int bj = r >> 2, g = 4 * (T - 5) + (r & 3); if (g >= 18) return -1; return (g < 6 ? C_QR + 64 * g : (g < 12 ? C_KR + 64 * (g - 6) : C_GR + 64 * (g - 12))) + 32 * bj; }
    { const int g = 4 * (T - 10) + (r >> 1); if (g >= 18) return -1; return (g < 6 ? C_VA + 64 * g : (g < 12 ? C_VR + 64 * (g - 6) : C_KR + 64 * (g - 12))) + 32 * (r & 1); }
}
__device__ __forceinline__ void transpose_item(const float* W, int K, int N, const float* gain, bf16* WT, LAS float* scr, int k0, int n0src, int n0dst, int lane) {
    if (n0src >= 0) {
        float v[32];
#pragma unroll
        for (int i = 0; i < 32; ++i) v[i] = W[(size_t)(k0 + 2 * i + (lane >> 5)) * N + n0src + (lane & 31)];
#pragma unroll
        for (int i = 0; i < 32; ++i) scr[(2 * i + (lane >> 5)) * 33 + (lane & 31)] = v[i];
    } else {
#pragma unroll 8
        for (int i = 0; i < 32; ++i) scr[(2 * i + (lane >> 5)) * 33 + (lane & 31)] = 0.f;
    }
    LDS_WAIT(); asm volatile("" ::: "memory");
    const int c = lane & 7;
    f32x4 g0 = {1.f, 1.f, 1.f, 1.f}, g1 = g0;
    if (gain) { g0 = *(const f32x4*)(gain + k0 + 8 * c); g1 = *(const f32x4*)(gain + k0 + 8 * c + 4); }
#pragma unroll
    for (int j = 0; j < 4; ++j) { const int n = (lane >> 3) + 8 * j; const LAS float* s = scr + (8 * c) * 33 + n;
        v4u o; o.x = pk2(s[0 * 33] * g0[0], s[1 * 33] * g0[1]); o.y = pk2(s[2 * 33] * g0[2], s[3 * 33] * g0[3]); o.z = pk2(s[4 * 33] * g1[0], s[5 * 33] * g1[1]); o.w = pk2(s[6 * 33] * g1[2], s[7 * 33] * g1[3]);
        *(GAS v4u*)(WT + (size_t)(n0dst + n) * K + k0 + 8 * c) = o; }
    LDS_WAIT(); asm volatile("" ::: "memory");
}
__device__ __forceinline__ void convert_layer(Frame& F, int L) {
    bf16* WB = (bf16*)(F.ws + WS_WBUF + (size_t)(L & 1) * WBUF_BYTES);
    LAS float* scr = (LAS float*)(F.lds + RING_OFF + F.wave * 16384);
    const float* w_in = F.in(3) + (size_t)L * 1024 * D_IN; const float* w_o = F.in(14) + (size_t)L * 1024 * 1024; const float* w1 = F.in(16) + (size_t)L * 1024 * 4096;
    const float* w2 = F.in(17) + (size_t)L * 4096 * 1024; const float* w_pg = F.in(19) + (size_t)L * 1024 * 1024; const float* w_ple = F.in(20) + (size_t)L * 256 * 1024;
    const float* pw = F.in(11) + (size_t)L * 256 * 256;
    const float* g_mix = F.in(2) + L * 1024; const float* g_ffn = F.in(15) + L * 1024; const float* g_ple = F.in(18) + L * 1024;
    constexpr int I_IN = 16 * (NIN_ROWS / 32), I_O = 16 * 32, I_1 = 16 * 128, I_2 = 64 * 32, I_PG = 16 * 32, I_PLE = 4 * 32, I_PW = 4 * 8;
    constexpr int NIT = I_IN + I_O + I_1 + I_2 + I_PG + I_PLE + I_PW;
    for (int it = F.gw; it < NIT; it += F.ngw) {
        int r = it;
        if (r < I_IN) { const int nb = r % (NIN_ROWS / 32), kb = r / (NIN_ROWS / 32); transpose_item(w_in, 1024, D_IN, g_mix, WB + WO_WIN, scr, 64 * kb, in_src_col(nb), 32 * nb, F.lane); continue; } r -= I_IN;
        if (r < I_O) { transpose_item(w_o, 1024, 1024, nullptr, WB + WO_WO, scr, 64 * (r / 32), 32 * (r % 32), 32 * (r % 32), F.lane); continue; } r -= I_O;
        if (r < I_1) { transpose_item(w1, 1024, 4096, g_ffn, WB + WO_W1, scr, 64 * (r / 128), 32 * (r % 128), 32 * (r % 128), F.lane); continue; } r -= I_1;
        if (r < I_2) { transpose_item(w2, 4096, 1024, nullptr, WB + WO_W2, scr, 64 * (r / 32), 32 * (r % 32), 32 * (r % 32), F.lane); continue; } r -= I_2;
        if (r < I_PG) { transpose_item(w_pg, 1024, 1024, g_ple, WB + WO_WPG, scr, 64 * (r / 32), 32 * (r % 32), 32 * (r % 32), F.lane); continue; } r -= I_PG;
        if (r < I_PLE) { transpose_item(w_ple, 256, 1024, nullptr, WB + WO_WPLE, scr, 64 * (r / 32), 32 * (r % 32), 32 * (r % 32), F.lane); continue; } r -= I_PLE;
        transpose_item(pw, 256, 256, nullptr, WB + WO_PW, scr, 64 * (r / 8), 32 * (r % 8), 32 * (r % 8), F.lane);
    }
}
__device__ __forceinline__ void sincos_acc(float ang, float& s, float& c) {
    const double x = (double)ang; const double kd = rint(x * 0.63661977236758134);
    const double r = (x - kd * 1.5707963267948966) - kd * 6.123233995736766e-17; const int q = ((int)kd) & 3; const double r2 = r * r;
    const double sp = r * (1.0 + r2 * (-1.0 / 6 + r2 * (1.0 / 120 + r2 * (-1.0 / 5040 + r2 * (1.0 / 362880 + r2 * (-1.0 / 39916800))))));
    const double cp = 1.0 + r2 * (-0.5 + r2 * (1.0 / 24 + r2 * (-1.0 / 720 + r2 * (1.0 / 40320 + r2 * (-1.0 / 3628800 + r2 * (1.0 / 479001600))))));
    double ss, cc;
    if (q == 0) { ss = sp; cc = cp; } else if (q == 1) { ss = cp; cc = -sp; } else if (q == 2) { ss = -sp; cc = -cp; } else { ss = -cp; cc = sp; }
    s = (float)ss; c = (float)cc;
}
__device__ __forceinline__ float log_gamma(int h) { return logf(1.0f - exp2f(-5.0f - (float)h)); }
__device__ __forceinline__ void prologue(Frame& F) {
    convert_layer(F, 0);
    const float* x = F.in(0); bf16* HB = (bf16*)(F.ws + WS_HB); float* SS = (float*)(F.ws + WS_SS);
    for (int m = F.gw; m < M; m += F.ngw) {
        const GAS f32x4* xr = (const GAS f32x4*)(x + (size_t)m * 1024) + F.lane; GAS f32x4* hr = (GAS f32x4*)(F.H + (size_t)m * 1024) + F.lane;
        GAS unsigned long long* o8 = (GAS unsigned long long*)(HB + (size_t)m * 1024) + F.lane; float s = 0.f;
#pragma unroll
        for (int j = 0; j < 4; ++j) { const f32x4 v = xr[64 * j]; hr[64 * j] = v; s += (v.x * v.x + v.y * v.y) + (v.z * v.z + v.w * v.w);
            o8[64 * j] = (unsigned long long)pk2(v.x, v.y) | ((unsigned long long)pk2(v.z, v.w) << 32); }
        s = wave_sum(s);
        if (F.lane < 16) SS[(size_t)m * 16 + F.lane] = F.lane == 0 ? s : 0.f;
    }
    { float2* cs = (float2*)(F.ws + WS_CS); float2* cst = (float2*)(F.ws + WS_CST);
      for (int idx = F.bid * 512 + F.tid; idx < SEQ * 32; idx += F.G * 512) { const int pos = idx >> 5, i = idx & 31; const float inv_freq = powf(10000.0f, -(float)(2 * i) / 64.0f);
          float s, c; sincos_acc((float)pos * inv_freq, s, c); cs[idx] = make_float2(c, s); cst[i * SEQ + pos] = make_float2(c, s); } }
    { float* bt = (float*)(F.ws + WS_BT); const float* rbp = F.in(6);
      for (int idx = F.bid * 512 + F.tid; idx < DEPTH * H_ATT * 7 * 1024; idx += F.G * 512) { const int reg = idx & 15, ln = (idx >> 4) & 63, di = (idx >> 10) % 7, lh = idx / 7168;
          int rel = 32 * di - 32 + (ln & 31) - ((reg & 3) + 8 * (reg >> 2) + 4 * (ln >> 5)); rel = rel < -REL_CLIP ? -REL_CLIP : (rel > REL_CLIP ? REL_CLIP : rel);
          bt[idx] = rbp[lh * 257 + rel + REL_CLIP] * 1.4426950408889634f; } }
    { float* dk = (float*)(F.ws + WS_DK);
      for (int idx = F.bid * 512 + F.tid; idx < H_RET * 64; idx += F.G * 512) dk[idx] = expf(log_gamma(idx >> 6) * (float)(63 - (idx & 63))); }
}
__device__ __forceinline__ void convert_p(Frame& F, int L) {
    const GAS f32x4* p4 = (const GAS f32x4*)(F.in(1) + (size_t)L * M * D_PLE); GAS unsigned long long* o8 = (GAS unsigned long long*)(F.ws + WS_PB); const int n4 = M * D_PLE / 4;
    for (int i = F.bid * 512 + F.tid; i < n4; i += F.G * 512) { const f32x4 v = p4[i]; o8[i] = (unsigned long long)pk2(v.x, v.y) | ((unsigned long long)pk2(v.z, v.w) << 32); }
}
typedef float f32x16 __attribute__((ext_vector_type(16)));
typedef short bf16x8 __attribute__((ext_vector_type(8)));
typedef unsigned u32x2 __attribute__((ext_vector_type(2)));
#define MFMA32(a, b, c) __builtin_amdgcn_mfma_f32_32x32x16_bf16((a), (b), (c), 0, 0, 0)
constexpr float LOG2E = 1.4426950408889634f;
__device__ __forceinline__ int crow(int r, int hi) { return (r & 3) + 8 * (r >> 2) + 4 * hi; }
typedef float f32x2_t __attribute__((ext_vector_type(2))); typedef __bf16 bf16x2_t __attribute__((ext_vector_type(2)));
__device__ __forceinline__ unsigned cvtpk(float lo, float hi) { f32x2_t v = {lo, hi}; bf16x2_t b = __builtin_convertvector(v, bf16x2_t); return __builtin_bit_cast(unsigned, b); }
template <int T8> __device__ __forceinline__ bf16x8 packfrag(const f32x16& x) {
    v4u p; p.x = cvtpk(x[8 * T8 + 0], x[8 * T8 + 1]); p.y = cvtpk(x[8 * T8 + 2], x[8 * T8 + 3]); p.z = cvtpk(x[8 * T8 + 4], x[8 * T8 + 5]); p.w = cvtpk(x[8 * T8 + 6], x[8 * T8 + 7]);
    return __builtin_bit_cast(bf16x8, p);
}
__device__ __forceinline__ f32x16 splat16(float v) { f32x16 r;
#pragma unroll
    for (int i = 0; i < 16; ++i) r[i] = v;
    return r; }
__device__ __forceinline__ float ex2(float x) { return __builtin_amdgcn_exp2f(x); }
constexpr size_t FRAG_T = 6291456;
__device__ __forceinline__ const bf16x8* ftok(const bf16* base, int bh, int blk, int lane) { return (const bf16x8*)(base + ((size_t)(bh * 64 + blk) * 4) * 512) + lane; }
__device__ __forceinline__ const bf16x8* fdim(const bf16* base, int bh, int kb16, int lane) { return (const bf16x8*)(base + ((size_t)(bh * 128 + kb16) * 2) * 512) + lane; }

constexpr int ATT_SLOT = 16384, ATT_NSLOT = 8;
__device__ __forceinline__ void attn_dma(const bf16* KF, const bf16* VF, int bh, int c, LAS unsigned char* ring, int w, int lane) {
    const int slot = c & (ATT_NSLOT - 1);
    const bf16x8* kg = ftok(KF, bh, 2 * c, lane) + 64 * w; const bf16x8* vg = fdim(VF, bh, 4 * c, lane) + 64 * w;
    __builtin_amdgcn_global_load_lds((const unsigned*)kg, (LAS unsigned*)(ring + slot * ATT_SLOT + w * 1024), 16, 0, 0);
    __builtin_amdgcn_global_load_lds((const unsigned*)vg, (LAS unsigned*)(ring + slot * ATT_SLOT + 8192 + w * 1024), 16, 0, 0);
}
template <bool TILE> __device__ __forceinline__ void attn_step(f32x16& o0, f32x16& o1, float& mrun, float& lsum, const bf16x8 (&qf)[4], const LAS unsigned char* slotp, const int lane,
                                                              const float cbias, const float* bt0, const float* bt1) {
    bf16x8 kf[8], vf[8];
#pragma unroll
    for (int s = 0; s < 8; ++s) kf[s] = *(const LAS bf16x8*)(slotp + s * 1024 + lane * 16);
#pragma unroll
    for (int s = 0; s < 8; ++s) vf[s] = *(const LAS bf16x8*)(slotp + 8192 + s * 1024 + lane * 16);
    f32x16 p0, p1;
    if constexpr (TILE) {
        const f32x4* bp = (const f32x4*)bt0; const f32x4* bq = (const f32x4*)bt1;
        const f32x4 t0 = bp[0], t1 = bp[1], t2 = bp[2], t3 = bp[3], u0 = bq[0], u1 = bq[1], u2 = bq[2], u3 = bq[3];
#pragma unroll
        for (int i = 0; i < 4; ++i) { p0[i] = t0[i]; p0[4 + i] = t1[i]; p0[8 + i] = t2[i]; p0[12 + i] = t3[i]; p1[i] = u0[i]; p1[4 + i] = u1[i]; p1[8 + i] = u2[i]; p1[12 + i] = u3[i]; }
    } else { p0 = splat16(cbias); p1 = p0; }
#pragma unroll
    for (int s = 0; s < 4; ++s) { p0 = MFMA32(kf[s], qf[s], p0); p1 = MFMA32(kf[4 + s], qf[s], p1); }
    float rm = fmaxf(p0[0], p1[0]);
#pragma unroll
    for (int r = 1; r < 16; ++r) rm = fmaxf(rm, fmaxf(p0[r], p1[r]));
    rm = fmaxf(rm, __shfl_xor(rm, 32));
    const float mn = fmaxf(mrun, rm), alpha = ex2(mrun - mn); mrun = mn;
    float ps = 0.f;
#pragma unroll
    for (int r = 0; r < 16; ++r) { p0[r] = ex2(p0[r] - mn); p1[r] = ex2(p1[r] - mn); ps += p0[r] + p1[r]; }
    lsum = lsum * alpha + ps;
#pragma unroll
    for (int r = 0; r < 16; ++r) { o0[r] *= alpha; o1[r] *= alpha; }
    { bf16x8 pf;
      pf = packfrag<0>(p0); o0 = MFMA32(vf[0], pf, o0); o1 = MFMA32(vf[1], pf, o1);
      pf = packfrag<1>(p0); o0 = MFMA32(vf[2], pf, o0); o1 = MFMA32(vf[3], pf, o1);
      pf = packfrag<0>(p1); o0 = MFMA32(vf[4], pf, o0); o1 = MFMA32(vf[5], pf, o1);
      pf = packfrag<1>(p1); o0 = MFMA32(vf[6], pf, o0); o1 = MFMA32(vf[7], pf, o1); }
}
__device__ __forceinline__ void attn_block_unit(Frame& F, const bf16* QF, const bf16* KF, const bf16* VF, const float* BT, const float* rb, bf16* MIX, int bh, int n0) {
    const int w = F.wave, lane = F.lane, hi = lane >> 5, q = lane & 31, jn = w >> 1, qh = w & 1, n = n0 + jn, h = bh % 6, b = bh / 6;
    LAS unsigned char* ring = F.lds + RING_OFF;
    bf16x8 qf[4];
    { const bf16x8* qp = ftok(QF, bh, n * 2 + qh, lane);
#pragma unroll
      for (int s = 0; s < 4; ++s) qf[s] = qp[64 * s]; }
    f32x16 o0 = splat16(0.f), o1 = splat16(0.f); float mrun = -1e30f, lsum = 0.f;
    const float cbias = rb[h * 257 + 256] * LOG2E;
    const int t0 = 5 - n0 < 0 ? 0 : 5 - n0;
    const int cmin = n0 - 8 < 0 ? 0 : n0 - 8, NB = n0 + 4 - cmin;
    int nis = 0;
    for (; nis < NB && nis <= n0 - 5 + t0 - cmin + 2; ++nis) attn_dma(KF, VF, bh, cmin + nis, ring, w, lane);
    for (int t = t0; t <= 8; ++t) {
        if (t <= 6) asm volatile("s_waitcnt vmcnt(4) lgkmcnt(0)\n\ts_barrier" ::: "memory"); else asm volatile("s_waitcnt vmcnt(0) lgkmcnt(0)\n\ts_barrier" ::: "memory");
        if (nis < NB && nis <= n0 - 5 + t - cmin + 3) { attn_dma(KF, VF, bh, cmin + nis, ring, w, lane); ++nis; }
        const int c = n - 8 + t;
        if (c >= 0) {
            const LAS unsigned char* slotp = ring + (c & (ATT_NSLOT - 1)) * ATT_SLOT;
            if (t < 6) attn_step<false>(o0, o1, mrun, lsum, qf, slotp, lane, cbias, nullptr, nullptr);
            else { const int D0 = 64 * (8 - t) + 32 * qh, D1 = D0 - 32; const int i0 = D0 >= 160 ? 6 : (D0 + 32) >> 5, i1 = D1 >= 160 ? 6 : (D1 + 32) >> 5;
                   attn_step<true>(o0, o1, mrun, lsum, qf, slotp, lane, cbias, BT + ((size_t)(h * 7 + i0) * 64 + lane) * 16, BT + ((size_t)(h * 7 + i1) * 64 + lane) * 16); }
        }
    }
    lsum += __shfl_xor(lsum, 32);
    const float inv = 1.0f / lsum;
    bf16* op = MIX + (size_t)(b * SEQ + n * CHUNK + qh * 32 + q) * 1024 + h * 64 + 4 * hi;
#pragma unroll
    for (int g = 0; g < 4; ++g) { u32x2 wv;
        wv.x = cvtpk(o0[4 * g] * inv, o0[4 * g + 1] * inv); wv.y = cvtpk(o0[4 * g + 2] * inv, o0[4 * g + 3] * inv); *(u32x2*)(op + 8 * g) = wv;
        wv.x = cvtpk(o1[4 * g] * inv, o1[4 * g + 1] * inv); wv.y = cvtpk(o1[4 * g + 2] * inv, o1[4 * g + 3] * inv); *(u32x2*)(op + 32 + 8 * g) = wv; }
    __syncthreads();
}
__device__ __forceinline__ void ret_block_unit(Frame& F, const bf16* QFr, const bf16* KFr, const bf16* KTr, const bf16* VFr, const bf16* G, const float* gn_g, bf16* MIX, int bh) {
    const int w = F.wave, lane = F.lane, tid = F.tid, hi = lane >> 5, cq = lane & 31, h = bh % 6, b = bh / 6, jc = w >> 1, hw = w & 1;
    LAS unsigned char* lds = F.lds + RING_OFF; LAS float* KVS = (LAS float*)lds; LAS unsigned char* STS = lds + 65536;
    const float lgam = log_gamma(h), dec = expf(lgam * 64.0f), lg2 = lgam * LOG2E;
    const int se = tid >> 3, sd = tid & 7;
    const int st_off = ((((se >> 5) * 4 + (sd >> 1)) * 64 + (sd & 1) * 32 + (se & 31)) * 16);
    f32x4 st0 = {0.f, 0.f, 0.f, 0.f}, st1 = st0;
    const int cc = 32 * hw + cq; const float* gg = gn_g + h * 64 + 4 * hi;
    for (int r = 0; r < 8; ++r) {
        const int n = 4 * r + jc;
        const size_t token = (size_t)b * SEQ + n * CHUNK + cc;
        { f32x16 a0 = splat16(0.f), a1 = splat16(0.f);
          const bf16x8* kp = fdim(KTr, bh, 4 * n, lane); const bf16x8* vp = fdim(VFr, bh, 4 * n, lane) + 64 * hw;
#pragma unroll
          for (int s = 0; s < 4; ++s) { const bf16x8 k0 = kp[128 * s], k1 = kp[128 * s + 64], v = vp[128 * s]; a0 = MFMA32(v, k0, a0); a1 = MFMA32(v, k1, a1); }
          LAS float* out = KVS + jc * 4096 + 32 * hw * 64 + cq;
#pragma unroll
          for (int i = 0; i < 16; ++i) { const int e = crow(i, hi); out[e * 64] = a0[i]; out[e * 64 + 32] = a1[i]; } }
        bf16x8 qf[4], kf[8], vf[8]; u32x2 gw[8];
        { const bf16x8* qp = ftok(QFr, bh, n * 2 + hw, lane); const bf16x8* kp = ftok(KFr, bh, n * 2, lane); const bf16x8* vp = fdim(VFr, bh, 4 * n, lane); const bf16* gp = G + token * 384 + h * 64 + 4 * hi;
#pragma unroll
          for (int s = 0; s < 4; ++s) qf[s] = qp[64 * s];
#pragma unroll
          for (int s = 0; s < 8; ++s) kf[s] = kp[64 * s];
#pragma unroll
          for (int s = 0; s < 8; ++s) vf[s] = vp[64 * s];
#pragma unroll
          for (int g = 0; g < 4; ++g) { gw[g] = *(const u32x2*)(gp + 8 * g); gw[4 + g] = *(const u32x2*)(gp + 32 + 8 * g); } }
        __syncthreads();
#pragma unroll
        for (int j = 0; j < 4; ++j) {
            v4u pk; pk.x = cvtpk(st0[0], st0[1]); pk.y = cvtpk(st0[2], st0[3]); pk.z = cvtpk(st1[0], st1[1]); pk.w = cvtpk(st1[2], st1[3]);
            *(LAS v4u*)(STS + j * 8192 + st_off) = pk;
            const LAS float* kvp = KVS + j * 4096 + se * 64 + 8 * sd; const f32x4 x0 = *(const LAS f32x4*)kvp, x1 = *(const LAS f32x4*)(kvp + 4);
            st0 = st0 * dec + x0; st1 = st1 * dec + x1; }
        __syncthreads();
        f32x16 s0 = splat16(0.f), s1 = splat16(0.f);
#pragma unroll
        for (int s = 0; s < 4; ++s) { s0 = MFMA32(kf[s], qf[s], s0); s1 = MFMA32(kf[4 + s], qf[s], s1); }
#pragma unroll
        for (int i = 0; i < 16; ++i) { const int m0 = crow(i, hi); const int d0 = cc - m0, d1 = cc - m0 - 32;
            s0[i] *= ex2(lg2 * (float)(d0 < 0 ? -d0 : d0)); s1[i] *= ex2(lg2 * (float)(d1 < 0 ? -d1 : d1)); }
        f32x16 o0 = splat16(0.f), o1 = splat16(0.f);
        { const LAS unsigned char* sp = STS + jc * 8192 + lane * 16;
#pragma unroll
          for (int s = 0; s < 4; ++s) { const bf16x8 fa = *(const LAS bf16x8*)(sp + s * 1024), fb = *(const LAS bf16x8*)(sp + (4 + s) * 1024); o0 = MFMA32(fa, qf[s], o0); o1 = MFMA32(fb, qf[s], o1); } }
        { const float qd = ex2(lg2 * (float)(cc + 1));
#pragma unroll
          for (int i = 0; i < 16; ++i) { o0[i] *= qd; o1[i] *= qd; } }
        { bf16x8 pf;
          pf = packfrag<0>(s0); o0 = MFMA32(vf[0], pf, o0); o1 = MFMA32(vf[1], pf, o1);
          pf = packfrag<1>(s0); o0 = MFMA32(vf[2], pf, o0); o1 = MFMA32(vf[3], pf, o1);
          pf = packfrag<0>(s1); o0 = MFMA32(vf[4], pf, o0); o1 = MFMA32(vf[5], pf, o1);
          pf = packfrag<1>(s1); o0 = MFMA32(vf[6], pf, o0); o1 = MFMA32(vf[7], pf, o1); }
        float sm = 0.f;
#pragma unroll
        for (int i = 0; i < 16; ++i) sm += o0[i] + o1[i];
        sm += __shfl_xor(sm, 32); const float mu = sm * (1.0f / 64.0f);
        float vr = 0.f;
#pragma unroll
        for (int i = 0; i < 16; ++i) { o0[i] -= mu; o1[i] -= mu; vr += o0[i] * o0[i] + o1[i] * o1[i]; }
        vr += __shfl_xor(vr, 32); const float rstd = rsqrtf(vr * (1.0f / 64.0f) + EPS);
        bf16* op = MIX + token * 1024 + D_ATT + D_CONV + h * 64 + 4 * hi;
#pragma unroll
        for (int g = 0; g < 4; ++g) {
            { const f32x4 gn = *(const f32x4*)(gg + 8 * g); u32x2 wv;
              wv.x = cvtpk(o0[4 * g] * rstd * gn[0] * __uint_as_float(gw[g].x << 16), o0[4 * g + 1] * rstd * gn[1] * __uint_as_float(gw[g].x & 0xffff0000u));
              wv.y = cvtpk(o0[4 * g + 2] * rstd * gn[2] * __uint_as_float(gw[g].y << 16), o0[4 * g + 3] * rstd * gn[3] * __uint_as_float(gw[g].y & 0xffff0000u)); *(u32x2*)(op + 8 * g) = wv; }
            { const f32x4 gn = *(const f32x4*)(gg + 32 + 8 * g); u32x2 wv;
              wv.x = cvtpk(o1[4 * g] * rstd * gn[0] * __uint_as_float(gw[4 + g].x << 16), o1[4 * g + 1] * rstd * gn[1] * __uint_as_float(gw[4 + g].x & 0xffff0000u));
              wv.y = cvtpk(o1[4 * g + 2] * rstd * gn[2] * __uint_as_float(gw[4 + g].y << 16), o1[4 * g + 3] * rstd * gn[3] * __uint_as_float(gw[4 + g].y & 0xffff0000u)); *(u32x2*)(op + 32 + 8 * g) = wv; }
        }
    }
    __syncthreads();
}
__device__ __forceinline__ void conv_unit(Frame& F, int L, int unit, const bf16* GLU, const bf16* PWT, bf16* MIX) {
    const float* cw = F.in(7) + L * CONV_K * 256; const float* cb = F.in(8) + L * 256; const float* lng = F.in(9) + L * 256; const float* lnb = F.in(10) + L * 256; const float* pwb = F.in(12) + L * 256;
    LAS unsigned char* lds = F.lds + RING_OFF; LAS float* Y = (LAS float*)(lds + 49152);
    const int t0 = unit * 64, s0 = t0 & 2047, tid = F.tid, lane = F.lane, w = F.wave;
    for (int i = tid; i < 94 * 32; i += 512) { const int r = i >> 5, c16 = i & 31; v4u v = {0u, 0u, 0u, 0u};
        if (s0 - 30 + r >= 0) v = *(const v4u*)(GLU + (size_t)(t0 - 30 + r) * 256 + c16 * 8);
        *(LAS v4u*)(lds + r * 512 + c16 * 16) = v; }
    __syncthreads();
    { const int cp = tid & 127, tg = tid >> 7;
      float w0[31], w1[31];
#pragma unroll
      for (int j = 0; j < 31; ++j) { const float2 ww = *(const float2*)(cw + j * 256 + 2 * cp); w0[j] = ww.x; w1[j] = ww.y; }
      unsigned win[46];
#pragma unroll
      for (int i = 0; i < 46; ++i) win[i] = *(const LAS unsigned*)(lds + (tg * 16 + i) * 512 + cp * 4);
      const float2 bb = *(const float2*)(cb + 2 * cp);
#pragma unroll
      for (int tt = 0; tt < 16; ++tt) { float a0 = bb.x, a1 = bb.y;
#pragma unroll
          for (int j = 0; j < 31; ++j) { a0 = fmaf(__uint_as_float(win[tt + j] << 16), w0[j], a0); a1 = fmaf(__uint_as_float(win[tt + j] & 0xffff0000u), w1[j], a1); }
          *(LAS f32x2_t*)(Y + (tg * 16 + tt) * 256 + 2 * cp) = (f32x2_t){a0, a1}; } }
    __syncthreads();
    { const f32x4 gg = *(const f32x4*)(lng + 4 * lane), bt = *(const f32x4*)(lnb + 4 * lane);
#pragma unroll 2
      for (int tk = 0; tk < 8; ++tk) { const int t = 8 * w + tk; f32x4 v = *(const LAS f32x4*)(Y + t * 256 + 4 * lane);
          const float mu = wave_sum((v.x + v.y) + (v.z + v.w)) * (1.f / 256.f); v = v - mu;
          const float r = rsqrtf(wave_sum((v.x * v.x + v.y * v.y) + (v.z * v.z + v.w * v.w)) * (1.f / 256.f) + EPS);
          f32x4 o = v * r * gg + bt; o.x *= sigmoidf_(o.x); o.y *= sigmoidf_(o.y); o.z *= sigmoidf_(o.z); o.w *= sigmoidf_(o.w);
          u32x2 pk; pk.x = cvtpk(o.x, o.y); pk.y = cvtpk(o.z, o.w);
          *(LAS u32x2*)(lds + ((((t >> 5) * 16 + (lane >> 2)) * 64 + ((lane >> 1) & 1) * 32 + (t & 31)) * 16 + 8 * (lane & 1))) = pk; } }
    __syncthreads();
    { const int hi = lane >> 5; f32x16 a0 = splat16(0.f), a1 = splat16(0.f);
      const bf16* ap = PWT + (size_t)(32 * w + (lane & 31)) * 256 + 8 * hi;
#pragma unroll 4
      for (int s = 0; s < 16; ++s) { const bf16x8 A = *(const bf16x8*)(ap + 16 * s);
          const bf16x8 B0 = *(const LAS bf16x8*)(lds + (s * 64 + lane) * 16), B1 = *(const LAS bf16x8*)(lds + ((16 + s) * 64 + lane) * 16);
          a0 = MFMA32(A, B0, a0); a1 = MFMA32(A, B1, a1); }
      bf16* op = MIX + (size_t)(t0 + (lane & 31)) * 1024 + D_ATT + 32 * w + 4 * hi; const float* bp = pwb + 32 * w + 4 * hi;
#pragma unroll
      for (int g = 0; g < 4; ++g) { const f32x4 bv = *(const f32x4*)(bp + 8 * g); u32x2 x;
          x.x = cvtpk(a0[4 * g] + bv[0], a0[4 * g + 1] + bv[1]); x.y = cvtpk(a0[4 * g + 2] + bv[2], a0[4 * g + 3] + bv[3]); *(u32x2*)(op + 8 * g) = x;
          x.x = cvtpk(a1[4 * g] + bv[0], a1[4 * g + 1] + bv[1]); x.y = cvtpk(a1[4 * g + 2] + bv[2], a1[4 * g + 3] + bv[3]); *(u32x2*)(op + 32 * 1024 + 8 * g) = x; } }
    __syncthreads();
}

template <int SUB> __device__ __forceinline__ void layer_phase(Frame& F, const int L) {
    bf16* HBP = (bf16*)(F.ws + WS_HB + (size_t)(L & 1) * HB_BYTES); bf16* HBQ = (bf16*)(F.ws + WS_HB + (size_t)((L + 1) & 1) * HB_BYTES);
    float* SS0 = (float*)(F.ws + WS_SS); float* SS1 = SS0 + (size_t)M * 16; float* SS2 = SS1 + (size_t)M * 16;
    bf16* PJ = (bf16*)(F.ws + WS_PROJ); bf16* MIX = (bf16*)(F.ws + WS_MIX);
    bf16 *QFa = PJ, *KFa = PJ + FRAG_T, *VFa = PJ + 2 * FRAG_T, *QFr = PJ + 3 * FRAG_T, *KFr = PJ + 4 * FRAG_T, *KTr = PJ + 5 * FRAG_T, *VFr = PJ + 6 * FRAG_T, *GG = PJ + 7 * FRAG_T, *GLU = PJ + 8 * FRAG_T;
    bf16* HID = (bf16*)(F.ws + WS_HID); bf16* PLE = (bf16*)(F.ws + WS_PLE);
    const bf16* WB = (const bf16*)(F.ws + WS_WBUF + (size_t)(L & 1) * WBUF_BYTES);
    if constexpr (SUB == 0) {
        pg8::InProjOrder S; S.init(M, NIN_ROWS, 1024, F.G, F.bid, HBP, WB + WO_WIN);
        pg8::EpiInProj E{{QFa, KFa, VFa, QFr, KFr, KTr, VFr, GG, GLU, SS0, F.in(4) + L * 64, F.in(5) + L * 64, (const float*)(F.ws + WS_CS), (const float*)(F.ws + WS_CST), (const float*)(F.ws + WS_DK)}};
        pg8::gemm_phase<pg8::EpiInProj, pg8::InProjOrder, true, true>(F.lds + RING_OFF, 1024, S, E, F.tid);
    } else if constexpr (SUB == 1) {
        const float* bt = (const float*)(F.ws + WS_BT) + (size_t)L * H_ATT * 7 * 1024; const float* rb = F.in(6) + L * H_ATT * 257; const float* gn = F.in(13) + L * D_RET;
        gu32* qctr = (gu32*)(F.ws + WS_CTL) + CW_QUEUE + 64 * L;
        volatile LAS unsigned* qslot = (volatile LAS unsigned*)(F.lds + MISC_OFF) + 16;
        for (;;) {
            __syncthreads();
            if (F.tid == 0) *qslot = __hip_atomic_fetch_add(qctr, 1u, __ATOMIC_RELAXED, __HIP_MEMORY_SCOPE_AGENT);
            __syncthreads();
            const int it = (int)__builtin_amdgcn_readfirstlane(*qslot);
            if (it >= 48 + 384 + 256) break;
            Frame F2 = F; { int t_ = F.tid; asm volatile("" : "+v"(t_)); F2.tid = t_; F2.lane = t_ & 63; }
            if (it < 48) ret_block_unit(F2, QFr, KFr, KTr, VFr, GG, gn, MIX, it);
            else if (it < 48 + 384) { const int u = it - 48; int grp, bh; if (u < 288) { grp = 2 + u / 48; bh = u % 48; } else { grp = 1 - (u - 288) / 48; bh = (u - 288) % 48; }
                attn_block_unit(F2, QFa, KFa, VFa, bt, rb, MIX, bh, 4 * grp); }
            else conv_unit(F2, L, it - 432, GLU, WB + WO_PW, MIX);
        }
        __syncthreads();
        convert_p(F, L);
        if (L + 1 < DEPTH) convert_layer(F, L + 1);
    } else if constexpr (SUB == 2) {
        pg8::StaticOrder S; S.init(M, 1024, 1024, F.G, F.bid, MIX, WB + WO_WO);
        pg8::EpiRes<false> E{F.H, HBQ, SS1, nullptr, nullptr};
        pg8::gemm_phase<pg8::EpiRes<false>, pg8::StaticOrder, false, true>(F.lds + RING_OFF, 1024, S, E, F.tid);
    } else if constexpr (SUB == 3) {
        pg8::StaticOrder S; S.init(M, 4096, 1024, F.G, F.bid, HBQ, WB + WO_W1);
        pg8::EpiBf16<1, true> E{HID, 4096, SS1};
        pg8::gemm_phase<pg8::EpiBf16<1, true>, pg8::StaticOrder, true, true>(F.lds + RING_OFF, 1024, S, E, F.tid);
    } else if constexpr (SUB == 4) {
        pg8::StaticOrder S; S.init(M, 1024, 4096, F.G, F.bid, HID, WB + WO_W2);
        pg8::EpiRes<false> E{F.H, HBP, SS2, nullptr, nullptr};
        pg8::gemm_phase<pg8::EpiRes<false>, pg8::StaticOrder, false, true>(F.lds + RING_OFF, 4096, S, E, F.tid);
    } else {
        { pg8::StaticOrder S; S.init(M, 1024, 256, F.G, F.bid, (const bf16*)(F.ws + WS_PB), WB + WO_WPLE);
          pg8::EpiBf16<0, false> E{PLE, 1024, nullptr};
          pg8::gemm_phase<pg8::EpiBf16<0, false>, pg8::StaticOrder, false, true>(F.lds + RING_OFF, 256, S, E, F.tid); }
        __syncthreads();
        { pg8::StaticOrder S; S.init(M, 1024, 1024, F.G, F.bid, HBP, WB + WO_WPG);
          pg8::EpiRes<true> E{F.H, HBQ, SS0, SS2, PLE};
          pg8::gemm_phase<pg8::EpiRes<true>, pg8::StaticOrder, false, true>(F.lds + RING_OFF, 1024, S, E, F.tid); }
    }
}
constexpr int PH_PER_LAYER = 6, N_PHASES = 1 + PH_PER_LAYER * DEPTH;
__global__ void __launch_bounds__(NWAVES * 64, 2) mk_fwd(Args args) {
    extern __shared__ __attribute__((aligned(16))) unsigned char lds[];
    LAS unsigned char* const ldsb = (LAS unsigned char*)lds;
    for (int u = threadIdx.x; u < (LDS_BYTES - LDSCTL_OFF) / 4; u += NWAVES * 64) ((LAS unsigned*)(ldsb + LDSCTL_OFF))[u] = 0u;
    __syncthreads();
    if (threadIdx.x == 0) {
        LAS unsigned long long* P = (LAS unsigned long long*)(ldsb + PTR_OFF);
#pragma unroll
        for (int i = 0; i < 21; ++i) P[i] = (unsigned long long)(uintptr_t)args.in[i];
        P[21] = (unsigned long long)(uintptr_t)args.out; P[22] = (unsigned long long)(uintptr_t)args.ws;
    }
    __syncthreads();
    XcdBarrier bar; { unsigned char* ws0 = args.ws; bar.bar = (unsigned*)(ws0 + WS_CTL) + CW_BAR; bar.x = 0; bar.st = nullptr;
    const bool multi = (args.ph_hi - args.ph_lo) > 1;
    if (multi) bar = xcd_barrier_post((unsigned*)(ws0 + WS_CTL) + CW_BAR, (volatile LAS unsigned*)(ldsb + MISC_OFF) + 8); }
    const int lo = args.ph_lo, hi = args.ph_hi;
    const int wave0 = __builtin_amdgcn_readfirstlane(threadIdx.x >> 6);
#define FRAME_INIT() \
        int wv_ = wave0, bid_ = blockIdx.x; asm volatile("" : "+s"(wv_)); asm volatile("" : "+s"(bid_)); \
        int tid_ = wv_ * 64 + (int)__builtin_amdgcn_mbcnt_hi(~0u, __builtin_amdgcn_mbcnt_lo(~0u, 0u)); \
        Frame F; F.lds = ldsb; F.tid = tid_; F.lane = tid_ & 63; F.wave = __builtin_amdgcn_readfirstlane(tid_ >> 6); \
        F.G = gridDim.x; F.bid = bid_; F.gw = F.bid * NWAVES + F.wave; F.ngw = F.G * NWAVES; \
        { LAS unsigned long long* P = (LAS unsigned long long*)(ldsb + PTR_OFF); \
          F.H = (float*)(uintptr_t)rfl64(P[21]); F.ws = (unsigned char*)(uintptr_t)rfl64(P[22]); }
#define GRID_BAR() do { XcdBarrier b2; b2.bar = (unsigned*)(F.ws + WS_CTL) + CW_BAR; b2.x = xb_xcc_id(); b2.st = (volatile LAS unsigned*)(F.lds + MISC_OFF) + 8; xcd_barrier(b2); } while (0)
#define RUN_PHASE(ph, call) if (lo <= (ph) && (ph) < hi) { FRAME_INIT(); call; if ((ph) + 1 < hi) GRID_BAR(); }
#ifndef MK_DUP_SUB
#define MK_DUP_SUB -1
#endif
#define RUN_PHASE_L(ph, SUBI, L) if (lo <= (ph) && (ph) < hi) { FRAME_INIT(); layer_phase<SUBI>(F, (L)); if (SUBI == MK_DUP_SUB) { GRID_BAR(); layer_phase<SUBI>(F, (L)); } if ((ph) + 1 < hi) GRID_BAR(); }
    RUN_PHASE(0, prologue(F))
#define RUN_LAYER(L) \
    RUN_PHASE_L(1 + 6 * (L) + 0, 0, L) RUN_PHASE_L(1 + 6 * (L) + 1, 1, L) RUN_PHASE_L(1 + 6 * (L) + 2, 2, L) RUN_PHASE_L(1 + 6 * (L) + 3, 3, L) \
    RUN_PHASE_L(1 + 6 * (L) + 4, 4, L) RUN_PHASE_L(1 + 6 * (L) + 5, 5, L)
    RUN_LAYER(0) RUN_LAYER(1) RUN_LAYER(2) RUN_LAYER(3)
}

extern "C" void kernel_launch(void* const* d_in, const int* in_sizes, int n_in, void* d_out, int out_size, void* d_ws, size_t ws_size, hipStream_t stream) {
    static int grid = 0;
    if (grid == 0) {
        if (n_in != 21 || out_size != M * D_MODEL || ws_size < WS_END) { fprintf(stderr, "kernel_launch: unexpected shapes / workspace (%d inputs, out %d, ws %zu)\n", n_in, out_size, ws_size); grid = -1; return; }
        int dev = 0, cus = 0, per_cu = 0;
        if (hipGetDevice(&dev) != hipSuccess || hipDeviceGetAttribute(&cus, hipDeviceAttributeMultiprocessorCount, dev) != hipSuccess) { grid = -1; return; }
        if (hipFuncSetAttribute((const void*)mk_fwd, hipFuncAttributeMaxDynamicSharedMemorySize, LDS_BYTES) != hipSuccess) { fprintf(stderr, "kernel_launch: hipFuncSetAttribute failed\n"); grid = -1; return; }
        if (hipOccupancyMaxActiveBlocksPerMultiprocessor(&per_cu, (const void*)mk_fwd, NWAVES * 64, LDS_BYTES) != hipSuccess || per_cu < 1) { fprintf(stderr, "kernel_launch: occupancy query says %d\n", per_cu); per_cu = 1; }
        (void)hipGetLastError();
        grid = cus;
    }
    if (grid < 0) return;
    if (hipMemsetAsync((char*)d_ws + WS_CTL, 0, CTL_ZERO_BYTES, stream) != hipSuccess) return;
    Args a{};
    for (int i = 0; i < 21; ++i) a.in[i] = (const float*)d_in[i];
    a.out = (float*)d_out; a.ws = (unsigned char*)d_ws;
#if MK_PER_PHASE
    for (int ph = 0; ph < N_PHASES; ++ph) { a.ph_lo = ph; a.ph_hi = ph + 1; hipLaunchKernelGGL(mk_fwd, dim3(grid), dim3(NWAVES * 64), LDS_BYTES, stream, a); }
#else
    a.ph_lo = 0; a.ph_hi = N_PHASES;
    void* kargs[] = {&a};
    hipError_t e = hipLaunchCooperativeKernel((const void*)mk_fwd, dim3(grid), dim3(NWAVES * 64), kargs, LDS_BYTES, stream);
    if (e != hipSuccess) fprintf(stderr, "kernel_launch: cooperative launch failed: %s (grid %d)\n", hipGetErrorString(e), grid);
#endif
}
```

```cpp
#include <hip/hip_runtime.h>
#include <cstdio>
#include <cstdint>

#ifndef MK_PER_PHASE
#define MK_PER_PHASE 0
#endif

namespace pg8 {
#define PG8_LAS __attribute__((address_space(3)))
typedef unsigned short bf16_t;
typedef short bf16x8 __attribute__((ext_vector_type(8)));
typedef float f32x4 __attribute__((ext_vector_type(4)));
typedef unsigned u32x4 __attribute__((ext_vector_type(4)));
constexpr int BM = 256, BK = 64, HALF = 128, HTB = HALF * BK * 2, STAGE_BYTES = 8 * HTB, NXCD = 8, WGM = 8;
__host__ __device__ __forceinline__ int lds_byte(int r, int c) { const int st = (r >> 4) * 2 + (c >> 5), rr = r & 15, cc = c & 31, ob = rr * 64 + cc * 2; return st * 1024 + (ob ^ (((ob >> 9) & 1) << 5)); }
__host__ __device__ __forceinline__ void stage_rc(int b, int& R, int& C) { const int st = b / 1024, sb = b % 1024, swz = sb ^ (((sb >> 9) & 1) << 5); R = (st >> 1) * 16 + swz / 64; C = (st & 1) * 32 + (swz % 64) / 2; }
__host__ __device__ __forceinline__ int perm32(int rho) { const int n = rho >> 4, i = rho & 15; return 8 * (i >> 2) + 4 * n + (i & 3); }
struct Unit { int pm, pn; };
struct StaticOrder {
    int nM, nN, nwg, G, c; const char* A; const char* Bt; size_t tstep;
    __device__ void init(int M, int N, int K, int G_, int c_, const void* A_, const void* Bt_) { nM = M / BM; nN = N / BM; nwg = nM * nN; G = G_; c = c_; A = (const char*)A_; Bt = (const char*)Bt_; tstep = (size_t)BM * K * 2; }
    __device__ bool next(int i, Unit& u) const {
        const long L = (long)i * G + c; if (L >= nwg) return false;
        int wgid = (int)L; { const int q = nwg / NXCD, r = nwg % NXCD, xcd = wgid % NXCD, off = wgid / NXCD; wgid = (xcd < r ? xcd * (q + 1) : r * (q + 1) + (xcd - r) * q) + off; }
        const int nig = WGM * nN, gid = wgid / nig, fm = gid * WGM, gsz = (nM - fm) < WGM ? (nM - fm) : WGM;
        u.pm = fm + ((wgid % nig) % gsz); u.pn = (wgid % nig) / gsz; return true;
    }
    __device__ __forceinline__ const char* a_ptr(const Unit& u) const { return A + (size_t)u.pm * tstep; }
    __device__ __forceinline__ const char* b_ptr(const Unit& u) const { return Bt + (size_t)u.pn * tstep; }
    __device__ __forceinline__ void a_ready(const Unit&) const {}
    __device__ __forceinline__ void done(const Unit&) const {}
};
__device__ __forceinline__ unsigned cvt_pk_bf16(float lo, float hi) { unsigned r; asm volatile("v_cvt_pk_bf16_f32 %0, %1, %2" : "=v"(r) : "v"(lo), "v"(hi)); return r; }
__device__ __forceinline__ u32x4 pack8(f32x4 v0, f32x4 v1) { u32x4 w; w.x = cvt_pk_bf16(v0[0], v0[1]); w.y = cvt_pk_bf16(v0[2], v0[3]); w.z = cvt_pk_bf16(v1[0], v1[1]); w.w = cvt_pk_bf16(v1[2], v1[3]); return w; }
__device__ __forceinline__ float bfl(unsigned w) { return __uint_as_float(w << 16); }
__device__ __forceinline__ float bfh(unsigned w) { return __uint_as_float(w & 0xffff0000u); }

__device__ __forceinline__ float row_rstd(const float* SS, int row) {
    const f32x4* p = (const f32x4*)(SS + (size_t)row * 16); const f32x4 a = p[0], b = p[1], c = p[2], d = p[3];
    const float s = ((a[0] + a[1]) + (a[2] + a[3])) + ((b[0] + b[1]) + (b[2] + b[3])) + ((c[0] + c[1]) + (c[2] + c[3])) + ((d[0] + d[1]) + (d[2] + d[3]));
    return rsqrtf(s * (1.0f / 1024.0f) + 1e-6f);
}
template <int ACT, bool SCALE> struct EpiBf16 {
    static constexpr bool PERM = true, AFTER_DRAIN = false;
    bf16_t* O; int ldc; const float* SS;
    __device__ __forceinline__ void operator()(const f32x4 (&acc)[2][2][4][2], const Unit& u, int wr, int wc, int fr, int fq) const {
        asm volatile("" : "+v"(fr), "+v"(fq));
        float rs[8];
#pragma unroll
        for (int i = 0; i < 8; ++i) rs[i] = SCALE ? row_rstd(SS, u.pm * BM + (i >> 2) * HALF + wr * 64 + (i & 3) * 16 + fr) : 1.0f;
#pragma unroll
        for (int ai = 0; ai < 2; ++ai)
#pragma unroll
            for (int m = 0; m < 4; ++m) { const int row = u.pm * BM + ai * HALF + wr * 64 + m * 16 + fr; const float r = rs[ai * 4 + m];
#pragma unroll
                for (int bj = 0; bj < 2; ++bj) { const int col = u.pn * BM + bj * HALF + wc * 32 + 8 * fq; f32x4 v0 = acc[ai][bj][m][0] * r, v1 = acc[ai][bj][m][1] * r;
                    if (ACT == 1) {
#pragma unroll
                        for (int j = 0; j < 4; ++j) { const float a = fmaxf(v0[j], 0.f), b = fmaxf(v1[j], 0.f); v0[j] = a * a; v1[j] = b * b; } }
                    *(u32x4*)(O + (size_t)row * ldc + col) = pack8(v0, v1); } }
    }
};
struct EpiBias {
    static constexpr bool PERM = true, AFTER_DRAIN = false;
    bf16_t* O; int ldc; const float* bias;
    __device__ __forceinline__ void operator()(const f32x4 (&acc)[2][2][4][2], const Unit& u, int wr, int wc, int fr, int fq) const {
#pragma unroll
        for (int ai = 0; ai < 2; ++ai)
#pragma unroll
            for (int m = 0; m < 4; ++m) { const int row = u.pm * BM + ai * HALF + wr * 64 + m * 16 + fr;
#pragma unroll
                for (int bj = 0; bj < 2; ++bj) { const int col = u.pn * BM + bj * HALF + wc * 32 + 8 * fq; const f32x4 b0 = *(const f32x4*)(bias + col), b1 = *(const f32x4*)(bias + col + 4);
                    *(u32x4*)(O + (size_t)row * ldc + col) = pack8(acc[ai][bj][m][0] + b0, acc[ai][bj][m][1] + b1); } }
    }
};
template <bool GATE> struct EpiRes {
    static constexpr bool PERM = true, AFTER_DRAIN = false;
    float* H; bf16_t* HB; float* SSout; const float* SSin; const bf16_t* PLE;
    __device__ __forceinline__ void operator()(const f32x4 (&acc)[2][2][4][2], const Unit& u, int wr, int wc, int fr, int fq) const {
        asm volatile("" : "+v"(fr), "+v"(fq));
        float rs[8], ssq[8];
#pragma unroll
        for (int i = 0; i < 8; ++i) rs[i] = GATE ? row_rstd(SSin, u.pm * BM + (i >> 2) * HALF + wr * 64 + (i & 3) * 16 + fr) : 1.0f;
        const int colb = u.pn * BM + wc * 32 + 8 * fq;
#pragma unroll
        for (int g2 = 0; g2 < 4; ++g2) {
            f32x4 hv[2][2][2]; u32x4 pw[2][2];
#pragma unroll
            for (int mm = 0; mm < 2; ++mm) { const int ai = g2 >> 1, m = (g2 & 1) * 2 + mm; const int row = u.pm * BM + ai * HALF + wr * 64 + m * 16 + fr;
#pragma unroll
                for (int bj = 0; bj < 2; ++bj) { const float* hp = H + (size_t)row * 1024 + colb + bj * HALF; hv[mm][bj][0] = *(const f32x4*)hp; hv[mm][bj][1] = *(const f32x4*)(hp + 4);
                    if (GATE) pw[mm][bj] = *(const u32x4*)(PLE + (size_t)row * 1024 + colb + bj * HALF); } }
#pragma unroll
            for (int mm = 0; mm < 2; ++mm) { const int ai = g2 >> 1, m = (g2 & 1) * 2 + mm; const int row = u.pm * BM + ai * HALF + wr * 64 + m * 16 + fr; const float r = rs[ai * 4 + m]; float sq = 0.f;
#pragma unroll
                for (int bj = 0; bj < 2; ++bj) { float* hp = H + (size_t)row * 1024 + colb + bj * HALF;
                    f32x4 v0 = acc[ai][bj][m][0], v1 = acc[ai][bj][m][1];
                    if (GATE) { const u32x4 p = pw[mm][bj];
                        const f32x4 p0 = {bfl(p.x), bfh(p.x), bfl(p.y), bfh(p.y)}, p1 = {bfl(p.z), bfh(p.z), bfl(p.w), bfh(p.w)};
#pragma unroll
                        for (int j = 0; j < 4; ++j) { v0[j] = p0[j] / (1.0f + __expf(-v0[j] * r)); v1[j] = p1[j] / (1.0f + __expf(-v1[j] * r)); } }
                    v0 = v0 + hv[mm][bj][0]; v1 = v1 + hv[mm][bj][1];
                    *(f32x4*)hp = v0; *(f32x4*)(hp + 4) = v1;
                    *(u32x4*)(HB + (size_t)row * 1024 + colb + bj * HALF) = pack8(v0, v1);
                    sq += (v0[0] * v0[0] + v0[1] * v0[1]) + (v0[2] * v0[2] + v0[3] * v0[3]) + (v1[0] * v1[0] + v1[1] * v1[1]) + (v1[2] * v1[2] + v1[3] * v1[3]); }
                sq += __shfl_xor(sq, 16); sq += __shfl_xor(sq, 32); ssq[ai * 4 + m] = sq; }
        }
        if (fq == 0) {
#pragma unroll
            for (int i = 0; i < 8; ++i) SSout[(size_t)(u.pm * BM + (i >> 2) * HALF + wr * 64 + (i & 3) * 16 + fr) * 16 + u.pn * 4 + wc] = ssq[i]; }
    }
};

typedef float f32x2v __attribute__((ext_vector_type(2)));
typedef unsigned u32x2 __attribute__((ext_vector_type(2)));
struct InProjOut {
    bf16_t* PJ; const float* SS; const float* qn_g; const float* kn_g; const unsigned char* TAB;
    static constexpr size_t FT = 6291456;
    __device__ __forceinline__ bf16_t* QFa() const { return PJ; }            __device__ __forceinline__ bf16_t* KFa() const { return PJ + FT; }
    __device__ __forceinline__ bf16_t* VFa() const { return PJ + 2 * FT; }   __device__ __forceinline__ bf16_t* QFr() const { return PJ + 3 * FT; }
    __device__ __forceinline__ bf16_t* KFr() const { return PJ + 4 * FT; }   __device__ __forceinline__ bf16_t* KTr() const { return PJ + 5 * FT; }
    __device__ __forceinline__ bf16_t* VFr() const { return PJ + 6 * FT; }   __device__ __forceinline__ bf16_t* G() const { return PJ + 7 * FT; }
    __device__ __forceinline__ bf16_t* GLU() const { return PJ + 8 * FT; }
    __device__ __forceinline__ const float* CS() const { return (const float*)TAB; }
    __device__ __forceinline__ const float* CST() const { return (const float*)(TAB + 512 * 1024); }
    __device__ __forceinline__ const float* DK() const { return (const float*)(TAB + 2 * 1024 * 1024); }
};
struct InProjOrder : StaticOrder {
    __device__ __forceinline__ const char* a_ptr(const Unit& u) const { return u.pn < 10 ? A + (size_t)u.pm * tstep : Bt + (size_t)u.pn * tstep; }
    __device__ __forceinline__ const char* b_ptr(const Unit& u) const { return u.pn < 10 ? Bt + (size_t)u.pn * tstep : A + (size_t)u.pm * tstep; }
};
struct PleOrder {
    int c, nmax; const char* A; const char* Bt; size_t tstep;
    __device__ void init(int c_, const void* A_, const void* Bt_) { c = c_; A = (const char*)A_; Bt = (const char*)Bt_; tstep = (size_t)BM * 256 * 2; nmax = 4; asm volatile("" : "+s"(nmax)); }
    __device__ bool next(int i, Unit& u) const { if (c < 192 || i >= nmax) return false; const int idx = i * 64 + (c - 192); u.pm = idx >> 2; u.pn = idx & 3; return true; }
    __device__ __forceinline__ const char* a_ptr(const Unit& u) const { return A + (size_t)u.pm * tstep; }
    __device__ __forceinline__ const char* b_ptr(const Unit& u) const { return Bt + (size_t)u.pn * tstep; }
    __device__ __forceinline__ void a_ready(const Unit&) const {}
    __device__ __forceinline__ void done(const Unit&) const {}
};
__device__ __forceinline__ float sigm(float x) { return 1.0f / (1.0f + __expf(-x)); }
__device__ __forceinline__ u32x2 pack4(f32x4 v) { u32x2 w; w.x = cvt_pk_bf16(v[0], v[1]); w.y = cvt_pk_bf16(v[2], v[3]); return w; }
struct EpiInProj {
    static constexpr bool PERM = true, AFTER_DRAIN = false;
    InProjOut o;
    __device__ __forceinline__ void operator()(const f32x4 (&acc)[2][2][4][2], const Unit& u, int wr, int wc, int fr, int fq) const {
        asm volatile("" : "+v"(fr), "+v"(fq));
        const int T = u.pn;
        if (T < 10) {
            int kind, head;
            if (T < 3) { const int g = 4 * T + wc; kind = g < 6 ? 0 : 1; head = g < 6 ? g : g - 6; }
            else if (T < 5) { kind = 2; head = 0; }
            else { const int g = 4 * (T - 5) + wc; kind = g < 6 ? 3 : (g < 12 ? 4 : (g < 18 ? 5 : 6)); head = g % 6; }
            if (kind == 6) return;
#pragma unroll
            for (int ai = 0; ai < 2; ++ai) {
                float rs[4];
#pragma unroll
                for (int i = 0; i < 4; ++i) rs[i] = row_rstd(o.SS, u.pm * BM + ai * HALF + wr * 64 + i * 16 + fr);
#pragma unroll
                for (int m = 0; m < 4; ++m) {
                    const int token = u.pm * BM + ai * HALF + wr * 64 + m * 16 + fr; const float rstd = rs[m];
                    const int bb = token >> 11, s = token & 2047;
                    f32x4 a0 = acc[ai][0][m][0] * rstd, a1 = acc[ai][0][m][1] * rstd, b0 = acc[ai][1][m][0] * rstd, b1 = acc[ai][1][m][1] * rstd;
                    if (kind == 0 || kind == 1) {
                        float ss = (a0[0] * a0[0] + a0[1] * a0[1]) + (a0[2] * a0[2] + a0[3] * a0[3]) + (a1[0] * a1[0] + a1[1] * a1[1]) + (a1[2] * a1[2] + a1[3] * a1[3])
                                 + (b0[0] * b0[0] + b0[1] * b0[1]) + (b0[2] * b0[2] + b0[3] * b0[3]) + (b1[0] * b1[0] + b1[1] * b1[1]) + (b1[2] * b1[2] + b1[3] * b1[3]);
                        ss += __shfl_xor(ss, 16); ss += __shfl_xor(ss, 32);
                        const float r2 = rsqrtf(ss * (1.0f / 64.0f) + 1e-6f) * (kind == 0 ? 0.125f * 1.4426950408889634f : 1.0f);
                        const float* gp = (kind == 0 ? o.qn_g : o.kn_g) + 8 * fq;
                        const f32x4 g0 = *(const f32x4*)gp, g1 = *(const f32x4*)(gp + 4), g2 = *(const f32x4*)(gp + 32), g3 = *(const f32x4*)(gp + 36);
                        bf16_t* base = (kind == 0 ? o.QFa() : o.KFa()) + ((size_t)((bb * 6 + head) * 64 + (s >> 5)) * 4 + (fq >> 1)) * 512 + ((fq & 1) * 32 + (s & 31)) * 8;
                        *(u32x4*)base = pack8(a0 * g0 * r2, a1 * g1 * r2); *(u32x4*)(base + 1024) = pack8(b0 * g2 * r2, b1 * g3 * r2);
                    } else if (kind == 3 || kind == 4) {
                        const float sc = kind == 3 ? 0.125f : 1.0f;
                        const f32x4* cp = (const f32x4*)(o.CS() + (size_t)s * 64 + 16 * fq);
                        const f32x4 c0 = cp[0], c1 = cp[1], c2 = cp[2], c3 = cp[3];
                        f32x4 x0, x1, y0, y1;
                        x0[0] = (a0[0] * c0[0] - b0[0] * c0[1]) * sc; y0[0] = (a0[0] * c0[1] + b0[0] * c0[0]) * sc; x0[1] = (a0[1] * c0[2] - b0[1] * c0[3]) * sc; y0[1] = (a0[1] * c0[3] + b0[1] * c0[2]) * sc;
                        x0[2] = (a0[2] * c1[0] - b0[2] * c1[1]) * sc; y0[2] = (a0[2] * c1[1] + b0[2] * c1[0]) * sc; x0[3] = (a0[3] * c1[2] - b0[3] * c1[3]) * sc; y0[3] = (a0[3] * c1[3] + b0[3] * c1[2]) * sc;
                        x1[0] = (a1[0] * c2[0] - b1[0] * c2[1]) * sc; y1[0] = (a1[0] * c2[1] + b1[0] * c2[0]) * sc; x1[1] = (a1[1] * c2[2] - b1[1] * c2[3]) * sc; y1[1] = (a1[1] * c2[3] + b1[1] * c2[2]) * sc;
                        x1[2] = (a1[2] * c3[0] - b1[2] * c3[1]) * sc; y1[2] = (a1[2] * c3[1] + b1[2] * c3[0]) * sc; x1[3] = (a1[3] * c3[2] - b1[3] * c3[3]) * sc; y1[3] = (a1[3] * c3[3] + b1[3] * c3[2]) * sc;
                        bf16_t* base = (kind == 3 ? o.QFr() : o.KFr()) + ((size_t)((bb * 6 + head) * 64 + (s >> 5)) * 4 + (fq >> 1)) * 512 + ((fq & 1) * 32 + (s & 31)) * 8;
                        *(u32x4*)base = pack8(x0, x1); *(u32x4*)(base + 1024) = pack8(y0, y1);
                    } else if (kind == 5) {
#pragma unroll
                        for (int j = 0; j < 4; ++j) { a0[j] *= sigm(a0[j]); a1[j] *= sigm(a1[j]); b0[j] *= sigm(b0[j]); b1[j] *= sigm(b1[j]); }
                        bf16_t* base = o.G() + (size_t)token * 384 + head * 64 + 8 * fq;
                        *(u32x4*)base = pack8(a0, a1); *(u32x4*)(base + 32) = pack8(b0, b1);
                    } else {
#pragma unroll
                        for (int j = 0; j < 4; ++j) { a0[j] *= sigm(b0[j]); a1[j] *= sigm(b1[j]); }
                        *(u32x4*)(o.GLU() + (size_t)token * 256 + 128 * (T - 3) + 32 * wc + 8 * fq) = pack8(a0, a1);
                    }
                }
            }
        } else {
#pragma unroll
            for (int bj = 0; bj < 2; ++bj) {
                const int tok0 = u.pm * BM + bj * HALF + wc * 32 + 8 * fq, bb = tok0 >> 11, s0 = tok0 & 2047, kb16 = s0 >> 4, uu = (s0 >> 3) & 1;
                f32x4 rs0, rs1;
#pragma unroll
                for (int j = 0; j < 4; ++j) { rs0[j] = row_rstd(o.SS, tok0 + j); rs1[j] = row_rstd(o.SS, tok0 + 4 + j); }
#pragma unroll
                for (int ai = 0; ai < 2; ++ai) {
                    const int g = 4 * (T - 10) + 2 * ai + wr;
                    if (g >= 18) continue;
                    const int head = g % 6, bh = bb * 6 + head;
                    if (g < 12) {
                        bf16_t* dst = (g < 6 ? o.VFa() : o.VFr()) + ((size_t)(bh * 128 + kb16) * 2) * 512 + 4 * uu;
#pragma unroll
                        for (int m = 0; m < 4; ++m) { bf16_t* p = dst + ((m >> 1) * 64 + 16 * (m & 1) + fr) * 8;
                            *(u32x2*)p = pack4(acc[ai][bj][m][0] * rs0); *(u32x2*)(p + 256) = pack4(acc[ai][bj][m][1] * rs1); }
                    } else {
                        bf16_t* dst = o.KTr() + ((size_t)(bh * 128 + kb16) * 2) * 512 + 4 * uu;
                        const f32x4 dk0 = *(const f32x4*)(o.DK() + head * 64 + (s0 & 63)), dk1 = *(const f32x4*)(o.DK() + head * 64 + (s0 & 63) + 4);
#pragma unroll
                        for (int m = 0; m < 2; ++m) { const int i = 16 * m + fr;
                            const f32x4* cp = (const f32x4*)(o.CST() + ((size_t)i * 2048 + s0) * 2);
                            const f32x4 c0 = cp[0], c1 = cp[1], c2 = cp[2], c3 = cp[3];
                            const f32x4 t10 = acc[ai][bj][m][0] * rs0, t11 = acc[ai][bj][m][1] * rs1, t20 = acc[ai][bj][m + 2][0] * rs0, t21 = acc[ai][bj][m + 2][1] * rs1;
                            f32x4 x0, x1, y0, y1;
                            x0[0] = (t10[0] * c0[0] - t20[0] * c0[1]) * dk0[0]; y0[0] = (t10[0] * c0[1] + t20[0] * c0[0]) * dk0[0]; x0[1] = (t10[1] * c0[2] - t20[1] * c0[3]) * dk0[1]; y0[1] = (t10[1] * c0[3] + t20[1] * c0[2]) * dk0[1];
                            x0[2] = (t10[2] * c1[0] - t20[2] * c1[1]) * dk0[2]; y0[2] = (t10[2] * c1[1] + t20[2] * c1[0]) * dk0[2]; x0[3] = (t10[3] * c1[2] - t20[3] * c1[3]) * dk0[3]; y0[3] = (t10[3] * c1[3] + t20[3] * c1[2]) * dk0[3];
                            x1[0] = (t11[0] * c2[0] - t21[0] * c2[1]) * dk1[0]; y1[0] = (t11[0] * c2[1] + t21[0] * c2[0]) * dk1[0]; x1[1] = (t11[1] * c2[2] - t21[1] * c2[3]) * dk1[1]; y1[1] = (t11[1] * c2[3] + t21[1] * c2[2]) * dk1[1];
                            x1[2] = (t11[2] * c3[0] - t21[2] * c3[1]) * dk1[2]; y1[2] = (t11[2] * c3[1] + t21[2] * c3[0]) * dk1[2]; x1[3] = (t11[3] * c3[2] - t21[3] * c3[3]) * dk1[3]; y1[3] = (t11[3] * c3[3] + t21[3] * c3[2]) * dk1[3];
                            bf16_t* p = dst + i * 8;
                            *(u32x2*)p = pack4(x0); *(u32x2*)(p + 256) = pack4(x1); *(u32x2*)(p + 512) = pack4(y0); *(u32x2*)(p + 512 + 256) = pack4(y1); }
                    }
                }
            }
        }
    }
};

template <class Epi, class Sched, bool ALIGN_EPI = false, bool SP2 = false>
__device__ __forceinline__ void gemm_phase(PG8_LAS unsigned char* lds, const int K, const Sched& S, const Epi& E, const int tid) {
    const int wid = __builtin_amdgcn_readfirstlane(tid >> 6), lane = tid & 63, wr = wid >> 2, wc = wid & 3, fr = lane & 15, fq = lane >> 4;
    const int nt = K / BK;
    unsigned voffA[2], voffB[2];
#pragma unroll
    for (int i = 0; i < 2; ++i) { int R, C; stage_rc(tid * 16 + i * 8192, R, C); const int Rb = Epi::PERM ? ((R & ~31) + perm32(R & 31)) : R;
        voffA[i] = (unsigned)(R * K + C) * 2u; voffB[i] = (unsigned)(Rb * K + C) * 2u; }
    const size_t kstep = (size_t)(BK * 2);
    const size_t hstep = (size_t)HALF * K * 2;
    const unsigned ldsw = (unsigned)wid * 1024u;
    const int aoff = lds_byte(wr * 64 + fr, fq * 8), boff = lds_byte(wc * 32 + fr, fq * 8);
#define PG8_SA(b, h) (((b) * 2 + (h)) * HTB)
#define PG8_SB(b, h) ((4 + (b) * 2 + (h)) * HTB)
#define PG8_STAGE(bufoff, gbase, voff) do { _Pragma("unroll") for (int _i = 0; _i < 2; ++_i) \
        __builtin_amdgcn_global_load_lds((const unsigned*)((const char*)(gbase) + (voff)[_i]), (PG8_LAS unsigned*)(lds + (bufoff) + ldsw + _i * 8192), 16, 0, 0); } while (0)
#define PG8_LDA(dst, b, h) do { _Pragma("unroll") for (int m = 0; m < 4; ++m) _Pragma("unroll") for (int k = 0; k < 2; ++k) dst[m][k] = *(const PG8_LAS bf16x8*)(lds + PG8_SA(b, h) + aoff + m * 2048 + k * 1024); } while (0)
#define PG8_LDB(dst, b, h) do { _Pragma("unroll") for (int n = 0; n < 2; ++n) _Pragma("unroll") for (int k = 0; k < 2; ++k) dst[n][k] = *(const PG8_LAS bf16x8*)(lds + PG8_SB(b, h) + boff + n * 2048 + k * 1024); } while (0)
#define PG8_MMA(ai, bj, At, Bt) do { __builtin_amdgcn_s_setprio(1); _Pragma("unroll") for (int m = 0; m < 4; ++m) _Pragma("unroll") for (int n = 0; n < 2; ++n) _Pragma("unroll") for (int k = 0; k < 2; ++k) \
        acc[ai][bj][m][n] = __builtin_amdgcn_mfma_f32_16x16x32_bf16(Bt[n][k], At[m][k], acc[ai][bj][m][n], 0, 0, 0); __builtin_amdgcn_s_setprio(0); } while (0)
#define PG8_WAIT_V(n) asm volatile("s_waitcnt vmcnt(" #n ")" ::: "memory")
#define PG8_WAIT_L(n) asm volatile("s_waitcnt lgkmcnt(" #n ")" ::: "memory")
#define PG8_BAR __builtin_amdgcn_s_barrier()
#define PG8_SCHED __builtin_amdgcn_sched_barrier(0)
    Unit cur, nxt; int ui = 0;
    if (!S.next(0, cur)) return;
    f32x4 acc[2][2][4][2];
#pragma unroll
    for (int a = 0; a < 2; ++a)
#pragma unroll
        for (int b = 0; b < 2; ++b)
#pragma unroll
            for (int m = 0; m < 4; ++m)
#pragma unroll
                for (int n = 0; n < 2; ++n) acc[a][b][m][n] = (f32x4){0.f, 0.f, 0.f, 0.f};
    bf16x8 At[4][2], B0[2][2], B1[2][2];
    const char* cA = S.a_ptr(cur); const char* cB = S.b_ptr(cur);
    S.a_ready(cur);
    if constexpr (SP2) {
        PG8_STAGE(PG8_SB(0, 0), cB, voffB); PG8_STAGE(PG8_SB(0, 1), cB + hstep, voffB); PG8_STAGE(PG8_SA(0, 0), cA, voffA); PG8_STAGE(PG8_SA(0, 1), cA + hstep, voffA);
        if (wr == 1) PG8_BAR;
        PG8_WAIT_V(2); PG8_BAR;
        PG8_STAGE(PG8_SB(1, 0), cB + kstep, voffB); PG8_STAGE(PG8_SA(1, 0), cA + kstep, voffA); PG8_STAGE(PG8_SB(1, 1), cB + hstep + kstep, voffB);
        PG8_WAIT_V(6); PG8_BAR;
    } else {
        PG8_STAGE(PG8_SB(0, 0), cB, voffB); PG8_STAGE(PG8_SA(0, 0), cA, voffA); PG8_STAGE(PG8_SB(0, 1), cB + hstep, voffB); PG8_STAGE(PG8_SA(0, 1), cA + hstep, voffA);
        if (wr == 1) PG8_BAR;
        PG8_WAIT_V(4); PG8_BAR;
        PG8_STAGE(PG8_SB(1, 0), cB + kstep, voffB); PG8_STAGE(PG8_SA(1, 0), cA + kstep, voffA); PG8_STAGE(PG8_SB(1, 1), cB + hstep + kstep, voffB);
        PG8_WAIT_V(6); PG8_BAR;
    }
    for (;;) {
        const bool has_next = S.next(ui + 1, nxt);
        const char* nA = has_next ? S.a_ptr(nxt) : cA; const char* nB = has_next ? S.b_ptr(nxt) : cB;
        for (int t = 0; t < nt; t += 2) {
            const bool last = (t == nt - 2);
            const char* a1 = cA + (size_t)(t + 1) * kstep;
            const char* a2 = last ? nA : cA + (size_t)(t + 2) * kstep; const char* b2 = last ? nB : cB + (size_t)(t + 2) * kstep;
            const char* a3 = a2 + kstep; const char* b3 = b2 + kstep;
            if (last && has_next) S.a_ready(nxt);
            if constexpr (SP2) {
            PG8_LDB(B0, 0, 0); PG8_LDB(B1, 0, 1); PG8_SCHED; PG8_LDA(At, 0, 0); PG8_STAGE(PG8_SA(1, 1), a1 + hstep, voffA);
            PG8_WAIT_V(8); PG8_WAIT_L(0); PG8_BAR; PG8_MMA(0, 0, At, B0); PG8_MMA(0, 1, At, B1); PG8_BAR; PG8_SCHED;
            PG8_LDA(At, 0, 1); PG8_STAGE(PG8_SB(0, 0), b2, voffB); PG8_STAGE(PG8_SB(0, 1), b2 + hstep, voffB); PG8_STAGE(PG8_SA(0, 0), a2, voffA);
            PG8_WAIT_V(8); PG8_WAIT_L(0); PG8_BAR; PG8_MMA(1, 0, At, B0); PG8_MMA(1, 1, At, B1); PG8_BAR; PG8_SCHED;
            PG8_LDB(B0, 1, 0); PG8_LDB(B1, 1, 1); PG8_SCHED; PG8_LDA(At, 1, 0); PG8_STAGE(PG8_SA(0, 1), a2 + hstep, voffA);
            PG8_WAIT_V(8); PG8_WAIT_L(0); PG8_BAR; PG8_MMA(0, 0, At, B0); PG8_MMA(0, 1, At, B1); PG8_BAR; PG8_SCHED;
            PG8_LDA(At, 1, 1); PG8_STAGE(PG8_SB(1, 0), b3, voffB); PG8_STAGE(PG8_SB(1, 1), b3 + hstep, voffB); PG8_STAGE(PG8_SA(1, 0), a3, voffA);
            PG8_WAIT_V(8); PG8_WAIT_L(0); PG8_BAR; PG8_MMA(1, 0, At, B0); PG8_MMA(1, 1, At, B1); PG8_BAR; PG8_SCHED;
            } else {
            PG8_LDB(B0, 0, 0); PG8_SCHED; PG8_LDA(At, 0, 0); PG8_STAGE(PG8_SA(1, 1), a1 + hstep, voffA);
            PG8_WAIT_L(8); PG8_BAR; PG8_WAIT_L(0); PG8_MMA(0, 0, At, B0); PG8_BAR; PG8_SCHED;
            PG8_LDB(B1, 0, 1); PG8_STAGE(PG8_SB(0, 0), b2, voffB);
            PG8_BAR; PG8_WAIT_L(0); PG8_MMA(0, 1, At, B1); PG8_BAR;
            PG8_LDA(At, 0, 1); PG8_STAGE(PG8_SA(0, 0), a2, voffA);
            PG8_BAR; PG8_WAIT_L(0); PG8_MMA(1, 0, At, B0); PG8_BAR; PG8_SCHED;
            PG8_STAGE(PG8_SB(0, 1), b2 + hstep, voffB);
            PG8_WAIT_V(6); PG8_BAR; PG8_MMA(1, 1, At, B1); PG8_BAR;
            PG8_LDB(B0, 1, 0); PG8_SCHED; PG8_LDA(At, 1, 0); PG8_STAGE(PG8_SA(0, 1), a2 + hstep, voffA);
            PG8_WAIT_L(8); PG8_BAR; PG8_WAIT_L(0); PG8_MMA(0, 0, At, B0); PG8_BAR; PG8_SCHED;
            PG8_LDB(B1, 1, 1); PG8_STAGE(PG8_SB(1, 0), b3, voffB);
            PG8_BAR; PG8_WAIT_L(0); PG8_MMA(0, 1, At, B1); PG8_BAR;
            PG8_LDA(At, 1, 1); PG8_STAGE(PG8_SA(1, 0), a3, voffA);
            PG8_BAR; PG8_WAIT_L(0); PG8_MMA(1, 0, At, B0); PG8_BAR; PG8_SCHED;
            PG8_STAGE(PG8_SB(1, 1), b3 + hstep, voffB);
            PG8_WAIT_V(6); PG8_BAR; PG8_MMA(1, 1, At, B1); PG8_BAR;
            }
        }
        if constexpr (ALIGN_EPI) { if (wr == 0) PG8_BAR; }
        if constexpr (!Epi::AFTER_DRAIN) { E(acc, cur, wr, wc, fr, fq); S.done(cur); }
        if (!has_next) break;
#pragma unroll
        for (int a = 0; a < 2; ++a)
#pragma unroll
            for (int b = 0; b < 2; ++b)
#pragma unroll
                for (int m = 0; m < 4; ++m)
#pragma unroll
                    for (int n = 0; n < 2; ++n) acc[a][b][m][n] = (f32x4){0.f, 0.f, 0.f, 0.f};
        cur = nxt; cA = nA; cB = nB; ++ui;
        if constexpr (ALIGN_EPI) { if (wr == 1) PG8_BAR; }
    }
    PG8_WAIT_V(0);
    if constexpr (!ALIGN_EPI) { if (wr == 0) PG8_BAR; }
    PG8_BAR;
    if constexpr (Epi::AFTER_DRAIN) { E.fused(acc, cur, wr, wc, fr, fq, lds, wid, lane); S.done(cur); }
#undef PG8_SA
#undef PG8_SB
#undef PG8_STAGE
#undef PG8_LDA
#undef PG8_LDB
#undef PG8_MMA
#undef PG8_WAIT_V
#undef PG8_WAIT_L
#undef PG8_BAR
#undef PG8_SCHED
}
}

constexpr int D_MODEL = 1024, BATCH = 8, SEQ = 2048, DEPTH = 4, CHUNK = 64, NLEFT = 8, HD = 64;
constexpr int D_ATT = 384, D_RET = 384, D_CONV = 256, H_ATT = 6, H_RET = 6, CONV_K = 31, REL_CLIP = 128;
constexpr int D_FF = 4096, D_PLE = 256, D_IN = 3200, M = BATCH * SEQ, NC = SEQ / CHUNK;
constexpr int NIN_ROWS = 15 * 256;
constexpr float EPS = 1e-6f;
constexpr int C_QA = 0, C_KA = 384, C_VA = 768, C_UC = 1152, C_QR = 1664, C_KR = 2048, C_VR = 2432, C_GR = 2816;
constexpr int NWAVES = 8;

constexpr size_t MiB = 1u << 20;
constexpr size_t WS_CTL = 0, CTL_ZERO_BYTES = 1 * MiB;
constexpr size_t WS_SS = 1 * MiB;
constexpr size_t WS_WBUF = 4 * MiB, WBUF_BYTES = 29 * MiB;
constexpr size_t WS_HB = 62 * MiB, HB_BYTES = 32 * MiB;
constexpr size_t WS_PLE = 126 * MiB;
constexpr size_t WS_PROJ = 158 * MiB;
constexpr size_t WS_MIX = 262 * MiB;
constexpr size_t WS_HID = 158 * MiB;
constexpr size_t WS_PB = 294 * MiB;
constexpr size_t WS_CS = 302 * MiB;
constexpr size_t WS_CST = WS_CS + 512 * 1024;
constexpr size_t WS_BT = 303 * MiB;
constexpr size_t WS_DK = WS_CS + 2 * MiB;
constexpr size_t WS_ST = 305 * MiB;
constexpr size_t WS_END = 318 * MiB;
constexpr size_t WO_WIN = 0, WO_WO = WO_WIN + (size_t)NIN_ROWS * 1024, WO_W1 = WO_WO + 1024 * 1024, WO_W2 = WO_W1 + 4096 * 1024, WO_WPG = WO_W2 + 4096 * 1024,
                 WO_WPLE = WO_WPG + 1024 * 1024, WO_PW = WO_WPLE + 1024 * 256, WO_END = WO_PW + 256 * 256;
static_assert(WO_END * 2 <= WBUF_BYTES, "weight buffer");
constexpr int CW_BAR = 4096, CW_QUEUE = 8192;

constexpr int RING_OFF = 0, RING_BYTES = 131072;
constexpr int LDSCTL_OFF = RING_BYTES, MISC_OFF = LDSCTL_OFF + 320;
constexpr int LDS_BYTES = 147456, PTR_OFF = LDSCTL_OFF + 1024;

#define GAS __attribute__((address_space(1)))
#define LAS __attribute__((address_space(3)))
typedef unsigned short bf16;
typedef unsigned v4u __attribute__((ext_vector_type(4)));
typedef float f32x4 __attribute__((ext_vector_type(4)));
typedef GAS unsigned gu32;
#define LDS_WAIT() asm volatile("s_waitcnt lgkmcnt(0)" ::: "memory")
__device__ __forceinline__ unsigned f2bf(float f) { unsigned u = __builtin_bit_cast(unsigned, f); return (u + 0x7fffu + ((u >> 16) & 1u)) >> 16; }
__device__ __forceinline__ unsigned pk2(float lo, float hi) { return f2bf(lo) | (f2bf(hi) << 16); }
__device__ __forceinline__ float bf2f(bf16 v) { return __uint_as_float((unsigned)v << 16); }

#define XB_TMO      128
#define XB_XCNT(j)  (256  + 64 * (j))
#define XB_XSUB(j)  (1280 + 64 * (j))
#define XB_XGEN(j)  (2304 + 64 * (j))
#define XB_TOP      3328
#define XB_TOPGEN   3392
#define XCD_BAR_WORDS 3456
#define XB_SPIN_CAP (1u << 18)

__device__ __forceinline__ unsigned xb_ld(unsigned* p)              { return __hip_atomic_load(p, __ATOMIC_RELAXED, __HIP_MEMORY_SCOPE_AGENT); }
__device__ __forceinline__ unsigned xb_add(unsigned* p, unsigned v) { return __hip_atomic_fetch_add(p, v, __ATOMIC_RELAXED, __HIP_MEMORY_SCOPE_AGENT); }
__device__ __forceinline__ unsigned xb_xcc_id() { return (unsigned)__builtin_amdgcn_s_getreg((3 << 11) | 20) & 0xFu; }
#define XB_SPIN(cond, bar) do { unsigned _sp = 0; while (cond) { __builtin_amdgcn_s_sleep(1); \
    if ((++_sp & 255u) == 0u) { if (xb_ld(&(bar)[XB_TMO])) break; if (_sp > XB_SPIN_CAP) { atomicAdd(&(bar)[XB_TMO], 1u); break; } } } } while (0)

struct XcdBarrier {
    unsigned* bar; unsigned x;
    volatile LAS unsigned* st;
};

__device__ __forceinline__ XcdBarrier xcd_barrier_post(unsigned* bar, volatile LAS unsigned* st) {
    XcdBarrier b; b.bar = bar; b.x = xb_xcc_id(); b.st = st;
    if (threadIdx.x == 0) (void)xb_add(&bar[XB_XCNT(b.x)], 1u);
    return b;
}
__device__ __forceinline__ void xcd_barrier_complete(unsigned* bar, unsigned x, unsigned& nloc, unsigned& nx) {
    const unsigned G = gridDim.x * gridDim.y * gridDim.z;
    unsigned sum, cnt, mine, sp = 0u;
    for (;;) {
        sum = 0u; cnt = 0u; mine = 0u;
#pragma unroll
        for (unsigned j = 0; j < 16; ++j) { const unsigned c = xb_ld(&bar[XB_XCNT(j)]); sum += c; cnt += (c > 0u) ? 1u : 0u; mine = (j == x) ? c : mine; }
        if (sum == G) break;
        __builtin_amdgcn_s_sleep(1);
        if ((++sp & 255u) == 0u) { if (xb_ld(&bar[XB_TMO])) break; if (sp > XB_SPIN_CAP) { atomicAdd(&bar[XB_TMO], 1u); break; } }
    }
    nloc = mine > 0u ? mine : 1u; nx = cnt > 0u ? cnt : 1u;
}

__device__ __forceinline__ void xcd_barrier(const XcdBarrier& b) {
    asm volatile("s_waitcnt vmcnt(0)" ::: "memory");
    __syncthreads();
    if (threadIdx.x == 0) {
        unsigned* bar = b.bar;
        __builtin_amdgcn_s_waitcnt(0);
        unsigned nloc = b.st[0], nx = b.st[1];
        if (nloc == 0u) { xcd_barrier_complete(bar, b.x, nloc, nx); b.st[0] = nloc; b.st[1] = nx; }
        const unsigned old = xb_add(&bar[XB_XSUB(b.x)], 1u);
        const unsigned gen = old / nloc;
        if (old + 1u == (gen + 1u) * nloc) {
            __builtin_amdgcn_fence(__ATOMIC_RELEASE, "agent");
            asm volatile("s_waitcnt vmcnt(0)" ::: "memory");
            const unsigned og = xb_add(&bar[XB_TOP], 1u);
            const unsigned tg = og / nx;
            if (og + 1u == (tg + 1u) * nx) xb_add(&bar[XB_TOPGEN], 1u);
            else XB_SPIN(xb_ld(&bar[XB_TOPGEN]) == tg, bar);
            __builtin_amdgcn_fence(__ATOMIC_ACQUIRE, "agent");
            xb_add(&bar[XB_XGEN(b.x)], 1u);
            asm volatile("s_waitcnt vmcnt(0)" ::: "memory");
        } else {
            XB_SPIN(xb_ld(&bar[XB_XGEN(b.x)]) == gen, bar);
            __builtin_amdgcn_fence(__ATOMIC_ACQUIRE, "agent");
            asm volatile("s_waitcnt vmcnt(0)" ::: "memory");
        }
    }
    __syncthreads();
}

__device__ __forceinline__ unsigned long long rfl64(unsigned long long v) { const unsigned lo = __builtin_amdgcn_readfirstlane((unsigned)v), hi = __builtin_amdgcn_readfirstlane((unsigned)(v >> 32)); return ((unsigned long long)hi << 32) | lo; }
struct Args { const float* in[21]; float* out; unsigned char* ws; int ph_lo, ph_hi; };
struct Frame {
    LAS unsigned char* lds; int tid, lane, wave, G, bid, gw, ngw, dup;
    float* H; unsigned char* ws;
    __device__ __forceinline__ const float* in(int k) const { return (const float*)(uintptr_t)rfl64(((LAS unsigned long long*)(lds + PTR_OFF))[k]); }
};
__device__ __forceinline__ float wave_sum(float v) {
#pragma unroll
    for (int o = 1; o < 64; o <<= 1) v += __shfl_xor(v, o);
    return v;
}
__device__ __forceinline__ float sigmoidf_(float x) { return 1.0f / (1.0f + expf(-x)); }

__host__ __device__ __forceinline__ int in_src_col(int nb) {
    const int T = nb >> 3, r = nb & 7;
    if (T < 3) { const int bj = r >> 2, g = 4 * T + (r & 3); return (g < 6 ? C_QA + 64 * g : C_KA + 64 * (g - 6)) + 32 * bj; }
    if (T < 5) { const int bj = r >> 2; return C_UC + 256 * bj + 128 * (T - 3) + 32 * (r & 3); }
    if (T < 10) { const int bj = r >> 2, g = 4 * (T - 5) + (r & 3); if (g >= 18) return -1; return (g < 6 ? C_QR + 64 * g : (g < 12 ? C_KR + 64 * (g - 6) : C_GR + 64 * (g - 12))) + 32 * bj; }
    { const int g = 4 * (T - 10) + (r >> 1); if (g >= 18) return -1; return (g < 6 ? C_VA + 64 * g : (g < 12 ? C_VR + 64 * (g - 6) : C_KR + 64 * (g - 12))) + 32 * (r & 1); }
}
__device__ __forceinline__ void transpose_item(const float* W, int K, int N, const float* gain, bf16* WT, LAS float* scr, int k0, int n0src, int n0dst, int lane) {
    if (n0src >= 0) {
        float v[32];
#pragma unroll
        for (int i = 0; i < 32; ++i) v[i] = W[(size_t)(k0 + 2 * i + (lane >> 5)) * N + n0src + (lane & 31)];
#pragma unroll
        for (int i = 0; i < 32; ++i) scr[(2 * i + (lane >> 5)) * 33 + (lane & 31)] = v[i];
    } else {
#pragma unroll 8
        for (int i = 0; i < 32; ++i) scr[(2 * i + (lane >> 5)) * 33 + (lane & 31)] = 0.f;
    }
    LDS_WAIT(); asm volatile("" ::: "memory");
    const int c = lane & 7;
    f32x4 g0 = {1.f, 1.f, 1.f, 1.f}, g1 = g0;
    if (gain) { g0 = *(const f32x4*)(gain + k0 + 8 * c); g1 = *(const f32x4*)(gain + k0 + 8 * c + 4); }
#pragma unroll
    for (int j = 0; j < 4; ++j) { const int n = (lane >> 3) + 8 * j; const LAS float* s = scr + (8 * c) * 33 + n;
        v4u o; o.x = pk2(s[0 * 33] * g0[0], s[1 * 33] * g0[1]); o.y = pk2(s[2 * 33] * g0[2], s[3 * 33] * g0[3]); o.z = pk2(s[4 * 33] * g1[0], s[5 * 33] * g1[1]); o.w = pk2(s[6 * 33] * g1[2], s[7 * 33] * g1[3]);
        *(GAS v4u*)(WT + (size_t)(n0dst + n) * K + k0 + 8 * c) = o; }
    LDS_WAIT(); asm volatile("" ::: "memory");
}
__device__ __forceinline__ void convert_layer(Frame& F, int L) {
    bf16* WB = (bf16*)(F.ws + WS_WBUF + (size_t)(L & 1) * WBUF_BYTES);
    LAS float* scr = (LAS float*)(F.lds + RING_OFF + F.wave * 16384);
    const float* w_in = F.in(3) + (size_t)L * 1024 * D_IN; const float* w_o = F.in(14) + (size_t)L * 1024 * 1024; const float* w1 = F.in(16) + (size_t)L * 1024 * 4096;
    const float* w2 = F.in(17) + (size_t)L * 4096 * 1024; const float* w_pg = F.in(19) + (size_t)L * 1024 * 1024; const float* w_ple = F.in(20) + (size_t)L * 256 * 1024;
    const float* pw = F.in(11) + (size_t)L * 256 * 256;
    const float* g_mix = F.in(2) + L * 1024; const float* g_ffn = F.in(15) + L * 1024; const float* g_ple = F.in(18) + L * 1024;
    constexpr int I_IN = 16 * (NIN_ROWS / 32), I_O = 16 * 32, I_1 = 16 * 128, I_2 = 64 * 32, I_PG = 16 * 32, I_PLE = 4 * 32, I_PW = 4 * 8;
    constexpr int NIT = I_IN + I_O + I_1 + I_2 + I_PG + I_PLE + I_PW;
    for (int it = F.gw; it < NIT; it += F.ngw) {
        int r = it;
        if (r < I_IN) { const int nb = r % (NIN_ROWS / 32), kb = r / (NIN_ROWS / 32); transpose_item(w_in, 1024, D_IN, g_mix, WB + WO_WIN, scr, 64 * kb, in_src_col(nb), 32 * nb, F.lane); continue; } r -= I_IN;
        if (r < I_O) { transpose_item(w_o, 1024, 1024, nullptr, WB + WO_WO, scr, 64 * (r / 32), 32 * (r % 32), 32 * (r % 32), F.lane); continue; } r -= I_O;
        if (r < I_1) { transpose_item(w1, 1024, 4096, g_ffn, WB + WO_W1, scr, 64 * (r / 128), 32 * (r % 128), 32 * (r % 128), F.lane); continue; } r -= I_1;
        if (r < I_2) { transpose_item(w2, 4096, 1024, nullptr, WB + WO_W2, scr, 64 * (r / 32), 32 * (r % 32), 32 * (r % 32), F.lane); continue; } r -= I_2;
        if (r < I_PG) { transpose_item(w_pg, 1024, 1024, g_ple, WB + WO_WPG, scr, 64 * (r / 32), 32 * (r % 32), 32 * (r % 32), F.lane); continue; } r -= I_PG;
        if (r < I_PLE) { transpose_item(w_ple, 256, 1024, nullptr, WB + WO_WPLE, scr, 64 * (r / 32), 32 * (r % 32), 32 * (r % 32), F.lane); continue; } r -= I_PLE;
        transpose_item(pw, 256, 256, nullptr, WB + WO_PW, scr, 64 * (r / 8), 32 * (r % 8), 32 * (r % 8), F.lane);
    }
}
__device__ __forceinline__ void sincos_acc(float ang, float& s, float& c) {
    const double x = (double)ang; const double kd = rint(x * 0.63661977236758134);
    const double r = (x - kd * 1.5707963267948966) - kd * 6.123233995736766e-17; const int q = ((int)kd) & 3; const double r2 = r * r;
    const double sp = r * (1.0 + r2 * (-1.0 / 6 + r2 * (1.0 / 120 + r2 * (-1.0 / 5040 + r2 * (1.0 / 362880 + r2 * (-1.0 / 39916800))))));
    const double cp = 1.0 + r2 * (-0.5 + r2 * (1.0 / 24 + r2 * (-1.0 / 720 + r2 * (1.0 / 40320 + r2 * (-1.0 / 3628800 + r2 * (1.0 / 479001600))))));
    double ss, cc;
    if (q == 0) { ss = sp; cc = cp; } else if (q == 1) { ss = cp; cc = -sp; } else if (q == 2) { ss = -sp; cc = -cp; } else { ss = -cp; cc = sp; }
    s = (float)ss; c = (float)cc;
}
__device__ __forceinline__ void convert_p(Frame& F, int L) {
    const GAS f32x4* p4 = (const GAS f32x4*)(F.in(1) + (size_t)L * M * D_PLE); GAS unsigned long long* o8 = (GAS unsigned long long*)(F.ws + WS_PB); const int n4 = M * D_PLE / 4;
    for (int i = F.bid * 512 + F.tid; i < n4; i += F.G * 512) { const f32x4 v = p4[i]; o8[i] = (unsigned long long)pk2(v.x, v.y) | ((unsigned long long)pk2(v.z, v.w) << 32); }
}
__device__ __forceinline__ float log_gamma(int h) { return logf(1.0f - exp2f(-5.0f - (float)h)); }
__device__ __forceinline__ void prologue(Frame& F) {
    convert_layer(F, 0); convert_p(F, 0);
    const float* x = F.in(0); bf16* HB = (bf16*)(F.ws + WS_HB); float* SS = (float*)(F.ws + WS_SS);
    for (int m = F.gw; m < M; m += F.ngw) {
        const GAS f32x4* xr = (const GAS f32x4*)(x + (size_t)m * 1024) + F.lane; GAS f32x4* hr = (GAS f32x4*)(F.H + (size_t)m * 1024) + F.lane;
        GAS unsigned long long* o8 = (GAS unsigned long long*)(HB + (size_t)m * 1024) + F.lane; float s = 0.f;
#pragma unroll
        for (int j = 0; j < 4; ++j) { const f32x4 v = xr[64 * j]; hr[64 * j] = v; s += (v.x * v.x + v.y * v.y) + (v.z * v.z + v.w * v.w);
            o8[64 * j] = (unsigned long long)pk2(v.x, v.y) | ((unsigned long long)pk2(v.z, v.w) << 32); }
        s = wave_sum(s);
        if (F.lane < 16) SS[(size_t)m * 16 + F.lane] = F.lane == 0 ? s : 0.f;
    }
    { float2* cs = (float2*)(F.ws + WS_CS); float2* cst = (float2*)(F.ws + WS_CST);
      for (int idx = F.bid * 512 + F.tid; idx < SEQ * 32; idx += F.G * 512) { const int pos = idx >> 5, i = idx & 31; const float inv_freq = powf(10000.0f, -(float)(2 * i) / 64.0f);
          float s, c; sincos_acc((float)pos * inv_freq, s, c); cs[idx] = make_float2(c, s); cst[i * SEQ + pos] = make_float2(c, s); } }
    { float* bt = (float*)(F.ws + WS_BT); const float* rbp = F.in(6);
      for (int idx = F.bid * 512 + F.tid; idx < DEPTH * H_ATT * 7 * 1024; idx += F.G * 512) { const int reg = idx & 15, ln = (idx >> 4) & 63, di = (idx >> 10) % 7, lh = idx / 7168;
          int rel = 32 * di - 32 + (ln & 31) - ((reg & 3) + 8 * (reg >> 2) + 4 * (ln >> 5)); rel = rel < -REL_CLIP ? -REL_CLIP : (rel > REL_CLIP ? REL_CLIP : rel);
          bt[idx] = rbp[lh * 257 + rel + REL_CLIP] * 1.4426950408889634f; } }
    { float* dk = (float*)(F.ws + WS_DK);
      for (int idx = F.bid * 512 + F.tid; idx < H_RET * 64; idx += F.G * 512) dk[idx] = expf(log_gamma(idx >> 6) * (float)(63 - (idx & 63))); }
}
typedef float f32x16 __attribute__((ext_vector_type(16)));
typedef short bf16x8 __attribute__((ext_vector_type(8)));
typedef unsigned u32x2 __attribute__((ext_vector_type(2)));
#define MFMA32(a, b, c) __builtin_amdgcn_mfma_f32_32x32x16_bf16((a), (b), (c), 0, 0, 0)
constexpr float LOG2E = 1.4426950408889634f;
__device__ __forceinline__ int crow(int r, int hi) { return (r & 3) + 8 * (r >> 2) + 4 * hi; }
typedef float f32x2_t __attribute__((ext_vector_type(2))); typedef __bf16 bf16x2_t __attribute__((ext_vector_type(2)));
__device__ __forceinline__ unsigned cvtpk(float lo, float hi) { f32x2_t v = {lo, hi}; bf16x2_t b = __builtin_convertvector(v, bf16x2_t); return __builtin_bit_cast(unsigned, b); }
template <int T8> __device__ __forceinline__ bf16x8 packfrag(const f32x16& x) {
    v4u p; p.x = cvtpk(x[8 * T8 + 0], x[8 * T8 + 1]); p.y = cvtpk(x[8 * T8 + 2], x[8 * T8 + 3]); p.z = cvtpk(x[8 * T8 + 4], x[8 * T8 + 5]); p.w = cvtpk(x[8 * T8 + 6], x[8 * T8 + 7]);
    return __builtin_bit_cast(bf16x8, p);
}
__device__ __forceinline__ f32x16 splat16(float v) { f32x16 r;
#pragma unroll
    for (int i = 0; i < 16; ++i) r[i] = v;
    return r; }
__device__ __forceinline__ float ex2(float x) { return __builtin_amdgcn_exp2f(x); }
constexpr size_t FRAG_T = 6291456;
__device__ __forceinline__ const bf16x8* ftok(const bf16* base, int bh, int blk, int lane) { return (const bf16x8*)(base + ((size_t)(bh * 64 + blk) * 4) * 512) + lane; }
__device__ __forceinline__ const bf16x8* fdim(const bf16* base, int bh, int kb16, int lane) { return (const bf16x8*)(base + ((size_t)(bh * 128 + kb16) * 2) * 512) + lane; }

constexpr int ATT_SLOT = 16384, ATT_NSLOT = 8;
__device__ __forceinline__ void attn_dma(const bf16* KF, const bf16* VF, int bh, int c, LAS unsigned char* ring, int w, int lane) {
    const int slot = c & (ATT_NSLOT - 1);
    const bf16x8* kg = ftok(KF, bh, 2 * c, lane) + 64 * w; const bf16x8* vg = fdim(VF, bh, 4 * c, lane) + 64 * w;
    __builtin_amdgcn_global_load_lds((const unsigned*)kg, (LAS unsigned*)(ring + slot * ATT_SLOT + w * 1024), 16, 0, 0);
    __builtin_amdgcn_global_load_lds((const unsigned*)vg, (LAS unsigned*)(ring + slot * ATT_SLOT + 8192 + w * 1024), 16, 0, 0);
}
template <bool TILE> __device__ __forceinline__ void attn_step(f32x16& o0, f32x16& o1, float& mrun, float& lsum, const bf16x8 (&qf)[4], const LAS unsigned char* slotp, const int lane,
                                                              const float cbias, const float* bt0, const float* bt1) {
    bf16x8 kf[8], vf[8];
    { const unsigned la = (unsigned)(uintptr_t)slotp + (unsigned)lane * 16u;
#define ATT_DSR(dst, off) asm volatile("ds_read_b128 %0, %1 offset:" #off : "=v"(dst) : "v"(la))
      ATT_DSR(kf[0], 0); ATT_DSR(kf[1], 1024); ATT_DSR(kf[2], 2048); ATT_DSR(kf[3], 3072); ATT_DSR(kf[4], 4096); ATT_DSR(kf[5], 5120); ATT_DSR(kf[6], 6144); ATT_DSR(kf[7], 7168);
      ATT_DSR(vf[0], 8192); ATT_DSR(vf[1], 9216); ATT_DSR(vf[2], 10240); ATT_DSR(vf[3], 11264); ATT_DSR(vf[4], 12288); ATT_DSR(vf[5], 13312); ATT_DSR(vf[6], 14336); ATT_DSR(vf[7], 15360);
#undef ATT_DSR
      asm volatile("s_waitcnt lgkmcnt(8)" : "+v"(kf[0]), "+v"(kf[1]), "+v"(kf[2]), "+v"(kf[3]), "+v"(kf[4]), "+v"(kf[5]), "+v"(kf[6]), "+v"(kf[7]));
      __builtin_amdgcn_sched_barrier(0); }
    f32x16 p0, p1;
    if constexpr (TILE) {
        const f32x4* bp = (const f32x4*)bt0; const f32x4* bq = (const f32x4*)bt1;
        const f32x4 t0 = bp[0], t1 = bp[1], t2 = bp[2], t3 = bp[3], u0 = bq[0], u1 = bq[1], u2 = bq[2], u3 = bq[3];
#pragma unroll
        for (int i = 0; i < 4; ++i) { p0[i] = t0[i]; p0[4 + i] = t1[i]; p0[8 + i] = t2[i]; p0[12 + i] = t3[i]; p1[i] = u0[i]; p1[4 + i] = u1[i]; p1[8 + i] = u2[i]; p1[12 + i] = u3[i]; }
    } else { p0 = splat16(cbias); p1 = p0; }
#pragma unroll
    for (int s = 0; s < 4; ++s) { p0 = MFMA32(kf[s], qf[s], p0); p1 = MFMA32(kf[4 + s], qf[s], p1); }
    float rm = fmaxf(p0[0], p1[0]);
#pragma unroll
    for (int r = 1; r < 16; ++r) rm = fmaxf(rm, fmaxf(p0[r], p1[r]));
    rm = fmaxf(rm, __shfl_xor(rm, 32));
    const float mn = fmaxf(mrun, rm), alpha = ex2(mrun - mn); mrun = mn;
    float ps = 0.f;
#pragma unroll
    for (int r = 0; r < 16; ++r) { p0[r] = ex2(p0[r] - mn); p1[r] = ex2(p1[r] - mn); ps += p0[r] + p1[r]; }
    lsum = lsum * alpha + ps;
#pragma unroll
    for (int r = 0; r < 16; ++r) { o0[r] *= alpha; o1[r] *= alpha; }
    asm volatile("s_waitcnt lgkmcnt(0)" : "+v"(vf[0]), "+v"(vf[1]), "+v"(vf[2]), "+v"(vf[3]), "+v"(vf[4]), "+v"(vf[5]), "+v"(vf[6]), "+v"(vf[7]));
    __builtin_amdgcn_sched_barrier(0);
    { bf16x8 pf;
      pf = packfrag<0>(p0); o0 = MFMA32(vf[0], pf, o0); o1 = MFMA32(vf[1], pf, o1);
      pf = packfrag<1>(p0); o0 = MFMA32(vf[2], pf, o0); o1 = MFMA32(vf[3], pf, o1);
      pf = packfrag<0>(p1); o0 = MFMA32(vf[4], pf, o0); o1 = MFMA32(vf[5], pf, o1);
      pf = packfrag<1>(p1); o0 = MFMA32(vf[6], pf, o0); o1 = MFMA32(vf[7], pf, o1); }
}
__device__ __forceinline__ void attn_block_unit(Frame& F, const bf16* QF, const bf16* KF, const bf16* VF, const float* BT, const float* rb, bf16* MIX, int bh, int n0) {
    const int w = F.wave, lane = F.lane, hi = lane >> 5, q = lane & 31, jn = w >> 1, qh = w & 1, n = n0 + jn, h = bh % 6, b = bh / 6;
    LAS unsigned char* ring = F.lds + RING_OFF;
    bf16x8 qf[4];
    { const bf16x8* qp = ftok(QF, bh, n * 2 + qh, lane);
#pragma unroll
      for (int s = 0; s < 4; ++s) qf[s] = qp[64 * s]; }
    f32x16 o0 = splat16(0.f), o1 = splat16(0.f); float mrun = -1e30f, lsum = 0.f;
    const float cbias = rb[h * 257 + 256] * LOG2E;
    const int t0 = 5 - n0 < 0 ? 0 : 5 - n0;
    const int cmin = n0 - 8 < 0 ? 0 : n0 - 8, NB = n0 + 4 - cmin;
    int nis = 0;
    for (; nis < NB && nis <= n0 - 5 + t0 - cmin + 2; ++nis) attn_dma(KF, VF, bh, cmin + nis, ring, w, lane);
    for (int t = t0; t <= 8; ++t) {
        if (t <= 6) asm volatile("s_waitcnt vmcnt(4) lgkmcnt(0)\n\ts_barrier" ::: "memory"); else asm volatile("s_waitcnt vmcnt(0) lgkmcnt(0)\n\ts_barrier" ::: "memory");
        if (nis < NB && nis <= n0 - 5 + t - cmin + 3) { attn_dma(KF, VF, bh, cmin + nis, ring, w, lane); ++nis; }
        const int c = n - 8 + t;
        if (c >= 0) {
            const LAS unsigned char* slotp = ring + (c & (ATT_NSLOT - 1)) * ATT_SLOT;
            if (t < 6) attn_step<false>(o0, o1, mrun, lsum, qf, slotp, lane, cbias, nullptr, nullptr);
            else { const int D0 = 64 * (8 - t) + 32 * qh, D1 = D0 - 32; const int i0 = D0 >= 160 ? 6 : (D0 + 32) >> 5, i1 = D1 >= 160 ? 6 : (D1 + 32) >> 5;
                   attn_step<true>(o0, o1, mrun, lsum, qf, slotp, lane, cbias, BT + ((size_t)(h * 7 + i0) * 64 + lane) * 16, BT + ((size_t)(h * 7 + i1) * 64 + lane) * 16); }
        }
    }
    lsum += __shfl_xor(lsum, 32);
    const float inv = 1.0f / lsum;
    bf16* op = MIX + (size_t)(b * SEQ + n * CHUNK + qh * 32 + q) * 1024 + h * 64 + 4 * hi;
#pragma unroll
    for (int g = 0; g < 4; ++g) { u32x2 wv;
        wv.x = cvtpk(o0[4 * g] * inv, o0[4 * g + 1] * inv); wv.y = cvtpk(o0[4 * g + 2] * inv, o0[4 * g + 3] * inv); *(u32x2*)(op + 8 * g) = wv;
        wv.x = cvtpk(o1[4 * g] * inv, o1[4 * g + 1] * inv); wv.y = cvtpk(o1[4 * g + 2] * inv, o1[4 * g + 3] * inv); *(u32x2*)(op + 32 + 8 * g) = wv; }
    __syncthreads();
}
__device__ __forceinline__ void ret_state_unit(Frame& F, const bf16* KTr, const bf16* VFr, bf16* STg, int bh) {
    const int w = F.wave, lane = F.lane, tid = F.tid, hi = lane >> 5, cq = lane & 31, h = bh % 6, jc = w >> 1, hw = w & 1;
    LAS float* KVS = (LAS float*)(F.lds + RING_OFF);
    const float dec = expf(log_gamma(h) * 64.0f);
    const int se = tid >> 3, sd = tid & 7;
    const int st_off = ((((se >> 5) * 4 + (sd >> 1)) * 64 + (sd & 1) * 32 + (se & 31)) * 8);
    f32x4 st0 = {0.f, 0.f, 0.f, 0.f}, st1 = st0;
    bf16x8 kk[8], vv[4];
    { const bf16x8* kp = fdim(KTr, bh, 4 * jc, lane); const bf16x8* vp = fdim(VFr, bh, 4 * jc, lane) + 64 * hw;
#pragma unroll
      for (int s = 0; s < 4; ++s) { kk[2 * s] = kp[128 * s]; kk[2 * s + 1] = kp[128 * s + 64]; vv[s] = vp[128 * s]; } }
    for (int r = 0; r < 8; ++r) {
        f32x16 a0 = splat16(0.f), a1 = splat16(0.f);
#pragma unroll
        for (int s = 0; s < 4; ++s) { a0 = MFMA32(vv[s], kk[2 * s], a0); a1 = MFMA32(vv[s], kk[2 * s + 1], a1); }
        if (r < 7) { const int n1 = 4 * (r + 1) + jc; const bf16x8* kp = fdim(KTr, bh, 4 * n1, lane); const bf16x8* vp = fdim(VFr, bh, 4 * n1, lane) + 64 * hw;
#pragma unroll
          for (int s = 0; s < 4; ++s) { kk[2 * s] = kp[128 * s]; kk[2 * s + 1] = kp[128 * s + 64]; vv[s] = vp[128 * s]; } }
        { LAS float* out = KVS + jc * 4096 + 32 * hw * 64 + cq;
#pragma unroll
          for (int i = 0; i < 16; ++i) { const int e = crow(i, hi); out[e * 64] = a0[i]; out[e * 64 + 32] = a1[i]; } }
        __syncthreads();
#pragma unroll
        for (int j = 0; j < 4; ++j) {
            v4u pk; pk.x = cvtpk(st0[0], st0[1]); pk.y = cvtpk(st0[2], st0[3]); pk.z = cvtpk(st1[0], st1[1]); pk.w = cvtpk(st1[2], st1[3]);
            *(v4u*)(STg + ((size_t)(bh * 32 + 4 * r + j)) * 4096 + st_off) = pk;
            const LAS float* kvp = KVS + j * 4096 + se * 64 + 8 * sd; const f32x4 x0 = *(const LAS f32x4*)kvp, x1 = *(const LAS f32x4*)(kvp + 4);
            st0 = st0 * dec + x0; st1 = st1 * dec + x1; }
        __syncthreads();
    }
}
__device__ __forceinline__ void rout_unit(const bf16* QFr, const bf16* KFr, const bf16* VFr, const bf16* STg, const bf16* G, const float* gn_g, bf16* MIX, int b, int h, int n, int ch, int lane) {
    const int bh = b * 6 + h, hi = lane >> 5, cq = lane & 31, cc = 32 * ch + cq;
    const float lg2 = log_gamma(h) * LOG2E;
    const size_t token = (size_t)b * SEQ + n * CHUNK + cc;
    bf16x8 qf[4], kf[8], vf[8], sf[8]; u32x2 gw[8];
    { const bf16x8* qp = ftok(QFr, bh, n * 2 + ch, lane); const bf16x8* kp = ftok(KFr, bh, n * 2, lane); const bf16x8* vp = fdim(VFr, bh, 4 * n, lane);
      const bf16x8* sp = (const bf16x8*)(STg + ((size_t)(bh * 32 + n)) * 4096) + lane;
      const bf16* gp = G + token * 384 + h * 64 + 4 * hi;
#pragma unroll
      for (int s = 0; s < 4; ++s) qf[s] = qp[64 * s];
#pragma unroll
      for (int s = 0; s < 8; ++s) kf[s] = kp[64 * s];
#pragma unroll
      for (int s = 0; s < 8; ++s) sf[s] = sp[64 * s];
#pragma unroll
      for (int s = 0; s < 8; ++s) vf[s] = vp[64 * s];
#pragma unroll
      for (int g = 0; g < 4; ++g) { gw[g] = *(const u32x2*)(gp + 8 * g); gw[4 + g] = *(const u32x2*)(gp + 32 + 8 * g); } }
    f32x16 s0 = splat16(0.f), s1 = splat16(0.f);
#pragma unroll
    for (int s = 0; s < 4; ++s) { s0 = MFMA32(kf[s], qf[s], s0); s1 = MFMA32(kf[4 + s], qf[s], s1); }
#pragma unroll
    for (int i = 0; i < 16; ++i) { const int m0 = crow(i, hi); const int d0 = cc - m0, d1 = cc - m0 - 32;
        s0[i] *= ex2(lg2 * (float)(d0 < 0 ? -d0 : d0)); s1[i] *= ex2(lg2 * (float)(d1 < 0 ? -d1 : d1)); }
    f32x16 o0 = splat16(0.f), o1 = splat16(0.f);
#pragma unroll
    for (int s = 0; s < 4; ++s) { o0 = MFMA32(sf[s], qf[s], o0); o1 = MFMA32(sf[4 + s], qf[s], o1); }
    { const float qd = ex2(lg2 * (float)(cc + 1));
#pragma unroll
      for (int i = 0; i < 16; ++i) { o0[i] *= qd; o1[i] *= qd; } }
    { bf16x8 pf;
      pf = packfrag<0>(s0); o0 = MFMA32(vf[0], pf, o0); o1 = MFMA32(vf[1], pf, o1);
      pf = packfrag<1>(s0); o0 = MFMA32(vf[2], pf, o0); o1 = MFMA32(vf[3], pf, o1);
      pf = packfrag<0>(s1); o0 = MFMA32(vf[4], pf, o0); o1 = MFMA32(vf[5], pf, o1);
      pf = packfrag<1>(s1); o0 = MFMA32(vf[6], pf, o0); o1 = MFMA32(vf[7], pf, o1); }
    float sm = 0.f;
#pragma unroll
    for (int i = 0; i < 16; ++i) sm += o0[i] + o1[i];
    sm += __shfl_xor(sm, 32); const float mu = sm * (1.0f / 64.0f);
    float vr = 0.f;
#pragma unroll
    for (int i = 0; i < 16; ++i) { o0[i] -= mu; o1[i] -= mu; vr += o0[i] * o0[i] + o1[i] * o1[i]; }
    vr += __shfl_xor(vr, 32); const float rstd = rsqrtf(vr * (1.0f / 64.0f) + EPS);
    const float* gg = gn_g + h * 64 + 4 * hi; bf16* op = MIX + token * 1024 + D_ATT + D_CONV + h * 64 + 4 * hi;
#pragma unroll
    for (int g = 0; g < 4; ++g) {
        { const f32x4 gn = *(const f32x4*)(gg + 8 * g); u32x2 wv;
          wv.x = cvtpk(o0[4 * g] * rstd * gn[0] * __uint_as_float(gw[g].x << 16), o0[4 * g + 1] * rstd * gn[1] * __uint_as_float(gw[g].x & 0xffff0000u));
          wv.y = cvtpk(o0[4 * g + 2] * rstd * gn[2] * __uint_as_float(gw[g].y << 16), o0[4 * g + 3] * rstd * gn[3] * __uint_as_float(gw[g].y & 0xffff0000u)); *(u32x2*)(op + 8 * g) = wv; }
        { const f32x4 gn = *(const f32x4*)(gg + 32 + 8 * g); u32x2 wv;
          wv.x = cvtpk(o1[4 * g] * rstd * gn[0] * __uint_as_float(gw[4 + g].x << 16), o1[4 * g + 1] * rstd * gn[1] * __uint_as_float(gw[4 + g].x & 0xffff0000u));
          wv.y = cvtpk(o1[4 * g + 2] * rstd * gn[2] * __uint_as_float(gw[4 + g].y << 16), o1[4 * g + 3] * rstd * gn[3] * __uint_as_float(gw[4 + g].y & 0xffff0000u)); *(u32x2*)(op + 32 + 8 * g) = wv; }
    }
}
__device__ __forceinline__ float dpp_sum8(float v) {
    v += __builtin_bit_cast(float, __builtin_amdgcn_update_dpp(0, __builtin_bit_cast(int, v), 0xB1, 0xF, 0xF, true));
    v += __builtin_bit_cast(float, __builtin_amdgcn_update_dpp(0, __builtin_bit_cast(int, v), 0x4E, 0xF, 0xF, true));
    v += __builtin_bit_cast(float, __builtin_amdgcn_update_dpp(0, __builtin_bit_cast(int, v), 0x141, 0xF, 0xF, true));
    return v;
}
__device__ __forceinline__ void conv_unit(Frame& F, int L, int unit, const bf16* GLU, const bf16* PWT, bf16* MIX) {
    const float* cw = F.in(7) + L * CONV_K * 256; const float* cb = F.in(8) + L * 256; const float* lng = F.in(9) + L * 256; const float* lnb = F.in(10) + L * 256; const float* pwb = F.in(12) + L * 256;
    LAS unsigned char* lds = F.lds + RING_OFF; LAS float* Y = (LAS float*)(lds + 49152);
    const int t0 = unit * 64, s0 = t0 & 2047, tid = F.tid, lane = F.lane, w = F.wave;
    const int cp = tid & 127, tg = tid >> 7;
    f32x2_t wv[31];
#pragma unroll
    for (int j = 0; j < 31; ++j) wv[j] = *(const f32x2_t*)(cw + j * 256 + 2 * cp);
    const f32x2_t bb = *(const f32x2_t*)(cb + 2 * cp);
    for (int i = tid; i < 94 * 32; i += 512) { const int r = i >> 5, c16 = i & 31; v4u v = {0u, 0u, 0u, 0u};
        if (s0 - 30 + r >= 0) v = *(const v4u*)(GLU + (size_t)(t0 - 30 + r) * 256 + c16 * 8);
        *(LAS v4u*)(lds + r * 512 + c16 * 16) = v; }
    __syncthreads();
    { unsigned win[46];
#pragma unroll
      for (int i = 0; i < 46; ++i) win[i] = *(const LAS unsigned*)(lds + (tg * 16 + i) * 512 + cp * 4);
#pragma unroll
      for (int tt = 0; tt < 16; ++tt) { f32x2_t a = bb;
#pragma unroll
          for (int j = 0; j < 31; ++j) { const f32x2_t x = {__uint_as_float(win[tt + j] << 16), __uint_as_float(win[tt + j] & 0xffff0000u)}; a = __builtin_elementwise_fma(x, wv[j], a); }
          *(LAS f32x2_t*)(Y + (tg * 16 + tt) * 256 + 2 * cp) = a; } }
    const int hi = lane >> 5;
    bf16x8 Af[16];
    { const bf16* ap = PWT + (size_t)(32 * w + (lane & 31)) * 256 + 8 * hi;
#pragma unroll
      for (int s = 0; s < 16; ++s) Af[s] = *(const bf16x8*)(ap + 16 * s); }
    __syncthreads();
    { const int t = tid >> 3, p = tid & 7;
      f32x4 v[8]; float sm = 0.f;
#pragma unroll
      for (int i = 0; i < 8; ++i) { v[i] = *(const LAS f32x4*)(Y + t * 256 + 32 * p + 4 * i); sm += (v[i].x + v[i].y) + (v[i].z + v[i].w); }
      const float mu = dpp_sum8(sm) * (1.f / 256.f); float q = 0.f;
#pragma unroll
      for (int i = 0; i < 8; ++i) { v[i] = v[i] - mu; q += (v[i].x * v[i].x + v[i].y * v[i].y) + (v[i].z * v[i].z + v[i].w * v[i].w); }
      const float r = rsqrtf(dpp_sum8(q) * (1.f / 256.f) + EPS);
#pragma unroll
      for (int c8 = 0; c8 < 4; ++c8) {
          const f32x4 g0 = *(const f32x4*)(lng + 32 * p + 8 * c8), g1 = *(const f32x4*)(lng + 32 * p + 8 * c8 + 4), b0 = *(const f32x4*)(lnb + 32 * p + 8 * c8), b1 = *(const f32x4*)(lnb + 32 * p + 8 * c8 + 4);
          f32x4 o0 = v[2 * c8] * r * g0 + b0, o1 = v[2 * c8 + 1] * r * g1 + b1;
#pragma unroll
          for (int j = 0; j < 4; ++j) { o0[j] *= pg8::sigm(o0[j]); o1[j] *= pg8::sigm(o1[j]); }
          v4u pk; pk.x = cvtpk(o0[0], o0[1]); pk.y = cvtpk(o0[2], o0[3]); pk.z = cvtpk(o1[0], o1[1]); pk.w = cvtpk(o1[2], o1[3]);
          *(LAS v4u*)(lds + ((((t >> 5) * 16 + 2 * p + (c8 >> 1)) * 64 + (c8 & 1) * 32 + (t & 31)) * 16)) = pk; } }
    __syncthreads();
    { f32x16 a0 = splat16(0.f), a1 = splat16(0.f);
#pragma unroll
      for (int s = 0; s < 16; ++s) { const bf16x8 B0 = *(const LAS bf16x8*)(lds + (s * 64 + lane) * 16), B1 = *(const LAS bf16x8*)(lds + ((16 + s) * 64 + lane) * 16);
          a0 = MFMA32(Af[s], B0, a0); a1 = MFMA32(Af[s], B1, a1); }
      bf16* op = MIX + (size_t)(t0 + (lane & 31)) * 1024 + D_ATT + 32 * w + 4 * hi; const float* bp = pwb + 32 * w + 4 * hi;
#pragma unroll
      for (int g = 0; g < 4; ++g) { const f32x4 bv = *(const f32x4*)(bp + 8 * g); u32x2 x;
          x.x = cvtpk(a0[4 * g] + bv[0], a0[4 * g + 1] + bv[1]); x.y = cvtpk(a0[4 * g + 2] + bv[2], a0[4 * g + 3] + bv[3]); *(u32x2*)(op + 8 * g) = x;
          x.x = cvtpk(a1[4 * g] + bv[0], a1[4 * g + 1] + bv[1]); x.y = cvtpk(a1[4 * g + 2] + bv[2], a1[4 * g + 3] + bv[3]); *(u32x2*)(op + 32 * 1024 + 8 * g) = x; } }
    __syncthreads();
}

template <int SUB> __device__ __forceinline__ void layer_phase(Frame& F, const int L) {
    bf16* HBP = (bf16*)(F.ws + WS_HB + (size_t)(L & 1) * HB_BYTES); bf16* HBQ = (bf16*)(F.ws + WS_HB + (size_t)((L + 1) & 1) * HB_BYTES);
    float* SS0 = (float*)(F.ws + WS_SS); float* SS1 = SS0 + (size_t)M * 16; float* SS2 = SS1 + (size_t)M * 16;
    bf16* PJ = (bf16*)(F.ws + WS_PROJ); bf16* MIX = (bf16*)(F.ws + WS_MIX);
    bf16 *QFa = PJ, *KFa = PJ + FRAG_T, *VFa = PJ + 2 * FRAG_T, *QFr = PJ + 3 * FRAG_T, *KFr = PJ + 4 * FRAG_T, *KTr = PJ + 5 * FRAG_T, *VFr = PJ + 6 * FRAG_T, *GG = PJ + 7 * FRAG_T, *GLU = PJ + 8 * FRAG_T;
    bf16* HID = (bf16*)(F.ws + WS_HID); bf16* PLE = (bf16*)(F.ws + WS_PLE);
    const bf16* WB = (const bf16*)(F.ws + WS_WBUF + (size_t)(L & 1) * WBUF_BYTES);
    if constexpr (SUB == 0) {
        pg8::InProjOrder S; S.init(M, NIN_ROWS, 1024, F.G, F.bid, HBP, WB + WO_WIN);
        pg8::EpiInProj E{{PJ, SS0, F.in(4) + L * 64, F.in(5) + L * 64, F.ws + WS_CS}};
        pg8::gemm_phase<pg8::EpiInProj, pg8::InProjOrder, true, true>(F.lds + RING_OFF, 1024, S, E, F.tid);
        if (F.G == 256) {
            __syncthreads();
            pg8::PleOrder S2; S2.init(F.bid, (const bf16*)(F.ws + WS_PB), WB + WO_WPLE);
            pg8::EpiBf16<0, false> E2{PLE, 1024, nullptr};
            int wv2 = F.wave; asm volatile("" : "+s"(wv2));
            const int t2 = wv2 * 64 + (int)__builtin_amdgcn_mbcnt_hi(~0u, __builtin_amdgcn_mbcnt_lo(~0u, 0u));
            int kk = 256; asm volatile("" : "+s"(kk));
            pg8::gemm_phase<pg8::EpiBf16<0, false>, pg8::PleOrder, false, true>(F.lds + RING_OFF, kk, S2, E2, t2);
        }
    } else if constexpr (SUB == 1 || SUB == 2) {
        constexpr int ATT_M1 = 192;
        const float* bt = (const float*)(F.ws + WS_BT) + (size_t)L * H_ATT * 7 * 1024; const float* rb = F.in(6) + L * H_ATT * 257; const float* gn = F.in(13) + L * D_RET;
        bf16* STg = (bf16*)(F.ws + WS_ST);
        gu32* qctr = (gu32*)(F.ws + WS_CTL) + CW_QUEUE + 64 * L + 16 * (SUB - 1) + 32 * F.dup;
        volatile LAS unsigned* qslot = (volatile LAS unsigned*)(F.lds + MISC_OFF) + 16;
        constexpr int NITEMS = SUB == 1 ? 48 + 256 + ATT_M1 : 384 + (384 - ATT_M1);
        for (;;) {
            __syncthreads();
            if (F.tid == 0) *qslot = __hip_atomic_fetch_add(qctr, 1u, __ATOMIC_RELAXED, __HIP_MEMORY_SCOPE_AGENT);
            __syncthreads();
            const int it = (int)__builtin_amdgcn_readfirstlane(*qslot);
            if (it >= NITEMS) break;
            Frame F2 = F; { int t_ = F.tid; asm volatile("" : "+v"(t_)); F2.tid = t_; F2.lane = t_ & 63; }
            int au = -1;
            if constexpr (SUB == 1) {
                if (it < 48) ret_state_unit(F2, KTr, VFr, STg, it);
                else if (it < 48 + ATT_M1) au = it - 48;
                else conv_unit(F2, L, it - 48 - ATT_M1, GLU, WB + WO_PW, MIX);
            } else {
                if (it < 384 - ATT_M1) au = ATT_M1 + it;
                else { const int u = it - (384 - ATT_M1), bh = u >> 3, n = 4 * (u & 7) + (F2.wave >> 1); rout_unit(QFr, KFr, VFr, STg, GG, gn, MIX, bh / 6, bh % 6, n, F2.wave & 1, F2.lane); }
            }
            if (au >= 0) { int grp, bh; if (au < 288) { grp = 2 + au / 48; bh = au % 48; } else { grp = 1 - (au - 288) / 48; bh = (au - 288) % 48; }
                attn_block_unit(F2, QFa, KFa, VFa, bt, rb, MIX, bh, 4 * grp); }
        }
        __syncthreads();
        if constexpr (SUB == 2) { if (L + 1 < DEPTH) { convert_p(F, L + 1); convert_layer(F, L + 1); } }
    } else if constexpr (SUB == 3) {
        pg8::StaticOrder S; S.init(M, 1024, 1024, F.G, F.bid, MIX, WB + WO_WO);
        pg8::EpiRes<false> E{F.H, HBQ, SS1, nullptr, nullptr};
        pg8::gemm_phase<pg8::EpiRes<false>, pg8::StaticOrder, false, true>(F.lds + RING_OFF, 1024, S, E, F.tid);
    } else if constexpr (SUB == 4) {
        pg8::StaticOrder S; S.init(M, 4096, 1024, F.G, F.bid, HBQ, WB + WO_W1);
        pg8::EpiBf16<1, true> E{HID, 4096, SS1};
        pg8::gemm_phase<pg8::EpiBf16<1, true>, pg8::StaticOrder, true, true>(F.lds + RING_OFF, 1024, S, E, F.tid);
    } else if constexpr (SUB == 5) {
        pg8::StaticOrder S; S.init(M, 1024, 4096, F.G, F.bid, HID, WB + WO_W2);
        pg8::EpiRes<false> E{F.H, HBP, SS2, nullptr, nullptr};
        pg8::gemm_phase<pg8::EpiRes<false>, pg8::StaticOrder, false, true>(F.lds + RING_OFF, 4096, S, E, F.tid);
    } else {
        if (F.G != 256) { pg8::StaticOrder S; S.init(M, 1024, 256, F.G, F.bid, (const bf16*)(F.ws + WS_PB), WB + WO_WPLE);
          pg8::EpiBf16<0, false> E{PLE, 1024, nullptr};
          pg8::gemm_phase<pg8::EpiBf16<0, false>, pg8::StaticOrder, false, true>(F.lds + RING_OFF, 256, S, E, F.tid); }
        __syncthreads();
        { pg8::StaticOrder S; S.init(M, 1024, 1024, F.G, F.bid, HBP, WB + WO_WPG);
          pg8::EpiRes<true> E{F.H, HBQ, SS0, SS2, PLE};
          pg8::gemm_phase<pg8::EpiRes<true>, pg8::StaticOrder, false, true>(F.lds + RING_OFF, 1024, S, E, F.tid); }
    }
}
constexpr int PH_PER_LAYER = 7, N_PHASES = 1 + PH_PER_LAYER * DEPTH;
__global__ void __launch_bounds__(NWAVES * 64, 2) mk_fwd(Args args) {
    extern __shared__ __attribute__((aligned(16))) unsigned char lds[];
    LAS unsigned char* const ldsb = (LAS unsigned char*)lds;
    for (int u = threadIdx.x; u < (LDS_BYTES - LDSCTL_OFF) / 4; u += NWAVES * 64) ((LAS unsigned*)(ldsb + LDSCTL_OFF))[u] = 0u;
    __syncthreads();
    if (threadIdx.x == 0) {
        LAS unsigned long long* P = (LAS unsigned long long*)(ldsb + PTR_OFF);
#pragma unroll
        for (int i = 0; i < 21; ++i) P[i] = (unsigned long long)(uintptr_t)args.in[i];
        P[21] = (unsigned long long)(uintptr_t)args.out; P[22] = (unsigned long long)(uintptr_t)args.ws;
    }
    __syncthreads();
    XcdBarrier bar; { unsigned char* ws0 = args.ws; bar.bar = (unsigned*)(ws0 + WS_CTL) + CW_BAR; bar.x = 0; bar.st = nullptr;
    const bool multi = (args.ph_hi - args.ph_lo) > 1;
    if (multi) bar = xcd_barrier_post((unsigned*)(ws0 + WS_CTL) + CW_BAR, (volatile LAS unsigned*)(ldsb + MISC_OFF) + 8); }
    const int lo = args.ph_lo, hi = args.ph_hi;
    const int wave0 = __builtin_amdgcn_readfirstlane(threadIdx.x >> 6);
#define FRAME_INIT() \
        int wv_ = wave0, bid_ = blockIdx.x; asm volatile("" : "+s"(wv_)); asm volatile("" : "+s"(bid_)); \
        int tid_ = wv_ * 64 + (int)__builtin_amdgcn_mbcnt_hi(~0u, __builtin_amdgcn_mbcnt_lo(~0u, 0u)); \
        Frame F; F.lds = ldsb; F.tid = tid_; F.lane = tid_ & 63; F.wave = __builtin_amdgcn_readfirstlane(tid_ >> 6); \
        F.G = gridDim.x; F.bid = bid_; F.gw = F.bid * NWAVES + F.wave; F.ngw = F.G * NWAVES; F.dup = 0; \
        { LAS unsigned long long* P = (LAS unsigned long long*)(ldsb + PTR_OFF); \
          F.H = (float*)(uintptr_t)rfl64(P[21]); F.ws = (unsigned char*)(uintptr_t)rfl64(P[22]); }
#define GRID_BAR() do { XcdBarrier b2; b2.bar = (unsigned*)(F.ws + WS_CTL) + CW_BAR; b2.x = xb_xcc_id(); b2.st = (volatile LAS unsigned*)(F.lds + MISC_OFF) + 8; xcd_barrier(b2); } while (0)
#define RUN_PHASE(ph, call) if (lo <= (ph) && (ph) < hi) { FRAME_INIT(); call; if ((ph) + 1 < hi) GRID_BAR(); }
#ifndef MK_DUP_SUB
#define MK_DUP_SUB -1
#endif
#define RUN_PHASE_L(ph, SUBI, L) if (lo <= (ph) && (ph) < hi) { FRAME_INIT(); layer_phase<SUBI>(F, (L)); if (SUBI == MK_DUP_SUB) { GRID_BAR(); F.dup = 1; layer_phase<SUBI>(F, (L)); } if ((ph) + 1 < hi) GRID_BAR(); }
    RUN_PHASE(0, prologue(F))
#define RUN_LAYER(L) \
    RUN_PHASE_L(1 + 7 * (L) + 0, 0, L) RUN_PHASE_L(1 + 7 * (L) + 1, 1, L) RUN_PHASE_L(1 + 7 * (L) + 2, 2, L) RUN_PHASE_L(1 + 7 * (L) + 3, 3, L) \
    RUN_PHASE_L(1 + 7 * (L) + 4, 4, L) RUN_PHASE_L(1 + 7 * (L) + 5, 5, L) RUN_PHASE_L(1 + 7 * (L) + 6, 6, L)
    RUN_LAYER(0) RUN_LAYER(1) RUN_LAYER(2) RUN_LAYER(3)
}

extern "C" void kernel_launch(void* const* d_in, const int* in_sizes, int n_in, void* d_out, int out_size, void* d_ws, size_t ws_size, hipStream_t stream) {
    static int grid = 0;
    if (grid == 0) {
        if (n_in != 21 || out_size != M * D_MODEL || ws_size < WS_END) { fprintf(stderr, "kernel_launch: unexpected shapes / workspace (%d inputs, out %d, ws %zu)\n", n_in, out_size, ws_size); grid = -1; return; }
        int dev = 0, cus = 0, per_cu = 0;
        if (hipGetDevice(&dev) != hipSuccess || hipDeviceGetAttribute(&cus, hipDeviceAttributeMultiprocessorCount, dev) != hipSuccess) { grid = -1; return; }
        if (hipFuncSetAttribute((const void*)mk_fwd, hipFuncAttributeMaxDynamicSharedMemorySize, LDS_BYTES) != hipSuccess) { fprintf(stderr, "kernel_launch: hipFuncSetAttribute failed\n"); grid = -1; return; }
        if (hipOccupancyMaxActiveBlocksPerMultiprocessor(&per_cu, (const void*)mk_fwd, NWAVES * 64, LDS_BYTES) != hipSuccess || per_cu < 1) { fprintf(stderr, "kernel_launch: occupancy query says %d\n", per_cu); per_cu = 1; }
        (void)hipGetLastError();
        grid = cus;
    }
    if (grid < 0) return;
    if (hipMemsetAsync((char*)d_ws + WS_CTL, 0, CTL_ZERO_BYTES, stream) != hipSuccess) return;
    Args a{};
    for (int i = 0; i < 21; ++i) a.in[i] = (const float*)d_in[i];
    a.out = (float*)d_out; a.ws = (unsigned char*)d_ws;
#if MK_PER_PHASE
    for (int ph = 0; ph < N_PHASES; ++ph) { a.ph_lo = ph; a.ph_hi = ph + 1; hipLaunchKernelGGL(mk_fwd, dim3(grid), dim3(NWAVES * 64), LDS_BYTES, stream, a); }
#else
    a.ph_lo = 0; a.ph_hi = N_PHASES;
    void* kargs[] = {&a};
    hipError_t e = hipLaunchCooperativeKernel((const void*)mk_fwd, dim3(grid), dim3(NWAVES * 64), kargs, LDS_BYTES, stream);
    if (e != hipSuccess) fprintf(stderr, "kernel_launch: cooperative launch failed: %s (grid %d)\n", hipGetErrorString(e), grid);
#endif
}
```

```cpp
#include <hip/hip_runtime.h>
#include <cstdio>
#include <cstdint>

#ifndef MK_PER_PHASE
#define MK_PER_PHASE 0
#endif

namespace pg8 {
#define PG8_LAS __attribute__((address_space(3)))
typedef unsigned short bf16_t;
typedef short bf16x8 __attribute__((ext_vector_type(8)));
typedef float f32x4 __attribute__((ext_vector_type(4)));
typedef unsigned u32x4 __attribute__((ext_vector_type(4)));
constexpr int BM = 256, BK = 64, HALF = 128, HTB = HALF * BK * 2, STAGE_BYTES = 8 * HTB, NXCD = 8, WGM = 8;
__host__ __device__ __forceinline__ int lds_byte(int r, int c) { const int st = (r >> 4) * 2 + (c >> 5), rr = r & 15, cc = c & 31, ob = rr * 64 + cc * 2; return st * 1024 + (ob ^ (((ob >> 9) & 1) << 5)); }
__host__ __device__ __forceinline__ void stage_rc(int b, int& R, int& C) { const int st = b / 1024, sb = b % 1024, swz = sb ^ (((sb >> 9) & 1) << 5); R = (st >> 1) * 16 + swz / 64; C = (st & 1) * 32 + (swz % 64) / 2; }
__host__ __device__ __forceinline__ int perm32(int rho) { const int n = rho >> 4, i = rho & 15; return 8 * (i >> 2) + 4 * n + (i & 3); }
struct Unit { int pm, pn; };
struct StaticOrder {
    int nM, nN, nwg, G, c; const char* A; const char* Bt; size_t tstep;
    __device__ void init(int M, int N, int K, int G_, int c_, const void* A_, const void* Bt_) { nM = M / BM; nN = N / BM; nwg = nM * nN; G = G_; c = c_; A = (const char*)A_; Bt = (const char*)Bt_; tstep = (size_t)BM * K * 2; }
    __device__ bool next(int i, Unit& u) const {
        const long L = (long)i * G + c; if (L >= nwg) return false;
        int wgid = (int)L; { const int q = nwg / NXCD, r = nwg % NXCD, xcd = wgid % NXCD, off = wgid / NXCD; wgid = (xcd < r ? xcd * (q + 1) : r * (q + 1) + (xcd - r) * q) + off; }
        const int nig = WGM * nN, gid = wgid / nig, fm = gid * WGM, gsz = (nM - fm) < WGM ? (nM - fm) : WGM;
        u.pm = fm + ((wgid % nig) % gsz); u.pn = (wgid % nig) / gsz; return true;
    }
    __device__ __forceinline__ const char* a_ptr(const Unit& u) const { return A + (size_t)u.pm * tstep; }
    __device__ __forceinline__ const char* b_ptr(const Unit& u) const { return Bt + (size_t)u.pn * tstep; }
    __device__ __forceinline__ void a_ready(const Unit&) const {}
    __device__ __forceinline__ void done(const Unit&) const {}
};
__device__ __forceinline__ unsigned cvt_pk_bf16(float lo, float hi) { unsigned r; asm volatile("v_cvt_pk_bf16_f32 %0, %1, %2" : "=v"(r) : "v"(lo), "v"(hi)); return r; }
__device__ __forceinline__ u32x4 pack8(f32x4 v0, f32x4 v1) { u32x4 w; w.x = cvt_pk_bf16(v0[0], v0[1]); w.y = cvt_pk_bf16(v0[2], v0[3]); w.z = cvt_pk_bf16(v1[0], v1[1]); w.w = cvt_pk_bf16(v1[2], v1[3]); return w; }
__device__ __forceinline__ float bfl(unsigned w) { return __uint_as_float(w << 16); }
__device__ __forceinline__ float bfh(unsigned w) { return __uint_as_float(w & 0xffff0000u); }

__device__ __forceinline__ float row_rstd(const float* SS, int row) {
    const f32x4* p = (const f32x4*)(SS + (size_t)row * 16); const f32x4 a = p[0], b = p[1], c = p[2], d = p[3];
    const float s = ((a[0] + a[1]) + (a[2] + a[3])) + ((b[0] + b[1]) + (b[2] + b[3])) + ((c[0] + c[1]) + (c[2] + c[3])) + ((d[0] + d[1]) + (d[2] + d[3]));
    return rsqrtf(s * (1.0f / 1024.0f) + 1e-6f);
}
template <int ACT, bool SCALE> struct EpiBf16 {
    static constexpr bool PERM = true, AFTER_DRAIN = false;
    bf16_t* O; int ldc; const float* SS;
    __device__ __forceinline__ void operator()(const f32x4 (&acc)[2][2][4][2], const Unit& u, int wr, int wc, int fr, int fq) const {
        asm volatile("" : "+v"(fr), "+v"(fq));
        float rs[8];
#pragma unroll
        for (int i = 0; i < 8; ++i) rs[i] = SCALE ? row_rstd(SS, u.pm * BM + (i >> 2) * HALF + wr * 64 + (i & 3) * 16 + fr) : 1.0f;
#pragma unroll
        for (int ai = 0; ai < 2; ++ai)
#pragma unroll
            for (int m = 0; m < 4; ++m) { const int row = u.pm * BM + ai * HALF + wr * 64 + m * 16 + fr; const float r = rs[ai * 4 + m];
#pragma unroll
                for (int bj = 0; bj < 2; ++bj) { const int col = u.pn * BM + bj * HALF + wc * 32 + 8 * fq; f32x4 v0 = acc[ai][bj][m][0] * r, v1 = acc[ai][bj][m][1] * r;
                    if (ACT == 1) {
#pragma unroll
                        for (int j = 0; j < 4; ++j) { const float a = fmaxf(v0[j], 0.f), b = fmaxf(v1[j], 0.f); v0[j] = a * a; v1[j] = b * b; } }
                    *(u32x4*)(O + (size_t)row * ldc + col) = pack8(v0, v1); } }
    }
};
struct EpiBias {
    static constexpr bool PERM = true, AFTER_DRAIN = false;
    bf16_t* O; int ldc; const float* bias;
    __device__ __forceinline__ void operator()(const f32x4 (&acc)[2][2][4][2], const Unit& u, int wr, int wc, int fr, int fq) const {
#pragma unroll
        for (int ai = 0; ai < 2; ++ai)
#pragma unroll
            for (int m = 0; m < 4; ++m) { const int row = u.pm * BM + ai * HALF + wr * 64 + m * 16 + fr;
#pragma unroll
                for (int bj = 0; bj < 2; ++bj) { const int col = u.pn * BM + bj * HALF + wc * 32 + 8 * fq; const f32x4 b0 = *(const f32x4*)(bias + col), b1 = *(const f32x4*)(bias + col + 4);
                    *(u32x4*)(O + (size_t)row * ldc + col) = pack8(acc[ai][bj][m][0] + b0, acc[ai][bj][m][1] + b1); } }
    }
};
template <bool GATE> struct EpiRes {
    static constexpr bool PERM = true, AFTER_DRAIN = false;
    const bf16_t* HBin; bf16_t* HB; float* SSout; const float* SSin; const bf16_t* PLE; float* OUT;
    __device__ __forceinline__ void operator()(const f32x4 (&acc)[2][2][4][2], const Unit& u, int wr, int wc, int fr, int fq) const {
        asm volatile("" : "+v"(fr), "+v"(fq));
        const int colb = u.pn * BM + wc * 32 + 8 * fq;
        constexpr int NB = GATE ? 2 : 4;
#pragma unroll
        for (int g0 = 0; g0 < 8; g0 += NB) {
            u32x4 hv[NB][2], pw[NB][2]; float rs[NB];
#pragma unroll
            for (int k = 0; k < NB; ++k) { const int ai = (g0 + k) >> 2, m = (g0 + k) & 3; const size_t off = (size_t)(u.pm * BM + ai * HALF + wr * 64 + m * 16 + fr) * 1024 + colb;
                rs[k] = GATE ? row_rstd(SSin, u.pm * BM + ai * HALF + wr * 64 + m * 16 + fr) : 1.0f;
#pragma unroll
                for (int bj = 0; bj < 2; ++bj) { hv[k][bj] = *(const u32x4*)(HBin + off + bj * HALF); if (GATE) pw[k][bj] = *(const u32x4*)(PLE + off + bj * HALF); } }
#pragma unroll
            for (int k = 0; k < NB; ++k) { const int ai = (g0 + k) >> 2, m = (g0 + k) & 3; const size_t off = (size_t)(u.pm * BM + ai * HALF + wr * 64 + m * 16 + fr) * 1024 + colb; const float r = rs[k]; float sq = 0.f;
#pragma unroll
                for (int bj = 0; bj < 2; ++bj) {
                    f32x4 v0 = acc[ai][bj][m][0], v1 = acc[ai][bj][m][1];
                    if (GATE) { const u32x4 p = pw[k][bj];
                        const f32x4 p0 = {bfl(p.x), bfh(p.x), bfl(p.y), bfh(p.y)}, p1 = {bfl(p.z), bfh(p.z), bfl(p.w), bfh(p.w)};
#pragma unroll
                        for (int j = 0; j < 4; ++j) { v0[j] = p0[j] / (1.0f + __expf(-v0[j] * r)); v1[j] = p1[j] / (1.0f + __expf(-v1[j] * r)); } }
                    { const u32x4 hh = hv[k][bj]; v0 = v0 + (f32x4){bfl(hh.x), bfh(hh.x), bfl(hh.y), bfh(hh.y)}; v1 = v1 + (f32x4){bfl(hh.z), bfh(hh.z), bfl(hh.w), bfh(hh.w)}; }
                    *(u32x4*)(HB + off + bj * HALF) = pack8(v0, v1);
                    if (OUT) { *(f32x4*)(OUT + off + bj * HALF) = v0; *(f32x4*)(OUT + off + bj * HALF + 4) = v1; }
                    sq += (v0[0] * v0[0] + v0[1] * v0[1]) + (v0[2] * v0[2] + v0[3] * v0[3]) + (v1[0] * v1[0] + v1[1] * v1[1]) + (v1[2] * v1[2] + v1[3] * v1[3]); }
                sq += __shfl_xor(sq, 16); sq += __shfl_xor(sq, 32);
                if (fq == 0) SSout[(size_t)(u.pm * BM + ai * HALF + wr * 64 + m * 16 + fr) * 16 + u.pn * 4 + wc] = sq; }
        }
    }
};

typedef float f32x2v __attribute__((ext_vector_type(2)));
typedef unsigned u32x2 __attribute__((ext_vector_type(2)));
struct InProjOut {
    bf16_t* PJ; const float* SS; const float* qn_g; const float* kn_g; const unsigned char* TAB;
    static constexpr size_t FT = 6291456;
    __device__ __forceinline__ bf16_t* QFa() const { return PJ; }            __device__ __forceinline__ bf16_t* KFa() const { return PJ + FT; }
    __device__ __forceinline__ bf16_t* VFa() const { return PJ + 2 * FT; }   __device__ __forceinline__ bf16_t* QFr() const { return PJ + 3 * FT; }
    __device__ __forceinline__ bf16_t* KFr() const { return PJ + 4 * FT; }   __device__ __forceinline__ bf16_t* KTr() const { return PJ + 5 * FT; }
    __device__ __forceinline__ bf16_t* VFr() const { return PJ + 6 * FT; }   __device__ __forceinline__ bf16_t* G() const { return PJ + 7 * FT; }
    __device__ __forceinline__ bf16_t* GLU() const { return PJ + 8 * FT; }
    __device__ __forceinline__ const float* CS() const { return (const float*)TAB; }
    __device__ __forceinline__ const float* CST() const { return (const float*)(TAB + 512 * 1024); }
    __device__ __forceinline__ const float* DK() const { return (const float*)(TAB + 2 * 1024 * 1024); }
};
struct InProjOrder : StaticOrder {
    __device__ __forceinline__ const char* a_ptr(const Unit& u) const { return u.pn < 10 ? A + (size_t)u.pm * tstep : Bt + (size_t)u.pn * tstep; }
    __device__ __forceinline__ const char* b_ptr(const Unit& u) const { return u.pn < 10 ? Bt + (size_t)u.pn * tstep : A + (size_t)u.pm * tstep; }
};
struct PleOrder {
    int c, nmax; const char* A; const char* Bt; size_t tstep;
    __device__ void init(int c_, const void* A_, const void* Bt_) { c = c_; A = (const char*)A_; Bt = (const char*)Bt_; tstep = (size_t)BM * 256 * 2; nmax = 4; asm volatile("" : "+s"(nmax)); }
    __device__ bool next(int i, Unit& u) const { if (c < 192 || i >= nmax) return false; const int idx = i * 64 + (c - 192); u.pm = idx >> 2; u.pn = idx & 3; return true; }
    __device__ __forceinline__ const char* a_ptr(const Unit& u) const { return A + (size_t)u.pm * tstep; }
    __device__ __forceinline__ const char* b_ptr(const Unit& u) const { return Bt + (size_t)u.pn * tstep; }
    __device__ __forceinline__ void a_ready(const Unit&) const {}
    __device__ __forceinline__ void done(const Unit&) const {}
};
__device__ __forceinline__ float sigm(float x) { return 1.0f / (1.0f + __expf(-x)); }
__device__ __forceinline__ u32x2 pack4(f32x4 v) { u32x2 w; w.x = cvt_pk_bf16(v[0], v[1]); w.y = cvt_pk_bf16(v[2], v[3]); return w; }
struct EpiInProj {
    static constexpr bool PERM = true, AFTER_DRAIN = false;
    InProjOut o;
    __device__ __forceinline__ void operator()(const f32x4 (&acc)[2][2][4][2], const Unit& u, int wr, int wc, int fr, int fq) const {
        asm volatile("" : "+v"(fr), "+v"(fq));
        const int T = u.pn;
        if (T < 10) {
            int kind, head;
            if (T < 3) { const int g = 4 * T + wc; kind = g < 6 ? 0 : 1; head = g < 6 ? g : g - 6; }
            else if (T < 5) { kind = 2; head = 0; }
            else { const int g = 4 * (T - 5) + wc; kind = g < 6 ? 3 : (g < 12 ? 4 : (g < 18 ? 5 : 6)); head = g % 6; }
            if (kind == 6) return;
#pragma unroll
            for (int ai = 0; ai < 2; ++ai) {
#pragma unroll
                for (int m = 0; m < 4; ++m) {
                    const int token = u.pm * BM + ai * HALF + wr * 64 + m * 16 + fr; const float rstd = row_rstd(o.SS, token);
                    const int bb = token >> 11, s = token & 2047;
                    f32x4 a0 = acc[ai][0][m][0] * rstd, a1 = acc[ai][0][m][1] * rstd, b0 = acc[ai][1][m][0] * rstd, b1 = acc[ai][1][m][1] * rstd;
                    if (kind == 0 || kind == 1) {
                        float ss = (a0[0] * a0[0] + a0[1] * a0[1]) + (a0[2] * a0[2] + a0[3] * a0[3]) + (a1[0] * a1[0] + a1[1] * a1[1]) + (a1[2] * a1[2] + a1[3] * a1[3])
                                 + (b0[0] * b0[0] + b0[1] * b0[1]) + (b0[2] * b0[2] + b0[3] * b0[3]) + (b1[0] * b1[0] + b1[1] * b1[1]) + (b1[2] * b1[2] + b1[3] * b1[3]);
                        ss += __shfl_xor(ss, 16); ss += __shfl_xor(ss, 32);
                        const float r2 = rsqrtf(ss * (1.0f / 64.0f) + 1e-6f) * (kind == 0 ? 0.125f * 1.4426950408889634f : 1.0f);
                        const float* gp = (kind == 0 ? o.qn_g : o.kn_g) + 8 * fq;
                        const f32x4 g0 = *(const f32x4*)gp, g1 = *(const f32x4*)(gp + 4), g2 = *(const f32x4*)(gp + 32), g3 = *(const f32x4*)(gp + 36);
                        bf16_t* base = (kind == 0 ? o.QFa() : o.KFa()) + ((size_t)((bb * 6 + head) * 64 + (s >> 5)) * 4 + (fq >> 1)) * 512 + ((fq & 1) * 32 + (s & 31)) * 8;
                        *(u32x4*)base = pack8(a0 * g0 * r2, a1 * g1 * r2); *(u32x4*)(base + 1024) = pack8(b0 * g2 * r2, b1 * g3 * r2);
                    } else if (kind == 3 || kind == 4) {
                        const float sc = kind == 3 ? 0.125f : 1.0f;
                        const f32x4* cp = (const f32x4*)(o.CS() + (size_t)s * 64 + 16 * fq);
                        const f32x4 c0 = cp[0], c1 = cp[1], c2 = cp[2], c3 = cp[3];
                        f32x4 x0, x1, y0, y1;
                        x0[0] = (a0[0] * c0[0] - b0[0] * c0[1]) * sc; y0[0] = (a0[0] * c0[1] + b0[0] * c0[0]) * sc; x0[1] = (a0[1] * c0[2] - b0[1] * c0[3]) * sc; y0[1] = (a0[1] * c0[3] + b0[1] * c0[2]) * sc;
                        x0[2] = (a0[2] * c1[0] - b0[2] * c1[1]) * sc; y0[2] = (a0[2] * c1[1] + b0[2] * c1[0]) * sc; x0[3] = (a0[3] * c1[2] - b0[3] * c1[3]) * sc; y0[3] = (a0[3] * c1[3] + b0[3] * c1[2]) * sc;
                        x1[0] = (a1[0] * c2[0] - b1[0] * c2[1]) * sc; y1[0] = (a1[0] * c2[1] + b1[0] * c2[0]) * sc; x1[1] = (a1[1] * c2[2] - b1[1] * c2[3]) * sc; y1[1] = (a1[1] * c2[3] + b1[1] * c2[2]) * sc;
                        x1[2] = (a1[2] * c3[0] - b1[2] * c3[1]) * sc; y1[2] = (a1[2] * c3[1] + b1[2] * c3[0]) * sc; x1[3] = (a1[3] * c3[2] - b1[3] * c3[3]) * sc; y1[3] = (a1[3] * c3[3] + b1[3] * c3[2]) * sc;
                        bf16_t* base = (kind == 3 ? o.QFr() : o.KFr()) + ((size_t)((bb * 6 + head) * 64 + (s >> 5)) * 4 + (fq >> 1)) * 512 + ((fq & 1) * 32 + (s & 31)) * 8;
                        *(u32x4*)base = pack8(x0, x1); *(u32x4*)(base + 1024) = pack8(y0, y1);
                    } else if (kind == 5) {
#pragma unroll
                        for (int j = 0; j < 4; ++j) { a0[j] *= sigm(a0[j]); a1[j] *= sigm(a1[j]); b0[j] *= sigm(b0[j]); b1[j] *= sigm(b1[j]); }
                        bf16_t* base = o.G() + (size_t)token * 384 + head * 64 + 8 * fq;
                        *(u32x4*)base = pack8(a0, a1); *(u32x4*)(base + 32) = pack8(b0, b1);
                    } else {
#pragma unroll
                        for (int j = 0; j < 4; ++j) { a0[j] *= sigm(b0[j]); a1[j] *= sigm(b1[j]); }
                        *(u32x4*)(o.GLU() + (size_t)token * 256 + 128 * (T - 3) + 32 * wc + 8 * fq) = pack8(a0, a1);
                    }
                }
            }
        } else {
#pragma unroll
            for (int bj = 0; bj < 2; ++bj) {
                const int tok0 = u.pm * BM + bj * HALF + wc * 32 + 8 * fq, bb = tok0 >> 11, s0 = tok0 & 2047, kb16 = s0 >> 4, uu = (s0 >> 3) & 1;
                f32x4 rs0, rs1;
#pragma unroll
                for (int j = 0; j < 4; ++j) { rs0[j] = row_rstd(o.SS, tok0 + j); rs1[j] = row_rstd(o.SS, tok0 + 4 + j); }
#pragma unroll
                for (int ai = 0; ai < 2; ++ai) {
                    const int g = 4 * (T - 10) + 2 * ai + wr;
                    if (g >= 18) continue;
                    const int head = g % 6, bh = bb * 6 + head;
                    if (g < 12) {
                        bf16_t* dst = (g < 6 ? o.VFa() : o.VFr()) + ((size_t)(bh * 128 + kb16) * 2) * 512 + 4 * uu;
#pragma unroll
                        for (int m = 0; m < 4; ++m) { bf16_t* p = dst + ((m >> 1) * 64 + 16 * (m & 1) + fr) * 8;
                            *(u32x2*)p = pack4(acc[ai][bj][m][0] * rs0); *(u32x2*)(p + 256) = pack4(acc[ai][bj][m][1] * rs1); }
                    } else {
                        bf16_t* dst = o.KTr() + ((size_t)(bh * 128 + kb16) * 2) * 512 + 4 * uu;
                        const f32x4 dk0 = *(const f32x4*)(o.DK() + head * 64 + (s0 & 63)), dk1 = *(const f32x4*)(o.DK() + head * 64 + (s0 & 63) + 4);
#pragma unroll
                        for (int m = 0; m < 2; ++m) { const int i = 16 * m + fr;
                            const f32x4* cp = (const f32x4*)(o.CST() + ((size_t)i * 2048 + s0) * 2);
                            const f32x4 c0 = cp[0], c1 = cp[1], c2 = cp[2], c3 = cp[3];
                            const f32x4 t10 = acc[ai][bj][m][0] * rs0, t11 = acc[ai][bj][m][1] * rs1, t20 = acc[ai][bj][m + 2][0] * rs0, t21 = acc[ai][bj][m + 2][1] * rs1;
                            f32x4 x0, x1, y0, y1;
                            x0[0] = (t10[0] * c0[0] - t20[0] * c0[1]) * dk0[0]; y0[0] = (t10[0] * c0[1] + t20[0] * c0[0]) * dk0[0]; x0[1] = (t10[1] * c0[2] - t20[1] * c0[3]) * dk0[1]; y0[1] = (t10[1] * c0[3] + t20[1] * c0[2]) * dk0[1];
                            x0[2] = (t10[2] * c1[0] - t20[2] * c1[1]) * dk0[2]; y0[2] = (t10[2] * c1[1] + t20[2] * c1[0]) * dk0[2]; x0[3] = (t10[3] * c1[2] - t20[3] * c1[3]) * dk0[3]; y0[3] = (t10[3] * c1[3] + t20[3] * c1[2]) * dk0[3];
                            x1[0] = (t11[0] * c2[0] - t21[0] * c2[1]) * dk1[0]; y1[0] = (t11[0] * c2[1] + t21[0] * c2[0]) * dk1[0]; x1[1] = (t11[1] * c2[2] - t21[1] * c2[3]) * dk1[1]; y1[1] = (t11[1] * c2[3] + t21[1] * c2[2]) * dk1[1];
                            x1[2] = (t11[2] * c3[0] - t21[2] * c3[1]) * dk1[2]; y1[2] = (t11[2] * c3[1] + t21[2] * c3[0]) * dk1[2]; x1[3] = (t11[3] * c3[2] - t21[3] * c3[3]) * dk1[3]; y1[3] = (t11[3] * c3[3] + t21[3] * c3[2]) * dk1[3];
                            bf16_t* p = dst + i * 8;
                            *(u32x2*)p = pack4(x0); *(u32x2*)(p + 256) = pack4(x1); *(u32x2*)(p + 512) = pack4(y0); *(u32x2*)(p + 512 + 256) = pack4(y1); }
                    }
                }
            }
        }
    }
};

template <class Epi, class Sched, bool ALIGN_EPI = false, bool SP2 = false>
__device__ __forceinline__ void gemm_phase(PG8_LAS unsigned char* lds, const int K, const Sched& S, const Epi& E, const int tid) {
    const int wid = __builtin_amdgcn_readfirstlane(tid >> 6), lane = tid & 63, wr = wid >> 2, wc = wid & 3, fr = lane & 15, fq = lane >> 4;
    const int nt = K / BK;
    unsigned voffA[2], voffB[2];
#pragma unroll
    for (int i = 0; i < 2; ++i) { int R, C; stage_rc(tid * 16 + i * 8192, R, C); const int Rb = Epi::PERM ? ((R & ~31) + perm32(R & 31)) : R;
        voffA[i] = (unsigned)(R * K + C) * 2u; voffB[i] = (unsigned)(Rb * K + C) * 2u; }
    const size_t kstep = (size_t)(BK * 2);
    const size_t hstep = (size_t)HALF * K * 2;
    const unsigned ldsw = (unsigned)wid * 1024u;
    const int aoff = lds_byte(wr * 64 + fr, fq * 8), boff = lds_byte(wc * 32 + fr, fq * 8);
#define PG8_SA(b, h) (((b) * 2 + (h)) * HTB)
#define PG8_SB(b, h) ((4 + (b) * 2 + (h)) * HTB)
#define PG8_STAGE(bufoff, gbase, voff) do { _Pragma("unroll") for (int _i = 0; _i < 2; ++_i) \
        __builtin_amdgcn_global_load_lds((const unsigned*)((const char*)(gbase) + (voff)[_i]), (PG8_LAS unsigned*)(lds + (bufoff) + ldsw + _i * 8192), 16, 0, 0); } while (0)
#define PG8_LDA(dst, b, h) do { _Pragma("unroll") for (int m = 0; m < 4; ++m) _Pragma("unroll") for (int k = 0; k < 2; ++k) dst[m][k] = *(const PG8_LAS bf16x8*)(lds + PG8_SA(b, h) + aoff + m * 2048 + k * 1024); } while (0)
#define PG8_LDB(dst, b, h) do { _Pragma("unroll") for (int n = 0; n < 2; ++n) _Pragma("unroll") for (int k = 0; k < 2; ++k) dst[n][k] = *(const PG8_LAS bf16x8*)(lds + PG8_SB(b, h) + boff + n * 2048 + k * 1024); } while (0)
#define PG8_MMA(ai, bj, At, Bt) do { __builtin_amdgcn_s_setprio(1); _Pragma("unroll") for (int m = 0; m < 4; ++m) _Pragma("unroll") for (int n = 0; n < 2; ++n) _Pragma("unroll") for (int k = 0; k < 2; ++k) \
        acc[ai][bj][m][n] = __builtin_amdgcn_mfma_f32_16x16x32_bf16(Bt[n][k], At[m][k], acc[ai][bj][m][n], 0, 0, 0); __builtin_amdgcn_s_setprio(0); } while (0)
#define PG8_WAIT_V(n) asm volatile("s_waitcnt vmcnt(" #n ")" ::: "memory")
#define PG8_WAIT_L(n) asm volatile("s_waitcnt lgkmcnt(" #n ")" ::: "memory")
#define PG8_BAR __builtin_amdgcn_s_barrier()
#define PG8_SCHED __builtin_amdgcn_sched_barrier(0)
    Unit cur, nxt; int ui = 0;
    if (!S.next(0, cur)) return;
    f32x4 acc[2][2][4][2];
#pragma unroll
    for (int a = 0; a < 2; ++a)
#pragma unroll
        for (int b = 0; b < 2; ++b)
#pragma unroll
            for (int m = 0; m < 4; ++m)
#pragma unroll
                for (int n = 0; n < 2; ++n) acc[a][b][m][n] = (f32x4){0.f, 0.f, 0.f, 0.f};
    bf16x8 At[4][2], B0[2][2], B1[2][2];
    const char* cA = S.a_ptr(cur); const char* cB = S.b_ptr(cur);
    S.a_ready(cur);
    if constexpr (SP2) {
        PG8_STAGE(PG8_SB(0, 0), cB, voffB); PG8_STAGE(PG8_SB(0, 1), cB + hstep, voffB); PG8_STAGE(PG8_SA(0, 0), cA, voffA); PG8_STAGE(PG8_SA(0, 1), cA + hstep, voffA);
        if (wr == 1) PG8_BAR;
        PG8_WAIT_V(2); PG8_BAR;
        PG8_STAGE(PG8_SB(1, 0), cB + kstep, voffB); PG8_STAGE(PG8_SA(1, 0), cA + kstep, voffA); PG8_STAGE(PG8_SB(1, 1), cB + hstep + kstep, voffB);
        PG8_WAIT_V(6); PG8_BAR;
    } else {
        PG8_STAGE(PG8_SB(0, 0), cB, voffB); PG8_STAGE(PG8_SA(0, 0), cA, voffA); PG8_STAGE(PG8_SB(0, 1), cB + hstep, voffB); PG8_STAGE(PG8_SA(0, 1), cA + hstep, voffA);
        if (wr == 1) PG8_BAR;
        PG8_WAIT_V(4); PG8_BAR;
        PG8_STAGE(PG8_SB(1, 0), cB + kstep, voffB); PG8_STAGE(PG8_SA(1, 0), cA + kstep, voffA); PG8_STAGE(PG8_SB(1, 1), cB + hstep + kstep, voffB);
        PG8_WAIT_V(6); PG8_BAR;
    }
    for (;;) {
        const bool has_next = S.next(ui + 1, nxt);
        const char* nA = has_next ? S.a_ptr(nxt) : cA; const char* nB = has_next ? S.b_ptr(nxt) : cB;
        for (int t = 0; t < nt; t += 2) {
            const bool last = (t == nt - 2);
            const char* a1 = cA + (size_t)(t + 1) * kstep;
            const char* a2 = last ? nA : cA + (size_t)(t + 2) * kstep; const char* b2 = last ? nB : cB + (size_t)(t + 2) * kstep;
            const char* a3 = a2 + kstep; const char* b3 = b2 + kstep;
            if (last && has_next) S.a_ready(nxt);
            if constexpr (SP2) {
            PG8_LDB(B0, 0, 0); PG8_LDB(B1, 0, 1); PG8_SCHED; PG8_LDA(At, 0, 0); PG8_STAGE(PG8_SA(1, 1), a1 + hstep, voffA);
            PG8_WAIT_V(8); PG8_WAIT_L(0); PG8_BAR; PG8_MMA(0, 0, At, B0); PG8_MMA(0, 1, At, B1); PG8_BAR; PG8_SCHED;
            PG8_LDA(At, 0, 1); PG8_STAGE(PG8_SB(0, 0), b2, voffB); PG8_STAGE(PG8_SB(0, 1), b2 + hstep, voffB); PG8_STAGE(PG8_SA(0, 0), a2, voffA);
            PG8_WAIT_V(8); PG8_WAIT_L(0); PG8_BAR; PG8_MMA(1, 0, At, B0); PG8_MMA(1, 1, At, B1); PG8_BAR; PG8_SCHED;
            PG8_LDB(B0, 1, 0); PG8_LDB(B1, 1, 1); PG8_SCHED; PG8_LDA(At, 1, 0); PG8_STAGE(PG8_SA(0, 1), a2 + hstep, voffA);
            PG8_WAIT_V(8); PG8_WAIT_L(0); PG8_BAR; PG8_MMA(0, 0, At, B0); PG8_MMA(0, 1, At, B1); PG8_BAR; PG8_SCHED;
            PG8_LDA(At, 1, 1); PG8_STAGE(PG8_SB(1, 0), b3, voffB); PG8_STAGE(PG8_SB(1, 1), b3 + hstep, voffB); PG8_STAGE(PG8_SA(1, 0), a3, voffA);
            PG8_WAIT_V(8); PG8_WAIT_L(0); PG8_BAR; PG8_MMA(1, 0, At, B0); PG8_MMA(1, 1, At, B1); PG8_BAR; PG8_SCHED;
            } else {
            PG8_LDB(B0, 0, 0); PG8_SCHED; PG8_LDA(At, 0, 0); PG8_STAGE(PG8_SA(1, 1), a1 + hstep, voffA);
            PG8_WAIT_L(8); PG8_BAR; PG8_WAIT_L(0); PG8_MMA(0, 0, At, B0); PG8_BAR; PG8_SCHED;
            PG8_LDB(B1, 0, 1); PG8_STAGE(PG8_SB(0, 0), b2, voffB);
            PG8_BAR; PG8_WAIT_L(0); PG8_MMA(0, 1, At, B1); PG8_BAR;
            PG8_LDA(At, 0, 1); PG8_STAGE(PG8_SA(0, 0), a2, voffA);
            PG8_BAR; PG8_WAIT_L(0); PG8_MMA(1, 0, At, B0); PG8_BAR; PG8_SCHED;
            PG8_STAGE(PG8_SB(0, 1), b2 + hstep, voffB);
            PG8_WAIT_V(6); PG8_BAR; PG8_MMA(1, 1, At, B1); PG8_BAR;
            PG8_LDB(B0, 1, 0); PG8_SCHED; PG8_LDA(At, 1, 0); PG8_STAGE(PG8_SA(0, 1), a2 + hstep, voffA);
            PG8_WAIT_L(8); PG8_BAR; PG8_WAIT_L(0); PG8_MMA(0, 0, At, B0); PG8_BAR; PG8_SCHED;
            PG8_LDB(B1, 1, 1); PG8_STAGE(PG8_SB(1, 0), b3, voffB);
            PG8_BAR; PG8_WAIT_L(0); PG8_MMA(0, 1, At, B1); PG8_BAR;
            PG8_LDA(At, 1, 1); PG8_STAGE(PG8_SA(1, 0), a3, voffA);
            PG8_BAR; PG8_WAIT_L(0); PG8_MMA(1, 0, At, B0); PG8_BAR; PG8_SCHED;
            PG8_STAGE(PG8_SB(1, 1), b3 + hstep, voffB);
            PG8_WAIT_V(6); PG8_BAR; PG8_MMA(1, 1, At, B1); PG8_BAR;
            }
        }
        if constexpr (ALIGN_EPI) { if (wr == 0) PG8_BAR; }
        if constexpr (!Epi::AFTER_DRAIN) { E(acc, cur, wr, wc, fr, fq); S.done(cur); }
        if (!has_next) break;
#pragma unroll
        for (int a = 0; a < 2; ++a)
#pragma unroll
            for (int b = 0; b < 2; ++b)
#pragma unroll
                for (int m = 0; m < 4; ++m)
#pragma unroll
                    for (int n = 0; n < 2; ++n) acc[a][b][m][n] = (f32x4){0.f, 0.f, 0.f, 0.f};
        cur = nxt; cA = nA; cB = nB; ++ui;
        if constexpr (ALIGN_EPI) { if (wr == 1) PG8_BAR; }
    }
    PG8_WAIT_V(0);
    if constexpr (!ALIGN_EPI) { if (wr == 0) PG8_BAR; }
    PG8_BAR;
    if constexpr (Epi::AFTER_DRAIN) { E.fused(acc, cur, wr, wc, fr, fq, lds, wid, lane); S.done(cur); }
#undef PG8_SA
#undef PG8_SB
#undef PG8_STAGE
#undef PG8_LDA
#undef PG8_LDB
#undef PG8_MMA
#undef PG8_WAIT_V
#undef PG8_WAIT_L
#undef PG8_BAR
#undef PG8_SCHED
}
}

constexpr int D_MODEL = 1024, BATCH = 8, SEQ = 2048, DEPTH = 4, CHUNK = 64, NLEFT = 8, HD = 64;
constexpr int D_ATT = 384, D_RET = 384, D_CONV = 256, H_ATT = 6, H_RET = 6, CONV_K = 31, REL_CLIP = 128;
constexpr int D_FF = 4096, D_PLE = 256, D_IN = 3200, M = BATCH * SEQ, NC = SEQ / CHUNK;
constexpr int NIN_ROWS = 15 * 256;
constexpr float EPS = 1e-6f;
constexpr int C_QA = 0, C_KA = 384, C_VA = 768, C_UC = 1152, C_QR = 1664, C_KR = 2048, C_VR = 2432, C_GR = 2816;
constexpr int NWAVES = 8;

constexpr size_t MiB = 1u << 20;
constexpr size_t WS_CTL = 0, CTL_ZERO_BYTES = 1 * MiB;
constexpr size_t WS_SS = 1 * MiB;
constexpr size_t WS_WBUF = 4 * MiB, WBUF_BYTES = 29 * MiB;
constexpr size_t WS_HB = 62 * MiB, HB_BYTES = 32 * MiB;
constexpr size_t WS_PLE = 126 * MiB;
constexpr size_t WS_PROJ = 158 * MiB;
constexpr size_t WS_MIX = 262 * MiB;
constexpr size_t WS_HID = 158 * MiB;
constexpr size_t WS_PB = 294 * MiB;
constexpr size_t WS_CS = 302 * MiB;
constexpr size_t WS_CST = WS_CS + 512 * 1024;
constexpr size_t WS_BT = 303 * MiB;
constexpr size_t WS_DK = WS_CS + 2 * MiB;
constexpr size_t WS_ST = 305 * MiB;
constexpr size_t WS_END = 318 * MiB;
constexpr size_t WO_WIN = 0, WO_WO = WO_WIN + (size_t)NIN_ROWS * 1024, WO_W1 = WO_WO + 1024 * 1024, WO_W2 = WO_W1 + 4096 * 1024, WO_WPG = WO_W2 + 4096 * 1024,
                 WO_WPLE = WO_WPG + 1024 * 1024, WO_PW = WO_WPLE + 1024 * 256, WO_END = WO_PW + 256 * 256;
static_assert(WO_END * 2 <= WBUF_BYTES, "weight buffer");
constexpr int CW_BAR = 4096, CW_QUEUE = 8192;

constexpr int RING_OFF = 0, RING_BYTES = 131072;
constexpr int LDSCTL_OFF = RING_BYTES, MISC_OFF = LDSCTL_OFF + 320;
constexpr int LDS_BYTES = 147456, PTR_OFF = LDSCTL_OFF + 1024;

#define GAS __attribute__((address_space(1)))
#define LAS __attribute__((address_space(3)))
typedef unsigned short bf16;
typedef unsigned v4u __attribute__((ext_vector_type(4)));
typedef float f32x4 __attribute__((ext_vector_type(4)));
typedef GAS unsigned gu32;
#define LDS_WAIT() asm volatile("s_waitcnt lgkmcnt(0)" ::: "memory")
__device__ __forceinline__ unsigned f2bf(float f) { unsigned u = __builtin_bit_cast(unsigned, f); return (u + 0x7fffu + ((u >> 16) & 1u)) >> 16; }
__device__ __forceinline__ unsigned pk2(float lo, float hi) { return f2bf(lo) | (f2bf(hi) << 16); }
__device__ __forceinline__ float bf2f(bf16 v) { return __uint_as_float((unsigned)v << 16); }

#define XB_TMO      128
#define XB_XCNT(j)  (256  + 64 * (j))
#define XB_XSUB(j)  (1280 + 64 * (j))
#define XB_XGEN(j)  (2304 + 64 * (j))
#define XB_TOP      3328
#define XB_TOPGEN   3392
#define XCD_BAR_WORDS 3456
#define XB_SPIN_CAP (1u << 18)

__device__ __forceinline__ unsigned xb_ld(unsigned* p)              { return __hip_atomic_load(p, __ATOMIC_RELAXED, __HIP_MEMORY_SCOPE_AGENT); }
__device__ __forceinline__ unsigned xb_add(unsigned* p, unsigned v) { return __hip_atomic_fetch_add(p, v, __ATOMIC_RELAXED, __HIP_MEMORY_SCOPE_AGENT); }
__device__ __forceinline__ unsigned xb_xcc_id() { return (unsigned)__builtin_amdgcn_s_getreg((3 << 11) | 20) & 0xFu; }
#define XB_SPIN(cond, bar) do { unsigned _sp = 0; while (cond) { __builtin_amdgcn_s_sleep(1); \
    if ((++_sp & 255u) == 0u) { if (xb_ld(&(bar)[XB_TMO])) break; if (_sp > XB_SPIN_CAP) { atomicAdd(&(bar)[XB_TMO], 1u); break; } } } } while (0)

struct XcdBarrier {
    unsigned* bar; unsigned x;
    volatile LAS unsigned* st;
};

__device__ __forceinline__ XcdBarrier xcd_barrier_post(unsigned* bar, volatile LAS unsigned* st) {
    XcdBarrier b; b.bar = bar; b.x = xb_xcc_id(); b.st = st;
    if (threadIdx.x == 0) (void)xb_add(&bar[XB_XCNT(b.x)], 1u);
    return b;
}
__device__ __forceinline__ void xcd_barrier_complete(unsigned* bar, unsigned x, unsigned& nloc, unsigned& nx) {
    const unsigned G = gridDim.x * gridDim.y * gridDim.z;
    unsigned sum, cnt, mine, sp = 0u;
    for (;;) {
        sum = 0u; cnt = 0u; mine = 0u;
#pragma unroll
        for (unsigned j = 0; j < 16; ++j) { const unsigned c = xb_ld(&bar[XB_XCNT(j)]); sum += c; cnt += (c > 0u) ? 1u : 0u; mine = (j == x) ? c : mine; }
        if (sum == G) break;
        __builtin_amdgcn_s_sleep(1);
        if ((++sp & 255u) == 0u) { if (xb_ld(&bar[XB_TMO])) break; if (sp > XB_SPIN_CAP) { atomicAdd(&bar[XB_TMO], 1u); break; } }
    }
    nloc = mine > 0u ? mine : 1u; nx = cnt > 0u ? cnt : 1u;
}

__device__ __forceinline__ void xcd_barrier(const XcdBarrier& b) {
    asm volatile("s_waitcnt vmcnt(0)" ::: "memory");
    __syncthreads();
    if (threadIdx.x == 0) {
        unsigned* bar = b.bar;
        __builtin_amdgcn_s_waitcnt(0);
        unsigned nloc = b.st[0], nx = b.st[1];
        if (nloc == 0u) { xcd_barrier_complete(bar, b.x, nloc, nx); b.st[0] = nloc; b.st[1] = nx; }
        const unsigned old = xb_add(&bar[XB_XSUB(b.x)], 1u);
        const unsigned gen = old / nloc;
        if (old + 1u == (gen + 1u) * nloc) {
            __builtin_amdgcn_fence(__ATOMIC_RELEASE, "agent");
            asm volatile("s_waitcnt vmcnt(0)" ::: "memory");
            const unsigned og = xb_add(&bar[XB_TOP], 1u);
            const unsigned tg = og / nx;
            if (og + 1u == (tg + 1u) * nx) xb_add(&bar[XB_TOPGEN], 1u);
            else XB_SPIN(xb_ld(&bar[XB_TOPGEN]) == tg, bar);
            __builtin_amdgcn_fence(__ATOMIC_ACQUIRE, "agent");
            xb_add(&bar[XB_XGEN(b.x)], 1u);
            asm volatile("s_waitcnt vmcnt(0)" ::: "memory");
        } else {
            XB_SPIN(xb_ld(&bar[XB_XGEN(b.x)]) == gen, bar);
            __builtin_amdgcn_fence(__ATOMIC_ACQUIRE, "agent");
            asm volatile("s_waitcnt vmcnt(0)" ::: "memory");
        }
    }
    __syncthreads();
}

__device__ __forceinline__ unsigned long long rfl64(unsigned long long v) { const unsigned lo = __builtin_amdgcn_readfirstlane((unsigned)v), hi = __builtin_amdgcn_readfirstlane((unsigned)(v >> 32)); return ((unsigned long long)hi << 32) | lo; }
struct Args { const float* in[21]; float* out; unsigned char* ws; int ph_lo, ph_hi; };
struct Frame {
    LAS unsigned char* lds; int tid, lane, wave, G, bid, gw, ngw, dup;
    float* H; unsigned char* ws;
    __device__ __forceinline__ const float* in(int k) const { return (const float*)(uintptr_t)rfl64(((LAS unsigned long long*)(lds + PTR_OFF))[k]); }
};
__device__ __forceinline__ float wave_sum(float v) {
#pragma unroll
    for (int o = 1; o < 64; o <<= 1) v += __shfl_xor(v, o);
    return v;
}
__device__ __forceinline__ float sigmoidf_(float x) { return 1.0f / (1.0f + expf(-x)); }

__host__ __device__ __forceinline__ int in_src_col(int nb) {
    const int T = nb >> 3, r = nb & 7;
    if (T < 3) { const int bj = r >> 2, g = 4 * T + (r & 3); return (g < 6 ? C_QA + 64 * g : C_KA + 64 * (g - 6)) + 32 * bj; }
    if (T < 5) { const int bj = r >> 2; return C_UC + 256 * bj + 128 * (T - 3) + 32 * (r & 3); }
    if (T < 10) { const int bj = r >> 2, g = 4 * (T - 5) + (r & 3); if (g >= 18) return -1; return (g < 6 ? C_QR + 64 * g : (g < 12 ? C_KR + 64 * (g - 6) : C_GR + 64 * (g - 12))) + 32 * bj; }
    { const int g = 4 * (T - 10) + (r >> 1); if (g >= 18) return -1; return (g < 6 ? C_VA + 64 * g : (g < 12 ? C_VR + 64 * (g - 6) : C_KR + 64 * (g - 12))) + 32 * (r & 1); }
}
__device__ __forceinline__ void transpose_item(const float* W, int K, int N, const float* gain, bf16* WT, LAS float* scr, int k0, int n0src, int n0dst, int lane) {
    if (n0src >= 0) {
        float v[32];
#pragma unroll
        for (int i = 0; i < 32; ++i) v[i] = W[(size_t)(k0 + 2 * i + (lane >> 5)) * N + n0src + (lane & 31)];
#pragma unroll
        for (int i = 0; i < 32; ++i) scr[(2 * i + (lane >> 5)) * 33 + (lane & 31)] = v[i];
    } else {
#pragma unroll 8
        for (int i = 0; i < 32; ++i) scr[(2 * i + (lane >> 5)) * 33 + (lane & 31)] = 0.f;
    }
    LDS_WAIT(); asm volatile("" ::: "memory");
    const int c = lane & 7;
    f32x4 g0 = {1.f, 1.f, 1.f, 1.f}, g1 = g0;
    if (gain) { g0 = *(const f32x4*)(gain + k0 + 8 * c); g1 = *(const f32x4*)(gain + k0 + 8 * c + 4); }
#pragma unroll
    for (int j = 0; j < 4; ++j) { const int n = (lane >> 3) + 8 * j; const LAS float* s = scr + (8 * c) * 33 + n;
        v4u o; o.x = pk2(s[0 * 33] * g0[0], s[1 * 33] * g0[1]); o.y = pk2(s[2 * 33] * g0[2], s[3 * 33] * g0[3]); o.z = pk2(s[4 * 33] * g1[0], s[5 * 33] * g1[1]); o.w = pk2(s[6 * 33] * g1[2], s[7 * 33] * g1[3]);
        *(GAS v4u*)(WT + (size_t)(n0dst + n) * K + k0 + 8 * c) = o; }
    LDS_WAIT(); asm volatile("" ::: "memory");
}
__device__ __forceinline__ void convert_layer(Frame& F, int L) {
    bf16* WB = (bf16*)(F.ws + WS_WBUF + (size_t)(L & 1) * WBUF_BYTES);
    LAS float* scr = (LAS float*)(F.lds + RING_OFF + F.wave * 16384);
    const float* w_in = F.in(3) + (size_t)L * 1024 * D_IN; const float* w_o = F.in(14) + (size_t)L * 1024 * 1024; const float* w1 = F.in(16) + (size_t)L * 1024 * 4096;
    const float* w2 = F.in(17) + (size_t)L * 4096 * 1024; const float* w_pg = F.in(19) + (size_t)L * 1024 * 1024; const float* w_ple = F.in(20) + (size_t)L * 256 * 1024;
    const float* pw = F.in(11) + (size_t)L * 256 * 256;
    const float* g_mix = F.in(2) + L * 1024; const float* g_ffn = F.in(15) + L * 1024; const float* g_ple = F.in(18) + L * 1024;
    constexpr int I_IN = 16 * (NIN_ROWS / 32), I_O = 16 * 32, I_1 = 16 * 128, I_2 = 64 * 32, I_PG = 16 * 32, I_PLE = 4 * 32, I_PW = 4 * 8;
    constexpr int NIT = I_IN + I_O + I_1 + I_2 + I_PG + I_PLE + I_PW;
    for (int it = F.gw; it < NIT; it += F.ngw) {
        int r = it;
        if (r < I_IN) { const int nb = r % (NIN_ROWS / 32), kb = r / (NIN_ROWS / 32); transpose_item(w_in, 1024, D_IN, g_mix, WB + WO_WIN, scr, 64 * kb, in_src_col(nb), 32 * nb, F.lane); continue; } r -= I_IN;
        if (r < I_O) { transpose_item(w_o, 1024, 1024, nullptr, WB + WO_WO, scr, 64 * (r / 32), 32 * (r % 32), 32 * (r % 32), F.lane); continue; } r -= I_O;
        if (r < I_1) { transpose_item(w1, 1024, 4096, g_ffn, WB + WO_W1, scr, 64 * (r / 128), 32 * (r % 128), 32 * (r % 128), F.lane); continue; } r -= I_1;
        if (r < I_2) { transpose_item(w2, 4096, 1024, nullptr, WB + WO_W2, scr, 64 * (r / 32), 32 * (r % 32), 32 * (r % 32), F.lane); continue; } r -= I_2;
        if (r < I_PG) { transpose_item(w_pg, 1024, 1024, g_ple, WB + WO_WPG, scr, 64 * (r / 32), 32 * (r % 32), 32 * (r % 32), F.lane); continue; } r -= I_PG;
        if (r < I_PLE) { transpose_item(w_ple, 256, 1024, nullptr, WB + WO_WPLE, scr, 64 * (r / 32), 32 * (r % 32), 32 * (r % 32), F.lane); continue; } r -= I_PLE;
        transpose_item(pw, 256, 256, nullptr, WB + WO_PW, scr, 64 * (r / 8), 32 * (r % 8), 32 * (r % 8), F.lane);
    }
}
__device__ __forceinline__ void sincos_acc(float ang, float& s, float& c) {
    const double x = (double)ang; const double kd = rint(x * 0.63661977236758134);
    const double r = (x - kd * 1.5707963267948966) - kd * 6.123233995736766e-17; const int q = ((int)kd) & 3; const double r2 = r * r;
    const double sp = r * (1.0 + r2 * (-1.0 / 6 + r2 * (1.0 / 120 + r2 * (-1.0 / 5040 + r2 * (1.0 / 362880 + r2 * (-1.0 / 39916800))))));
    const double cp = 1.0 + r2 * (-0.5 + r2 * (1.0 / 24 + r2 * (-1.0 / 720 + r2 * (1.0 / 40320 + r2 * (-1.0 / 3628800 + r2 * (1.0 / 479001600))))));
    double ss, cc;
    if (q == 0) { ss = sp; cc = cp; } else if (q == 1) { ss = cp; cc = -sp; } else if (q == 2) { ss = -sp; cc = -cp; } else { ss = -cp; cc = sp; }
    s = (float)ss; c = (float)cc;
}
__device__ __forceinline__ void convert_p(Frame& F, int L) {
    const GAS f32x4* p4 = (const GAS f32x4*)(F.in(1) + (size_t)L * M * D_PLE); GAS unsigned long long* o8 = (GAS unsigned long long*)(F.ws + WS_PB); const int n4 = M * D_PLE / 4;
    for (int i = F.bid * 512 + F.tid; i < n4; i += F.G * 512) { const f32x4 v = p4[i]; o8[i] = (unsigned long long)pk2(v.x, v.y) | ((unsigned long long)pk2(v.z, v.w) << 32); }
}
__device__ __forceinline__ float log_gamma(int h) { return logf(1.0f - exp2f(-5.0f - (float)h)); }
__device__ __forceinline__ void prologue(Frame& F) {
    convert_layer(F, 0); convert_p(F, 0);
    const float* x = F.in(0); bf16* HB = (bf16*)(F.ws + WS_HB); float* SS = (float*)(F.ws + WS_SS);
    for (int m = F.gw; m < M; m += F.ngw) {
        const GAS f32x4* xr = (const GAS f32x4*)(x + (size_t)m * 1024) + F.lane;
        GAS unsigned long long* o8 = (GAS unsigned long long*)(HB + (size_t)m * 1024) + F.lane; float s = 0.f;
#pragma unroll
        for (int j = 0; j < 4; ++j) { const f32x4 v = xr[64 * j]; s += (v.x * v.x + v.y * v.y) + (v.z * v.z + v.w * v.w);
            o8[64 * j] = (unsigned long long)pk2(v.x, v.y) | ((unsigned long long)pk2(v.z, v.w) << 32); }
        s = wave_sum(s);
        if (F.lane < 16) SS[(size_t)m * 16 + F.lane] = F.lane == 0 ? s : 0.f;
    }
    { float2* cs = (float2*)(F.ws + WS_CS); float2* cst = (float2*)(F.ws + WS_CST);
      for (int idx = F.bid * 512 + F.tid; idx < SEQ * 32; idx += F.G * 512) { const int pos = idx >> 5, i = idx & 31; const float inv_freq = powf(10000.0f, -(float)(2 * i) / 64.0f);
          float s, c; sincos_acc((float)pos * inv_freq, s, c); cs[idx] = make_float2(c, s); cst[i * SEQ + pos] = make_float2(c, s); } }
    { float* bt = (float*)(F.ws + WS_BT); const float* rbp = F.in(6);
      for (int idx = F.bid * 512 + F.tid; idx < DEPTH * H_ATT * 7 * 1024; idx += F.G * 512) { const int reg = idx & 15, ln = (idx >> 4) & 63, di = (idx >> 10) % 7, lh = idx / 7168;
          int rel = 32 * di - 32 + (ln & 31) - ((reg & 3) + 8 * (reg >> 2) + 4 * (ln >> 5)); rel = rel < -REL_CLIP ? -REL_CLIP : (rel > REL_CLIP ? REL_CLIP : rel);
          bt[idx] = rbp[lh * 257 + rel + REL_CLIP] * 1.4426950408889634f; } }
    { float* dk = (float*)(F.ws + WS_DK);
      for (int idx = F.bid * 512 + F.tid; idx < H_RET * 64; idx += F.G * 512) dk[idx] = expf(log_gamma(idx >> 6) * (float)(63 - (idx & 63))); }
}
typedef float f32x16 __attribute__((ext_vector_type(16)));
typedef short bf16x8 __attribute__((ext_vector_type(8)));
typedef unsigned u32x2 __attribute__((ext_vector_type(2)));
#define MFMA32(a, b, c) __builtin_amdgcn_mfma_f32_32x32x16_bf16((a), (b), (c), 0, 0, 0)
constexpr float LOG2E = 1.4426950408889634f;
__device__ __forceinline__ int crow(int r, int hi) { return (r & 3) + 8 * (r >> 2) + 4 * hi; }
typedef float f32x2_t __attribute__((ext_vector_type(2))); typedef __bf16 bf16x2_t __attribute__((ext_vector_type(2)));
__device__ __forceinline__ unsigned cvtpk(float lo, float hi) { f32x2_t v = {lo, hi}; bf16x2_t b = __builtin_convertvector(v, bf16x2_t); return __builtin_bit_cast(unsigned, b); }
template <int T8> __device__ __forceinline__ bf16x8 packfrag(const f32x16& x) {
    v4u p; p.x = cvtpk(x[8 * T8 + 0], x[8 * T8 + 1]); p.y = cvtpk(x[8 * T8 + 2], x[8 * T8 + 3]); p.z = cvtpk(x[8 * T8 + 4], x[8 * T8 + 5]); p.w = cvtpk(x[8 * T8 + 6], x[8 * T8 + 7]);
    return __builtin_bit_cast(bf16x8, p);
}
__device__ __forceinline__ f32x16 splat16(float v) { f32x16 r;
#pragma unroll
    for (int i = 0; i < 16; ++i) r[i] = v;
    return r; }
__device__ __forceinline__ float ex2(float x) { return __builtin_amdgcn_exp2f(x); }
constexpr size_t FRAG_T = 6291456;
__device__ __forceinline__ const bf16x8* ftok(const bf16* base, int bh, int blk, int lane) { return (const bf16x8*)(base + ((size_t)(bh * 64 + blk) * 4) * 512) + lane; }
__device__ __forceinline__ const bf16x8* fdim(const bf16* base, int bh, int kb16, int lane) { return (const bf16x8*)(base + ((size_t)(bh * 128 + kb16) * 2) * 512) + lane; }

constexpr int ATT_SLOT = 16384, ATT_NSLOT = 8;
__device__ __forceinline__ void attn_dma(const bf16* KF, const bf16* VF, int bh, int c, LAS unsigned char* ring, int w, int lane) {
    const int slot = c & (ATT_NSLOT - 1);
    const bf16x8* kg = ftok(KF, bh, 2 * c, lane) + 64 * w; const bf16x8* vg = fdim(VF, bh, 4 * c, lane) + 64 * w;
    __builtin_amdgcn_global_load_lds((const unsigned*)kg, (LAS unsigned*)(ring + slot * ATT_SLOT + w * 1024), 16, 0, 0);
    __builtin_amdgcn_global_load_lds((const unsigned*)vg, (LAS unsigned*)(ring + slot * ATT_SLOT + 8192 + w * 1024), 16, 0, 0);
}
template <bool TILE> __device__ __forceinline__ void attn_step(f32x16& o0, f32x16& o1, float& mrun, float& lsum, const bf16x8 (&qf)[4], const LAS unsigned char* slotp, const int lane,
                                                              const float cbias, const float* bt0, const float* bt1) {
    bf16x8 kf[8], vf[8];
    { const unsigned la = (unsigned)(uintptr_t)slotp + (unsigned)lane * 16u;
#define ATT_DSR(dst, off) asm volatile("ds_read_b128 %0, %1 offset:" #off : "=v"(dst) : "v"(la))
      ATT_DSR(kf[0], 0); ATT_DSR(kf[1], 1024); ATT_DSR(kf[2], 2048); ATT_DSR(kf[3], 3072); ATT_DSR(kf[4], 4096); ATT_DSR(kf[5], 5120); ATT_DSR(kf[6], 6144); ATT_DSR(kf[7], 7168);
      ATT_DSR(vf[0], 8192); ATT_DSR(vf[1], 9216); ATT_DSR(vf[2], 10240); ATT_DSR(vf[3], 11264); ATT_DSR(vf[4], 12288); ATT_DSR(vf[5], 13312); ATT_DSR(vf[6], 14336); ATT_DSR(vf[7], 15360);
#undef ATT_DSR
      asm volatile("s_waitcnt lgkmcnt(8)" : "+v"(kf[0]), "+v"(kf[1]), "+v"(kf[2]), "+v"(kf[3]), "+v"(kf[4]), "+v"(kf[5]), "+v"(kf[6]), "+v"(kf[7]));
      __builtin_amdgcn_sched_barrier(0); }
    f32x16 p0, p1;
    if constexpr (TILE) {
        const f32x4* bp = (const f32x4*)bt0; const f32x4* bq = (const f32x4*)bt1;
        const f32x4 t0 = bp[0], t1 = bp[1], t2 = bp[2], t3 = bp[3], u0 = bq[0], u1 = bq[1], u2 = bq[2], u3 = bq[3];
#pragma unroll
        for (int i = 0; i < 4; ++i) { p0[i] = t0[i]; p0[4 + i] = t1[i]; p0[8 + i] = t2[i]; p0[12 + i] = t3[i]; p1[i] = u0[i]; p1[4 + i] = u1[i]; p1[8 + i] = u2[i]; p1[12 + i] = u3[i]; }
    } else { p0 = splat16(cbias); p1 = p0; }
#pragma unroll
    for (int s = 0; s < 4; ++s) { p0 = MFMA32(kf[s], qf[s], p0); p1 = MFMA32(kf[4 + s], qf[s], p1); }
    float rm = fmaxf(p0[0], p1[0]);
#pragma unroll
    for (int r = 1; r < 16; ++r) rm = fmaxf(rm, fmaxf(p0[r], p1[r]));
    rm = fmaxf(rm, __shfl_xor(rm, 32));
    const float mn = fmaxf(mrun, rm), alpha = ex2(mrun - mn); mrun = mn;
    float ps = 0.f;
#pragma unroll
    for (int r = 0; r < 16; ++r) { p0[r] = ex2(p0[r] - mn); p1[r] = ex2(p1[r] - mn); ps += p0[r] + p1[r]; }
    lsum = lsum * alpha + ps;
#pragma unroll
    for (int r = 0; r < 16; ++r) { o0[r] *= alpha; o1[r] *= alpha; }
    asm volatile("s_waitcnt lgkmcnt(0)" : "+v"(vf[0]), "+v"(vf[1]), "+v"(vf[2]), "+v"(vf[3]), "+v"(vf[4]), "+v"(vf[5]), "+v"(vf[6]), "+v"(vf[7]));
    __builtin_amdgcn_sched_barrier(0);
    { bf16x8 pf;
      pf = packfrag<0>(p0); o0 = MFMA32(vf[0], pf, o0); o1 = MFMA32(vf[1], pf, o1);
      pf = packfrag<1>(p0); o0 = MFMA32(vf[2], pf, o0); o1 = MFMA32(vf[3], pf, o1);
      pf = packfrag<0>(p1); o0 = MFMA32(vf[4], pf, o0); o1 = MFMA32(vf[5], pf, o1);
      pf = packfrag<1>(p1); o0 = MFMA32(vf[6], pf, o0); o1 = MFMA32(vf[7], pf, o1); }
}
__device__ __forceinline__ void attn_block_unit(Frame& F, const bf16* QF, const bf16* KF, const bf16* VF, const float* BT, const float* rb, bf16* MIX, int bh, int n0) {
    const int w = F.wave, lane = F.lane, hi = lane >> 5, q = lane & 31, jn = w >> 1, qh = w & 1, n = n0 + jn, h = bh % 6, b = bh / 6;
    LAS unsigned char* ring = F.lds + RING_OFF;
    bf16x8 qf[4];
    { const bf16x8* qp = ftok(QF, bh, n * 2 + qh, lane);
#pragma unroll
      for (int s = 0; s < 4; ++s) qf[s] = qp[64 * s]; }
    f32x16 o0 = splat16(0.f), o1 = splat16(0.f); float mrun = -1e30f, lsum = 0.f;
    const float cbias = rb[h * 257 + 256] * LOG2E;
    const int t0 = 5 - n0 < 0 ? 0 : 5 - n0;
    const int cmin = n0 - 8 < 0 ? 0 : n0 - 8, NB = n0 + 4 - cmin;
    int nis = 0;
    for (; nis < NB && nis <= n0 - 5 + t0 - cmin + 2; ++nis) attn_dma(KF, VF, bh, cmin + nis, ring, w, lane);
    for (int t = t0; t <= 8; ++t) {
        if (t <= 6) asm volatile("s_waitcnt vmcnt(4) lgkmcnt(0)\n\ts_barrier" ::: "memory"); else asm volatile("s_waitcnt vmcnt(0) lgkmcnt(0)\n\ts_barrier" ::: "memory");
        if (nis < NB && nis <= n0 - 5 + t - cmin + 3) { attn_dma(KF, VF, bh, cmin + nis, ring, w, lane); ++nis; }
        const int c = n - 8 + t;
        if (c >= 0) {
            const LAS unsigned char* slotp = ring + (c & (ATT_NSLOT - 1)) * ATT_SLOT;
            if (t < 6) attn_step<false>(o0, o1, mrun, lsum, qf, slotp, lane, cbias, nullptr, nullptr);
            else { const int D0 = 64 * (8 - t) + 32 * qh, D1 = D0 - 32; const int i0 = D0 >= 160 ? 6 : (D0 + 32) >> 5, i1 = D1 >= 160 ? 6 : (D1 + 32) >> 5;
                   attn_step<true>(o0, o1, mrun, lsum, qf, slotp, lane, cbias, BT + ((size_t)(h * 7 + i0) * 64 + lane) * 16, BT + ((size_t)(h * 7 + i1) * 64 + lane) * 16); }
        }
    }
    lsum += __shfl_xor(lsum, 32);
    const float inv = 1.0f / lsum;
    bf16* op = MIX + (size_t)(b * SEQ + n * CHUNK + qh * 32 + q) * 1024 + h * 64 + 4 * hi;
#pragma unroll
    for (int g = 0; g < 4; ++g) { u32x2 wv;
        wv.x = cvtpk(o0[4 * g] * inv, o0[4 * g + 1] * inv); wv.y = cvtpk(o0[4 * g + 2] * inv, o0[4 * g + 3] * inv); *(u32x2*)(op + 8 * g) = wv;
        wv.x = cvtpk(o1[4 * g] * inv, o1[4 * g + 1] * inv); wv.y = cvtpk(o1[4 * g + 2] * inv, o1[4 * g + 3] * inv); *(u32x2*)(op + 32 + 8 * g) = wv; }
    __syncthreads();
}
__device__ __forceinline__ void ret_state_unit(Frame& F, const bf16* KTr, const bf16* VFr, bf16* STg, int bh) {
    const int w = F.wave, lane = F.lane, tid = F.tid, hi = lane >> 5, cq = lane & 31, h = bh % 6, jc = w >> 1, hw = w & 1;
    LAS float* KVS = (LAS float*)(F.lds + RING_OFF);
    const float dec = expf(log_gamma(h) * 64.0f);
    const int se = tid >> 3, sd = tid & 7;
    const int st_off = ((((se >> 5) * 4 + (sd >> 1)) * 64 + (sd & 1) * 32 + (se & 31)) * 8);
    f32x4 st0 = {0.f, 0.f, 0.f, 0.f}, st1 = st0;
    bf16x8 kk[8], vv[4];
    { const bf16x8* kp = fdim(KTr, bh, 4 * jc, lane); const bf16x8* vp = fdim(VFr, bh, 4 * jc, lane) + 64 * hw;
#pragma unroll
      for (int s = 0; s < 4; ++s) { kk[2 * s] = kp[128 * s]; kk[2 * s + 1] = kp[128 * s + 64]; vv[s] = vp[128 * s]; } }
    for (int r = 0; r < 8; ++r) {
        f32x16 a0 = splat16(0.f), a1 = splat16(0.f);
#pragma unroll
        for (int s = 0; s < 4; ++s) { a0 = MFMA32(vv[s], kk[2 * s], a0); a1 = MFMA32(vv[s], kk[2 * s + 1], a1); }
        if (r < 7) { const int n1 = 4 * (r + 1) + jc; const bf16x8* kp = fdim(KTr, bh, 4 * n1, lane); const bf16x8* vp = fdim(VFr, bh, 4 * n1, lane) + 64 * hw;
#pragma unroll
          for (int s = 0; s < 4; ++s) { kk[2 * s] = kp[128 * s]; kk[2 * s + 1] = kp[128 * s + 64]; vv[s] = vp[128 * s]; } }
        { LAS float* out = KVS + jc * 4096 + 32 * hw * 64 + cq;
#pragma unroll
          for (int i = 0; i < 16; ++i) { const int e = crow(i, hi); out[e * 64] = a0[i]; out[e * 64 + 32] = a1[i]; } }
        __syncthreads();
#pragma unroll
        for (int j = 0; j < 4; ++j) {
            v4u pk; pk.x = cvtpk(st0[0], st0[1]); pk.y = cvtpk(st0[2], st0[3]); pk.z = cvtpk(st1[0], st1[1]); pk.w = cvtpk(st1[2], st1[3]);
            *(v4u*)(STg + ((size_t)(bh * 32 + 4 * r + j)) * 4096 + st_off) = pk;
            const LAS float* kvp = KVS + j * 4096 + se * 64 + 8 * sd; const f32x4 x0 = *(const LAS f32x4*)kvp, x1 = *(const LAS f32x4*)(kvp + 4);
            st0 = st0 * dec + x0; st1 = st1 * dec + x1; }
        __syncthreads();
    }
}
__device__ __forceinline__ void rout_unit(const bf16* QFr, const bf16* KFr, const bf16* VFr, const bf16* STg, const bf16* G, const float* gn_g, bf16* MIX, int b, int h, int n, int ch, int lane) {
    const int bh = b * 6 + h, hi = lane >> 5, cq = lane & 31, cc = 32 * ch + cq;
    const float lg2 = log_gamma(h) * LOG2E;
    const size_t token = (size_t)b * SEQ + n * CHUNK + cc;
    bf16x8 qf[4], kf[8], vf[8], sf[8]; u32x2 gw[8];
    { const bf16x8* qp = ftok(QFr, bh, n * 2 + ch, lane); const bf16x8* kp = ftok(KFr, bh, n * 2, lane); const bf16x8* vp = fdim(VFr, bh, 4 * n, lane);
      const bf16x8* sp = (const bf16x8*)(STg + ((size_t)(bh * 32 + n)) * 4096) + lane;
      const bf16* gp = G + token * 384 + h * 64 + 4 * hi;
#pragma unroll
      for (int s = 0; s < 4; ++s) qf[s] = qp[64 * s];
#pragma unroll
      for (int s = 0; s < 8; ++s) kf[s] = kp[64 * s];
#pragma unroll
      for (int s = 0; s < 8; ++s) sf[s] = sp[64 * s];
#pragma unroll
      for (int s = 0; s < 8; ++s) vf[s] = vp[64 * s];
#pragma unroll
      for (int g = 0; g < 4; ++g) { gw[g] = *(const u32x2*)(gp + 8 * g); gw[4 + g] = *(const u32x2*)(gp + 32 + 8 * g); } }
    f32x16 s0 = splat16(0.f), s1 = splat16(0.f);
#pragma unroll
    for (int s = 0; s < 4; ++s) { s0 = MFMA32(kf[s], qf[s], s0); s1 = MFMA32(kf[4 + s], qf[s], s1); }
#pragma unroll
    for (int i = 0; i < 16; ++i) { const int m0 = crow(i, hi); const int d0 = cc - m0, d1 = cc - m0 - 32;
        s0[i] *= ex2(lg2 * (float)(d0 < 0 ? -d0 : d0)); s1[i] *= ex2(lg2 * (float)(d1 < 0 ? -d1 : d1)); }
    f32x16 o0 = splat16(0.f), o1 = splat16(0.f);
#pragma unroll
    for (int s = 0; s < 4; ++s) { o0 = MFMA32(sf[s], qf[s], o0); o1 = MFMA32(sf[4 + s], qf[s], o1); }
    { const float qd = ex2(lg2 * (float)(cc + 1));
#pragma unroll
      for (int i = 0; i < 16; ++i) { o0[i] *= qd; o1[i] *= qd; } }
    { bf16x8 pf;
      pf = packfrag<0>(s0); o0 = MFMA32(vf[0], pf, o0); o1 = MFMA32(vf[1], pf, o1);
      pf = packfrag<1>(s0); o0 = MFMA32(vf[2], pf, o0); o1 = MFMA32(vf[3], pf, o1);
      pf = packfrag<0>(s1); o0 = MFMA32(vf[4], pf, o0); o1 = MFMA32(vf[5], pf, o1);
      pf = packfrag<1>(s1); o0 = MFMA32(vf[6], pf, o0); o1 = MFMA32(vf[7], pf, o1); }
    float sm = 0.f;
#pragma unroll
    for (int i = 0; i < 16; ++i) sm += o0[i] + o1[i];
    sm += __shfl_xor(sm, 32); const float mu = sm * (1.0f / 64.0f);
    float vr = 0.f;
#pragma unroll
    for (int i = 0; i < 16; ++i) { o0[i] -= mu; o1[i] -= mu; vr += o0[i] * o0[i] + o1[i] * o1[i]; }
    vr += __shfl_xor(vr, 32); const float rstd = rsqrtf(vr * (1.0f / 64.0f) + EPS);
    const float* gg = gn_g + h * 64 + 4 * hi; bf16* op = MIX + token * 1024 + D_ATT + D_CONV + h * 64 + 4 * hi;
#pragma unroll
    for (int g = 0; g < 4; ++g) {
        { const f32x4 gn = *(const f32x4*)(gg + 8 * g); u32x2 wv;
          wv.x = cvtpk(o0[4 * g] * rstd * gn[0] * __uint_as_float(gw[g].x << 16), o0[4 * g + 1] * rstd * gn[1] * __uint_as_float(gw[g].x & 0xffff0000u));
          wv.y = cvtpk(o0[4 * g + 2] * rstd * gn[2] * __uint_as_float(gw[g].y << 16), o0[4 * g + 3] * rstd * gn[3] * __uint_as_float(gw[g].y & 0xffff0000u)); *(u32x2*)(op + 8 * g) = wv; }
        { const f32x4 gn = *(const f32x4*)(gg + 32 + 8 * g); u32x2 wv;
          wv.x = cvtpk(o1[4 * g] * rstd * gn[0] * __uint_as_float(gw[4 + g].x << 16), o1[4 * g + 1] * rstd * gn[1] * __uint_as_float(gw[4 + g].x & 0xffff0000u));
          wv.y = cvtpk(o1[4 * g + 2] * rstd * gn[2] * __uint_as_float(gw[4 + g].y << 16), o1[4 * g + 3] * rstd * gn[3] * __uint_as_float(gw[4 + g].y & 0xffff0000u)); *(u32x2*)(op + 32 + 8 * g) = wv; }
    }
}
__device__ __forceinline__ float dpp_sum8(float v) {
    v += __builtin_bit_cast(float, __builtin_amdgcn_update_dpp(0, __builtin_bit_cast(int, v), 0xB1, 0xF, 0xF, true));
    v += __builtin_bit_cast(float, __builtin_amdgcn_update_dpp(0, __builtin_bit_cast(int, v), 0x4E, 0xF, 0xF, true));
    v += __builtin_bit_cast(float, __builtin_amdgcn_update_dpp(0, __builtin_bit_cast(int, v), 0x141, 0xF, 0xF, true));
    return v;
}
__device__ __forceinline__ void conv_unit(Frame& F, int L, int unit, const bf16* GLU, const bf16* PWT, bf16* MIX) {
    const float* cw = F.in(7) + L * CONV_K * 256; const float* cb = F.in(8) + L * 256; const float* lng = F.in(9) + L * 256; const float* lnb = F.in(10) + L * 256; const float* pwb = F.in(12) + L * 256;
    LAS unsigned char* lds = F.lds + RING_OFF; LAS float* Y = (LAS float*)(lds + 49152);
    const int t0 = unit * 64, s0 = t0 & 2047, tid = F.tid, lane = F.lane, w = F.wave;
    const int cp = tid & 127, tg = tid >> 7;
    f32x2_t wv[31];
#pragma unroll
    for (int j = 0; j < 31; ++j) wv[j] = *(const f32x2_t*)(cw + j * 256 + 2 * cp);
    const f32x2_t bb = *(const f32x2_t*)(cb + 2 * cp);
    for (int i = tid; i < 94 * 32; i += 512) { const int r = i >> 5, c16 = i & 31; v4u v = {0u, 0u, 0u, 0u};
        if (s0 - 30 + r >= 0) v = *(const v4u*)(GLU + (size_t)(t0 - 30 + r) * 256 + c16 * 8);
        *(LAS v4u*)(lds + r * 512 + c16 * 16) = v; }
    __syncthreads();
    { unsigned win[46];
#pragma unroll
      for (int i = 0; i < 46; ++i) win[i] = *(const LAS unsigned*)(lds + (tg * 16 + i) * 512 + cp * 4);
#pragma unroll
      for (int tt = 0; tt < 16; ++tt) { f32x2_t a = bb;
#pragma unroll
          for (int j = 0; j < 31; ++j) { const f32x2_t x = {__uint_as_float(win[tt + j] << 16), __uint_as_float(win[tt + j] & 0xffff0000u)}; a = __builtin_elementwise_fma(x, wv[j], a); }
          *(LAS f32x2_t*)(Y + (tg * 16 + tt) * 256 + 2 * cp) = a; } }
    const int hi = lane >> 5;
    bf16x8 Af[16];
    { const bf16* ap = PWT + (size_t)(32 * w + (lane & 31)) * 256 + 8 * hi;
#pragma unroll
      for (int s = 0; s < 16; ++s) Af[s] = *(const bf16x8*)(ap + 16 * s); }
    __syncthreads();
    { const int t = tid >> 3, p = tid & 7;
      f32x4 v[8]; float sm = 0.f;
#pragma unroll
      for (int i = 0; i < 8; ++i) { v[i] = *(const LAS f32x4*)(Y + t * 256 + 32 * p + 4 * i); sm += (v[i].x + v[i].y) + (v[i].z + v[i].w); }
      const float mu = dpp_sum8(sm) * (1.f / 256.f); float q = 0.f;
#pragma unroll
      for (int i = 0; i < 8; ++i) { v[i] = v[i] - mu; q += (v[i].x * v[i].x + v[i].y * v[i].y) + (v[i].z * v[i].z + v[i].w * v[i].w); }
      const float r = rsqrtf(dpp_sum8(q) * (1.f / 256.f) + EPS);
#pragma unroll
      for (int c8 = 0; c8 < 4; ++c8) {
          const f32x4 g0 = *(const f32x4*)(lng + 32 * p + 8 * c8), g1 = *(const f32x4*)(lng + 32 * p + 8 * c8 + 4), b0 = *(const f32x4*)(lnb + 32 * p + 8 * c8), b1 = *(const f32x4*)(lnb + 32 * p + 8 * c8 + 4);
          f32x4 o0 = v[2 * c8] * r * g0 + b0, o1 = v[2 * c8 + 1] * r * g1 + b1;
#pragma unroll
          for (int j = 0; j < 4; ++j) { o0[j] *= pg8::sigm(o0[j]); o1[j] *= pg8::sigm(o1[j]); }
          v4u pk; pk.x = cvtpk(o0[0], o0[1]); pk.y = cvtpk(o0[2], o0[3]); pk.z = cvtpk(o1[0], o1[1]); pk.w = cvtpk(o1[2], o1[3]);
          *(LAS v4u*)(lds + ((((t >> 5) * 16 + 2 * p + (c8 >> 1)) * 64 + (c8 & 1) * 32 + (t & 31)) * 16)) = pk; } }
    __syncthreads();
    { f32x16 a0 = splat16(0.f), a1 = splat16(0.f);
#pragma unroll
      for (int s = 0; s < 16; ++s) { const bf16x8 B0 = *(const LAS bf16x8*)(lds + (s * 64 + lane) * 16), B1 = *(const LAS bf16x8*)(lds + ((16 + s) * 64 + lane) * 16);
          a0 = MFMA32(Af[s], B0, a0); a1 = MFMA32(Af[s], B1, a1); }
      bf16* op = MIX + (size_t)(t0 + (lane & 31)) * 1024 + D_ATT + 32 * w + 4 * hi; const float* bp = pwb + 32 * w + 4 * hi;
#pragma unroll
      for (int g = 0; g < 4; ++g) { const f32x4 bv = *(const f32x4*)(bp + 8 * g); u32x2 x;
          x.x = cvtpk(a0[4 * g] + bv[0], a0[4 * g + 1] + bv[1]); x.y = cvtpk(a0[4 * g + 2] + bv[2], a0[4 * g + 3] + bv[3]); *(u32x2*)(op + 8 * g) = x;
          x.x = cvtpk(a1[4 * g] + bv[0], a1[4 * g + 1] + bv[1]); x.y = cvtpk(a1[4 * g + 2] + bv[2], a1[4 * g + 3] + bv[3]); *(u32x2*)(op + 32 * 1024 + 8 * g) = x; } }
    __syncthreads();
}

template <int SUB> __device__ __forceinline__ void layer_phase(Frame& F, const int L) {
    bf16* HBP = (bf16*)(F.ws + WS_HB + (size_t)(L & 1) * HB_BYTES); bf16* HBQ = (bf16*)(F.ws + WS_HB + (size_t)((L + 1) & 1) * HB_BYTES);
    float* SS0 = (float*)(F.ws + WS_SS); float* SS1 = SS0 + (size_t)M * 16; float* SS2 = SS1 + (size_t)M * 16;
    bf16* PJ = (bf16*)(F.ws + WS_PROJ); bf16* MIX = (bf16*)(F.ws + WS_MIX);
    bf16 *QFa = PJ, *KFa = PJ + FRAG_T, *VFa = PJ + 2 * FRAG_T, *QFr = PJ + 3 * FRAG_T, *KFr = PJ + 4 * FRAG_T, *KTr = PJ + 5 * FRAG_T, *VFr = PJ + 6 * FRAG_T, *GG = PJ + 7 * FRAG_T, *GLU = PJ + 8 * FRAG_T;
    bf16* HID = (bf16*)(F.ws + WS_HID); bf16* PLE = (bf16*)(F.ws + WS_PLE);
    const bf16* WB = (const bf16*)(F.ws + WS_WBUF + (size_t)(L & 1) * WBUF_BYTES);
    if constexpr (SUB == 0) {
        pg8::InProjOrder S; S.init(M, NIN_ROWS, 1024, F.G, F.bid, HBP, WB + WO_WIN);
        pg8::EpiInProj E{{PJ, SS0, F.in(4) + L * 64, F.in(5) + L * 64, F.ws + WS_CS}};
        pg8::gemm_phase<pg8::EpiInProj, pg8::InProjOrder, true, true>(F.lds + RING_OFF, 1024, S, E, F.tid);
        if (F.G == 256) {
            __syncthreads();
            pg8::PleOrder S2; S2.init(F.bid, (const bf16*)(F.ws + WS_PB), WB + WO_WPLE);
            pg8::EpiBf16<0, false> E2{PLE, 1024, nullptr};
            int wv2 = F.wave; asm volatile("" : "+s"(wv2));
            const int t2 = wv2 * 64 + (int)__builtin_amdgcn_mbcnt_hi(~0u, __builtin_amdgcn_mbcnt_lo(~0u, 0u));
            int kk = 256; asm volatile("" : "+s"(kk));
            pg8::gemm_phase<pg8::EpiBf16<0, false>, pg8::PleOrder, false, true>(F.lds + RING_OFF, kk, S2, E2, t2);
        }
    } else if constexpr (SUB == 1 || SUB == 2) {
        constexpr int ATT_M1 = 192;
        const float* bt = (const float*)(F.ws + WS_BT) + (size_t)L * H_ATT * 7 * 1024; const float* rb = F.in(6) + L * H_ATT * 257; const float* gn = F.in(13) + L * D_RET;
        bf16* STg = (bf16*)(F.ws + WS_ST);
        gu32* qctr = (gu32*)(F.ws + WS_CTL) + CW_QUEUE + 64 * L + 16 * (SUB - 1) + 32 * F.dup;
        volatile LAS unsigned* qslot = (volatile LAS unsigned*)(F.lds + MISC_OFF) + 16;
        constexpr int NITEMS = SUB == 1 ? 48 + 256 + ATT_M1 : 384 + (384 - ATT_M1);
        for (;;) {
            __syncthreads();
            if (F.tid == 0) *qslot = __hip_atomic_fetch_add(qctr, 1u, __ATOMIC_RELAXED, __HIP_MEMORY_SCOPE_AGENT);
            __syncthreads();
            const int it = (int)__builtin_amdgcn_readfirstlane(*qslot);
            if (it >= NITEMS) break;
            Frame F2 = F; { int t_ = F.tid; asm volatile("" : "+v"(t_)); F2.tid = t_; F2.lane = t_ & 63; }
            int au = -1;
            if constexpr (SUB == 1) {
                if (it < 48) ret_state_unit(F2, KTr, VFr, STg, it);
                else if (it < 48 + ATT_M1) au = it - 48;
                else conv_unit(F2, L, it - 48 - ATT_M1, GLU, WB + WO_PW, MIX);
            } else {
                if (it < 384 - ATT_M1) au = ATT_M1 + it;
                else { const int u = it - (384 - ATT_M1), bh = u >> 3, n = 4 * (u & 7) + (F2.wave >> 1); rout_unit(QFr, KFr, VFr, STg, GG, gn, MIX, bh / 6, bh % 6, n, F2.wave & 1, F2.lane); }
            }
            if (au >= 0) { int grp, bh; if (au < 288) { grp = 2 + au / 48; bh = au % 48; } else { grp = 1 - (au - 288) / 48; bh = (au - 288) % 48; }
                attn_block_unit(F2, QFa, KFa, VFa, bt, rb, MIX, bh, 4 * grp); }
        }
        __syncthreads();
        if constexpr (SUB == 2) { if (L + 1 < DEPTH) { convert_p(F, L + 1); convert_layer(F, L + 1); } }
    } else if constexpr (SUB == 3) {
        pg8::StaticOrder S; S.init(M, 1024, 1024, F.G, F.bid, MIX, WB + WO_WO);
        pg8::EpiRes<false> E{HBP, HBQ, SS1, nullptr, nullptr, nullptr};
        pg8::gemm_phase<pg8::EpiRes<false>, pg8::StaticOrder, false, true>(F.lds + RING_OFF, 1024, S, E, F.tid);
    } else if constexpr (SUB == 4) {
        pg8::StaticOrder S; S.init(M, 4096, 1024, F.G, F.bid, HBQ, WB + WO_W1);
        pg8::EpiBf16<1, true> E{HID, 4096, SS1};
        pg8::gemm_phase<pg8::EpiBf16<1, true>, pg8::StaticOrder, true, true>(F.lds + RING_OFF, 1024, S, E, F.tid);
    } else if constexpr (SUB == 5) {
        pg8::StaticOrder S; S.init(M, 1024, 4096, F.G, F.bid, HID, WB + WO_W2);
        pg8::EpiRes<false> E{HBQ, HBP, SS2, nullptr, nullptr, nullptr};
        pg8::gemm_phase<pg8::EpiRes<false>, pg8::StaticOrder, false, true>(F.lds + RING_OFF, 4096, S, E, F.tid);
    } else {
        if (F.G != 256) { pg8::StaticOrder S; S.init(M, 1024, 256, F.G, F.bid, (const bf16*)(F.ws + WS_PB), WB + WO_WPLE);
          pg8::EpiBf16<0, false> E{PLE, 1024, nullptr};
          pg8::gemm_phase<pg8::EpiBf16<0, false>, pg8::StaticOrder, false, true>(F.lds + RING_OFF, 256, S, E, F.tid); }
        __syncthreads();
        { pg8::StaticOrder S; S.init(M, 1024, 1024, F.G, F.bid, HBP, WB + WO_WPG);
          pg8::EpiRes<true> E{HBP, HBQ, SS0, SS2, PLE, L == DEPTH - 1 ? F.H : nullptr};
          pg8::gemm_phase<pg8::EpiRes<true>, pg8::StaticOrder, false, true>(F.lds + RING_OFF, 1024, S, E, F.tid); }
    }
}
constexpr int PH_PER_LAYER = 7, N_PHASES = 1 + PH_PER_LAYER * DEPTH;
__global__ void __launch_bounds__(NWAVES * 64, 2) mk_fwd(Args args) {
    extern __shared__ __attribute__((aligned(16))) unsigned char lds[];
    LAS unsigned char* const ldsb = (LAS unsigned char*)lds;
    for (int u = threadIdx.x; u < (LDS_BYTES - LDSCTL_OFF) / 4; u += NWAVES * 64) ((LAS unsigned*)(ldsb + LDSCTL_OFF))[u] = 0u;
    __syncthreads();
    if (threadIdx.x == 0) {
        LAS unsigned long long* P = (LAS unsigned long long*)(ldsb + PTR_OFF);
#pragma unroll
        for (int i = 0; i < 21; ++i) P[i] = (unsigned long long)(uintptr_t)args.in[i];
        P[21] = (unsigned long long)(uintptr_t)args.out; P[22] = (unsigned long long)(uintptr_t)args.ws;
    }
    __syncthreads();
    XcdBarrier bar; { unsigned char* ws0 = args.ws; bar.bar = (unsigned*)(ws0 + WS_CTL) + CW_BAR; bar.x = 0; bar.st = nullptr;
    const bool multi = (args.ph_hi - args.ph_lo) > 1;
    if (multi) bar = xcd_barrier_post((unsigned*)(ws0 + WS_CTL) + CW_BAR, (volatile LAS unsigned*)(ldsb + MISC_OFF) + 8); }
    const int lo = args.ph_lo, hi = args.ph_hi;
    const int wave0 = __builtin_amdgcn_readfirstlane(threadIdx.x >> 6);
#define FRAME_INIT() \
        int wv_ = wave0, bid_ = blockIdx.x; asm volatile("" : "+s"(wv_)); asm volatile("" : "+s"(bid_)); \
        int tid_ = wv_ * 64 + (int)__builtin_amdgcn_mbcnt_hi(~0u, __builtin_amdgcn_mbcnt_lo(~0u, 0u)); \
        Frame F; F.lds = ldsb; F.tid = tid_; F.lane = tid_ & 63; F.wave = __builtin_amdgcn_readfirstlane(tid_ >> 6); \
        F.G = gridDim.x; F.bid = bid_; F.gw = F.bid * NWAVES + F.wave; F.ngw = F.G * NWAVES; F.dup = 0; \
        { LAS unsigned long long* P = (LAS unsigned long long*)(ldsb + PTR_OFF); \
          F.H = (float*)(uintptr_t)rfl64(P[21]); F.ws = (unsigned char*)(uintptr_t)rfl64(P[22]); }
#define GRID_BAR() do { XcdBarrier b2; b2.bar = (unsigned*)(F.ws + WS_CTL) + CW_BAR; b2.x = xb_xcc_id(); b2.st = (volatile LAS unsigned*)(F.lds + MISC_OFF) + 8; xcd_barrier(b2); } while (0)
#define RUN_PHASE(ph, call) if (lo <= (ph) && (ph) < hi) { FRAME_INIT(); call; if ((ph) + 1 < hi) GRID_BAR(); }
#ifndef MK_DUP_SUB
#define MK_DUP_SUB -1
#endif
#define RUN_PHASE_L(ph, SUBI, L) if (lo <= (ph) && (ph) < hi) { FRAME_INIT(); layer_phase<SUBI>(F, (L)); if (SUBI == MK_DUP_SUB) { GRID_BAR(); F.dup = 1; layer_phase<SUBI>(F, (L)); } if ((ph) + 1 < hi) GRID_BAR(); }
    RUN_PHASE(0, prologue(F))
#define RUN_LAYER(L) \
    RUN_PHASE_L(1 + 7 * (L) + 0, 0, L) RUN_PHASE_L(1 + 7 * (L) + 1, 1, L) RUN_PHASE_L(1 + 7 * (L) + 2, 2, L) RUN_PHASE_L(1 + 7 * (L) + 3, 3, L) \
    RUN_PHASE_L(1 + 7 * (L) + 4, 4, L) RUN_PHASE_L(1 + 7 * (L) + 5, 5, L) RUN_PHASE_L(1 + 7 * (L) + 6, 6, L)
    RUN_LAYER(0) RUN_LAYER(1) RUN_LAYER(2) RUN_LAYER(3)
}

extern "C" void kernel_launch(void* const* d_in, const int* in_sizes, int n_in, void* d_out, int out_size, void* d_ws, size_t ws_size, hipStream_t stream) {
    static int grid = 0;
    if (grid == 0) {
        if (n_in != 21 || out_size != M * D_MODEL || ws_size < WS_END) { fprintf(stderr, "kernel_launch: unexpected shapes / workspace (%d inputs, out %d, ws %zu)\n", n_in, out_size, ws_size); grid = -1; return; }
        int dev = 0, cus = 0, per_cu = 0;
        if (hipGetDevice(&dev) != hipSuccess || hipDeviceGetAttribute(&cus, hipDeviceAttributeMultiprocessorCount, dev) != hipSuccess) { grid = -1; return; }
        if (hipFuncSetAttribute((const void*)mk_fwd, hipFuncAttributeMaxDynamicSharedMemorySize, LDS_BYTES) != hipSuccess) { fprintf(stderr, "kernel_launch: hipFuncSetAttribute failed\n"); grid = -1; return; }
        if (hipOccupancyMaxActiveBlocksPerMultiprocessor(&per_cu, (const void*)mk_fwd, NWAVES * 64, LDS_BYTES) != hipSuccess || per_cu < 1) { fprintf(stderr, "kernel_launch: occupancy query says %d\n", per_cu); per_cu = 1; }
        (void)hipGetLastError();
        grid = cus;
    }
    if (grid < 0) return;
    if (hipMemsetAsync((char*)d_ws + WS_CTL, 0, CTL_ZERO_BYTES, stream) != hipSuccess) return;
    Args a{};
    for (int i = 0; i < 21; ++i) a.in[i] = (const float*)d_in[i];
    a.out = (float*)d_out; a.ws = (unsigned char*)d_ws;
#if MK_PER_PHASE
    for (int ph = 0; ph < N_PHASES; ++ph) { a.ph_lo = ph; a.ph_hi = ph + 1; hipLaunchKernelGGL(mk_fwd, dim3(grid), dim3(NWAVES * 64), LDS_BYTES, stream, a); }
#else
    a.ph_lo = 0; a.ph_hi = N_PHASES;
    void* kargs[] = {&a};
    hipError_t e = hipLaunchCooperativeKernel((const void*)mk_fwd, dim3(grid), dim3(NWAVES * 64), kargs, LDS_BYTES, stream);
    if (e != hipSuccess) fprintf(stderr, "kernel_launch: cooperative launch failed: %s (grid %d)\n", hipGetErrorString(e), grid);
#endif
}
```

```cpp
#include <hip/hip_runtime.h>
#include <cstdio>
#include <cstdint>

#ifndef MK_FORCE_GLOBAL
#define MK_FORCE_GLOBAL 0
#endif
#ifndef MK_PER_PHASE
#define MK_PER_PHASE 0
#endif

namespace pg8 {
#define PG8_LAS __attribute__((address_space(3)))
typedef unsigned short bf16_t;
typedef short bf16x8 __attribute__((ext_vector_type(8)));
typedef float f32x4 __attribute__((ext_vector_type(4)));
typedef unsigned u32x4 __attribute__((ext_vector_type(4)));
constexpr int BM = 256, BK = 64, HALF = 128, HTB = HALF * BK * 2, STAGE_BYTES = 8 * HTB, NXCD = 8, WGM = 8;
__host__ __device__ __forceinline__ int lds_byte(int r, int c) { const int st = (r >> 4) * 2 + (c >> 5), rr = r & 15, cc = c & 31, ob = rr * 64 + cc * 2; return st * 1024 + (ob ^ (((ob >> 9) & 1) << 5)); }
__host__ __device__ __forceinline__ void stage_rc(int b, int& R, int& C) { const int st = b / 1024, sb = b % 1024, swz = sb ^ (((sb >> 9) & 1) << 5); R = (st >> 1) * 16 + swz / 64; C = (st & 1) * 32 + (swz % 64) / 2; }
__host__ __device__ __forceinline__ int perm32(int rho) { const int n = rho >> 4, i = rho & 15; return 8 * (i >> 2) + 4 * n + (i & 3); }
struct Unit { int pm, pn; };
struct StaticOrder {
    int nM, nN, nwg, G, c; const char* A; const char* Bt; size_t tstep;
    __device__ void init(int M, int N, int K, int G_, int c_, const void* A_, const void* Bt_) { nM = M / BM; nN = N / BM; nwg = nM * nN; G = G_; c = c_; A = (const char*)A_; Bt = (const char*)Bt_; tstep = (size_t)BM * K * 2; }
    __device__ bool next(int i, Unit& u) const {
        const long L = (long)i * G + c; if (L >= nwg) return false;
        int wgid = (int)L; { const int q = nwg / NXCD, r = nwg % NXCD, xcd = wgid % NXCD, off = wgid / NXCD; wgid = (xcd < r ? xcd * (q + 1) : r * (q + 1) + (xcd - r) * q) + off; }
        const int nig = WGM * nN, gid = wgid / nig, fm = gid * WGM, gsz = (nM - fm) < WGM ? (nM - fm) : WGM;
        u.pm = fm + ((wgid % nig) % gsz); u.pn = (wgid % nig) / gsz; return true;
    }
    __device__ __forceinline__ const char* a_ptr(const Unit& u) const { return A + (size_t)u.pm * tstep; }
    __device__ __forceinline__ const char* b_ptr(const Unit& u) const { return Bt + (size_t)u.pn * tstep; }
    __device__ __forceinline__ void a_ready(const Unit&) const {}
    __device__ __forceinline__ void done(const Unit&) const {}
};
__device__ __forceinline__ unsigned cvt_pk_bf16(float lo, float hi) { unsigned r; asm volatile("v_cvt_pk_bf16_f32 %0, %1, %2" : "=v"(r) : "v"(lo), "v"(hi)); return r; }
__device__ __forceinline__ u32x4 pack8(f32x4 v0, f32x4 v1) { u32x4 w; w.x = cvt_pk_bf16(v0[0], v0[1]); w.y = cvt_pk_bf16(v0[2], v0[3]); w.z = cvt_pk_bf16(v1[0], v1[1]); w.w = cvt_pk_bf16(v1[2], v1[3]); return w; }
__device__ __forceinline__ float bfl(unsigned w) { return __uint_as_float(w << 16); }
__device__ __forceinline__ float bfh(unsigned w) { return __uint_as_float(w & 0xffff0000u); }

__device__ __forceinline__ float row_rstd(const float* SS, int row) {
    const f32x4* p = (const f32x4*)(SS + (size_t)row * 16); const f32x4 a = p[0], b = p[1], c = p[2], d = p[3];
    const float s = ((a[0] + a[1]) + (a[2] + a[3])) + ((b[0] + b[1]) + (b[2] + b[3])) + ((c[0] + c[1]) + (c[2] + c[3])) + ((d[0] + d[1]) + (d[2] + d[3]));
    return rsqrtf(s * (1.0f / 1024.0f) + 1e-6f);
}
template <int ACT, bool SCALE> struct EpiBf16 {
    static constexpr bool PERM = true, AFTER_DRAIN = false;
    bf16_t* O; int ldc; const float* SS;
    __device__ __forceinline__ void operator()(const f32x4 (&acc)[2][2][4][2], const Unit& u, int wr, int wc, int fr, int fq) const {
        asm volatile("" : "+v"(fr), "+v"(fq));
        float rs[8];
#pragma unroll
        for (int i = 0; i < 8; ++i) rs[i] = SCALE ? row_rstd(SS, u.pm * BM + (i >> 2) * HALF + wr * 64 + (i & 3) * 16 + fr) : 1.0f;
#pragma unroll
        for (int ai = 0; ai < 2; ++ai)
#pragma unroll
            for (int m = 0; m < 4; ++m) { const int row = u.pm * BM + ai * HALF + wr * 64 + m * 16 + fr; const float r = rs[ai * 4 + m];
#pragma unroll
                for (int bj = 0; bj < 2; ++bj) { const int col = u.pn * BM + bj * HALF + wc * 32 + 8 * fq; f32x4 v0 = acc[ai][bj][m][0] * r, v1 = acc[ai][bj][m][1] * r;
                    if (ACT == 1) {
#pragma unroll
                        for (int j = 0; j < 4; ++j) { const float a = fmaxf(v0[j], 0.f), b = fmaxf(v1[j], 0.f); v0[j] = a * a; v1[j] = b * b; } }
                    *(u32x4*)(O + (size_t)row * ldc + col) = pack8(v0, v1); } }
    }
};
struct EpiBias {
    static constexpr bool PERM = true, AFTER_DRAIN = false;
    bf16_t* O; int ldc; const float* bias;
    __device__ __forceinline__ void operator()(const f32x4 (&acc)[2][2][4][2], const Unit& u, int wr, int wc, int fr, int fq) const {
#pragma unroll
        for (int ai = 0; ai < 2; ++ai)
#pragma unroll
            for (int m = 0; m < 4; ++m) { const int row = u.pm * BM + ai * HALF + wr * 64 + m * 16 + fr;
#pragma unroll
                for (int bj = 0; bj < 2; ++bj) { const int col = u.pn * BM + bj * HALF + wc * 32 + 8 * fq; const f32x4 b0 = *(const f32x4*)(bias + col), b1 = *(const f32x4*)(bias + col + 4);
                    *(u32x4*)(O + (size_t)row * ldc + col) = pack8(acc[ai][bj][m][0] + b0, acc[ai][bj][m][1] + b1); } }
    }
};
template <bool GATE> struct EpiRes {
    static constexpr bool PERM = true, AFTER_DRAIN = false;
    const bf16_t* HBin; bf16_t* HB; float* SSout; const float* SSin; const bf16_t* PLE; float* OUT;
    __device__ __forceinline__ void operator()(const f32x4 (&acc)[2][2][4][2], const Unit& u, int wr, int wc, int fr, int fq) const {
        asm volatile("" : "+v"(fr), "+v"(fq));
        const int colb = u.pn * BM + wc * 32 + 8 * fq;
        constexpr int NB = GATE ? 2 : 4;
#pragma unroll
        for (int g0 = 0; g0 < 8; g0 += NB) {
            u32x4 hv[NB][2], pw[NB][2]; float rs[NB];
#pragma unroll
            for (int k = 0; k < NB; ++k) { const int ai = (g0 + k) >> 2, m = (g0 + k) & 3; const size_t off = (size_t)(u.pm * BM + ai * HALF + wr * 64 + m * 16 + fr) * 1024 + colb;
                rs[k] = GATE ? row_rstd(SSin, u.pm * BM + ai * HALF + wr * 64 + m * 16 + fr) : 1.0f;
#pragma unroll
                for (int bj = 0; bj < 2; ++bj) { hv[k][bj] = *(const u32x4*)(HBin + off + bj * HALF); if (GATE) pw[k][bj] = *(const u32x4*)(PLE + off + bj * HALF); } }
#pragma unroll
            for (int k = 0; k < NB; ++k) { const int ai = (g0 + k) >> 2, m = (g0 + k) & 3; const size_t off = (size_t)(u.pm * BM + ai * HALF + wr * 64 + m * 16 + fr) * 1024 + colb; const float r = rs[k]; float sq = 0.f;
#pragma unroll
                for (int bj = 0; bj < 2; ++bj) {
                    f32x4 v0 = acc[ai][bj][m][0], v1 = acc[ai][bj][m][1];
                    if (GATE) { const u32x4 p = pw[k][bj];
                        const f32x4 p0 = {bfl(p.x), bfh(p.x), bfl(p.y), bfh(p.y)}, p1 = {bfl(p.z), bfh(p.z), bfl(p.w), bfh(p.w)};
#pragma unroll
                        for (int j = 0; j < 4; ++j) { v0[j] = p0[j] / (1.0f + __expf(-v0[j] * r)); v1[j] = p1[j] / (1.0f + __expf(-v1[j] * r)); } }
                    { const u32x4 hh = hv[k][bj]; v0 = v0 + (f32x4){bfl(hh.x), bfh(hh.x), bfl(hh.y), bfh(hh.y)}; v1 = v1 + (f32x4){bfl(hh.z), bfh(hh.z), bfl(hh.w), bfh(hh.w)}; }
                    *(u32x4*)(HB + off + bj * HALF) = pack8(v0, v1);
                    if (OUT) { *(f32x4*)(OUT + off + bj * HALF) = v0; *(f32x4*)(OUT + off + bj * HALF + 4) = v1; }
                    sq += (v0[0] * v0[0] + v0[1] * v0[1]) + (v0[2] * v0[2] + v0[3] * v0[3]) + (v1[0] * v1[0] + v1[1] * v1[1]) + (v1[2] * v1[2] + v1[3] * v1[3]); }
                sq += __shfl_xor(sq, 16); sq += __shfl_xor(sq, 32);
                if (fq == 0) SSout[(size_t)(u.pm * BM + ai * HALF + wr * 64 + m * 16 + fr) * 16 + u.pn * 4 + wc] = sq; }
        }
    }
};

typedef float f32x2v __attribute__((ext_vector_type(2)));
typedef unsigned u32x2 __attribute__((ext_vector_type(2)));
struct InProjOut {
    bf16_t* PJ; const float* SS; const float* qn_g; const float* kn_g; const unsigned char* TAB;
    static constexpr size_t FT = 6291456;
    __device__ __forceinline__ bf16_t* QFa() const { return PJ; }            __device__ __forceinline__ bf16_t* KFa() const { return PJ + FT; }
    __device__ __forceinline__ bf16_t* VFa() const { return PJ + 2 * FT; }   __device__ __forceinline__ bf16_t* QFr() const { return PJ + 3 * FT; }
    __device__ __forceinline__ bf16_t* KFr() const { return PJ + 4 * FT; }   __device__ __forceinline__ bf16_t* KTr() const { return PJ + 5 * FT; }
    __device__ __forceinline__ bf16_t* VFr() const { return PJ + 6 * FT; }   __device__ __forceinline__ bf16_t* G() const { return PJ + 7 * FT; }
    __device__ __forceinline__ bf16_t* GLU() const { return PJ + 8 * FT; }
    __device__ __forceinline__ const float* CS() const { return (const float*)TAB; }
    __device__ __forceinline__ const float* CST() const { return (const float*)(TAB + 512 * 1024); }
    __device__ __forceinline__ const float* DK() const { return (const float*)(TAB + 2 * 1024 * 1024); }
};
struct InProjOrder : StaticOrder {
    __device__ __forceinline__ const char* a_ptr(const Unit& u) const { return u.pn < 10 ? A + (size_t)u.pm * tstep : Bt + (size_t)u.pn * tstep; }
    __device__ __forceinline__ const char* b_ptr(const Unit& u) const { return u.pn < 10 ? Bt + (size_t)u.pn * tstep : A + (size_t)u.pm * tstep; }
};
struct PleOrder {
    int c, nmax; const char* A; const char* Bt; size_t tstep;
    __device__ void init(int c_, const void* A_, const void* Bt_) { c = c_; A = (const char*)A_; Bt = (const char*)Bt_; tstep = (size_t)BM * 256 * 2; nmax = 4; asm volatile("" : "+s"(nmax)); }
    __device__ bool next(int i, Unit& u) const { if (c < 192 || i >= nmax) return false; const int il = i * 8 + ((c >> 3) - 24); u.pm = 8 * (c & 7) + (il >> 2); u.pn = il & 3; return true; }
    __device__ __forceinline__ const char* a_ptr(const Unit& u) const { return A + (size_t)u.pm * tstep; }
    __device__ __forceinline__ const char* b_ptr(const Unit& u) const { return Bt + (size_t)u.pn * tstep; }
    __device__ __forceinline__ void a_ready(const Unit&) const {}
    __device__ __forceinline__ void done(const Unit&) const {}
};
__device__ __forceinline__ float sigm(float x) { return 1.0f / (1.0f + __expf(-x)); }
__device__ __forceinline__ u32x2 pack4(f32x4 v) { u32x2 w; w.x = cvt_pk_bf16(v[0], v[1]); w.y = cvt_pk_bf16(v[2], v[3]); return w; }
struct EpiInProj {
    static constexpr bool PERM = true, AFTER_DRAIN = false;
    InProjOut o;
    __device__ __forceinline__ void operator()(const f32x4 (&acc)[2][2][4][2], const Unit& u, int wr, int wc, int fr, int fq) const {
        asm volatile("" : "+v"(fr), "+v"(fq));
        const int T = u.pn;
        if (T < 10) {
            int kind, head;
            if (T < 3) { const int g = 4 * T + wc; kind = g < 6 ? 0 : 1; head = g < 6 ? g : g - 6; }
            else if (T < 5) { kind = 2; head = 0; }
            else { const int g = 4 * (T - 5) + wc; kind = g < 6 ? 3 : (g < 12 ? 4 : (g < 18 ? 5 : 6)); head = g % 6; }
            if (kind == 6) return;
#pragma unroll
            for (int ai = 0; ai < 2; ++ai) {
#pragma unroll
                for (int m = 0; m < 4; ++m) {
                    const int token = u.pm * BM + ai * HALF + wr * 64 + m * 16 + fr; const float rstd = row_rstd(o.SS, token);
                    const int bb = token >> 11, s = token & 2047;
                    f32x4 a0 = acc[ai][0][m][0] * rstd, a1 = acc[ai][0][m][1] * rstd, b0 = acc[ai][1][m][0] * rstd, b1 = acc[ai][1][m][1] * rstd;
                    if (kind == 0 || kind == 1) {
                        float ss = (a0[0] * a0[0] + a0[1] * a0[1]) + (a0[2] * a0[2] + a0[3] * a0[3]) + (a1[0] * a1[0] + a1[1] * a1[1]) + (a1[2] * a1[2] + a1[3] * a1[3])
                                 + (b0[0] * b0[0] + b0[1] * b0[1]) + (b0[2] * b0[2] + b0[3] * b0[3]) + (b1[0] * b1[0] + b1[1] * b1[1]) + (b1[2] * b1[2] + b1[3] * b1[3]);
                        ss += __shfl_xor(ss, 16); ss += __shfl_xor(ss, 32);
                        const float r2 = rsqrtf(ss * (1.0f / 64.0f) + 1e-6f) * (kind == 0 ? 0.125f * 1.4426950408889634f : 1.0f);
                        const float* gp = (kind == 0 ? o.qn_g : o.kn_g) + 8 * fq;
                        const f32x4 g0 = *(const f32x4*)gp, g1 = *(const f32x4*)(gp + 4), g2 = *(const f32x4*)(gp + 32), g3 = *(const f32x4*)(gp + 36);
                        bf16_t* base = (kind == 0 ? o.QFa() : o.KFa()) + ((size_t)((bb * 6 + head) * 64 + (s >> 5)) * 4 + (fq >> 1)) * 512 + ((fq & 1) * 32 + (s & 31)) * 8;
                        *(u32x4*)base = pack8(a0 * g0 * r2, a1 * g1 * r2); *(u32x4*)(base + 1024) = pack8(b0 * g2 * r2, b1 * g3 * r2);
                    } else if (kind == 3 || kind == 4) {
                        const float sc = kind == 3 ? 0.125f : 1.0f;
                        const f32x4* cp = (const f32x4*)(o.CS() + (size_t)s * 64 + 16 * fq);
                        const f32x4 c0 = cp[0], c1 = cp[1], c2 = cp[2], c3 = cp[3];
                        f32x4 x0, x1, y0, y1;
                        x0[0] = (a0[0] * c0[0] - b0[0] * c0[1]) * sc; y0[0] = (a0[0] * c0[1] + b0[0] * c0[0]) * sc; x0[1] = (a0[1] * c0[2] - b0[1] * c0[3]) * sc; y0[1] = (a0[1] * c0[3] + b0[1] * c0[2]) * sc;
                        x0[2] = (a0[2] * c1[0] - b0[2] * c1[1]) * sc; y0[2] = (a0[2] * c1[1] + b0[2] * c1[0]) * sc; x0[3] = (a0[3] * c1[2] - b0[3] * c1[3]) * sc; y0[3] = (a0[3] * c1[3] + b0[3] * c1[2]) * sc;
                        x1[0] = (a1[0] * c2[0] - b1[0] * c2[1]) * sc; y1[0] = (a1[0] * c2[1] + b1[0] * c2[0]) * sc; x1[1] = (a1[1] * c2[2] - b1[1] * c2[3]) * sc; y1[1] = (a1[1] * c2[3] + b1[1] * c2[2]) * sc;
                        x1[2] = (a1[2] * c3[0] - b1[2] * c3[1]) * sc; y1[2] = (a1[2] * c3[1] + b1[2] * c3[0]) * sc; x1[3] = (a1[3] * c3[2] - b1[3] * c3[3]) * sc; y1[3] = (a1[3] * c3[3] + b1[3] * c3[2]) * sc;
                        bf16_t* base = (kind == 3 ? o.QFr() : o.KFr()) + ((size_t)((bb * 6 + head) * 64 + (s >> 5)) * 4 + (fq >> 1)) * 512 + ((fq & 1) * 32 + (s & 31)) * 8;
                        *(u32x4*)base = pack8(x0, x1); *(u32x4*)(base + 1024) = pack8(y0, y1);
                    } else if (kind == 5) {
#pragma unroll
                        for (int j = 0; j < 4; ++j) { a0[j] *= sigm(a0[j]); a1[j] *= sigm(a1[j]); b0[j] *= sigm(b0[j]); b1[j] *= sigm(b1[j]); }
                        bf16_t* base = o.G() + (size_t)token * 384 + head * 64 + 8 * fq;
                        *(u32x4*)base = pack8(a0, a1); *(u32x4*)(base + 32) = pack8(b0, b1);
                    } else {
#pragma unroll
                        for (int j = 0; j < 4; ++j) { a0[j] *= sigm(b0[j]); a1[j] *= sigm(b1[j]); }
                        *(u32x4*)(o.GLU() + (size_t)token * 256 + 128 * (T - 3) + 32 * wc + 8 * fq) = pack8(a0, a1);
                    }
                }
            }
        } else {
#pragma unroll
            for (int bj = 0; bj < 2; ++bj) {
                const int tok0 = u.pm * BM + bj * HALF + wc * 32 + 8 * fq, bb = tok0 >> 11, s0 = tok0 & 2047, kb16 = s0 >> 4, uu = (s0 >> 3) & 1;
                f32x4 rs0, rs1;
#pragma unroll
                for (int j = 0; j < 4; ++j) { rs0[j] = row_rstd(o.SS, tok0 + j); rs1[j] = row_rstd(o.SS, tok0 + 4 + j); }
#pragma unroll
                for (int ai = 0; ai < 2; ++ai) {
                    const int g = 4 * (T - 10) + 2 * ai + wr;
                    if (g >= 18) continue;
                    const int head = g % 6, bh = bb * 6 + head;
                    if (g < 12) {
                        bf16_t* dst = (g < 6 ? o.VFa() : o.VFr()) + ((size_t)(bh * 128 + kb16) * 2) * 512 + 4 * uu;
#pragma unroll
                        for (int m = 0; m < 4; ++m) { bf16_t* p = dst + ((m >> 1) * 64 + 16 * (m & 1) + fr) * 8;
                            *(u32x2*)p = pack4(acc[ai][bj][m][0] * rs0); *(u32x2*)(p + 256) = pack4(acc[ai][bj][m][1] * rs1); }
                    } else {
                        bf16_t* dst = o.KTr() + ((size_t)(bh * 128 + kb16) * 2) * 512 + 4 * uu;
                        const f32x4 dk0 = *(const f32x4*)(o.DK() + head * 64 + (s0 & 63)), dk1 = *(const f32x4*)(o.DK() + head * 64 + (s0 & 63) + 4);
#pragma unroll
                        for (int m = 0; m < 2; ++m) { const int i = 16 * m + fr;
                            const f32x4* cp = (const f32x4*)(o.CST() + ((size_t)i * 2048 + s0) * 2);
                            const f32x4 c0 = cp[0], c1 = cp[1], c2 = cp[2], c3 = cp[3];
                            const f32x4 t10 = acc[ai][bj][m][0] * rs0, t11 = acc[ai][bj][m][1] * rs1, t20 = acc[ai][bj][m + 2][0] * rs0, t21 = acc[ai][bj][m + 2][1] * rs1;
                            f32x4 x0, x1, y0, y1;
                            x0[0] = (t10[0] * c0[0] - t20[0] * c0[1]) * dk0[0]; y0[0] = (t10[0] * c0[1] + t20[0] * c0[0]) * dk0[0]; x0[1] = (t10[1] * c0[2] - t20[1] * c0[3]) * dk0[1]; y0[1] = (t10[1] * c0[3] + t20[1] * c0[2]) * dk0[1];
                            x0[2] = (t10[2] * c1[0] - t20[2] * c1[1]) * dk0[2]; y0[2] = (t10[2] * c1[1] + t20[2] * c1[0]) * dk0[2]; x0[3] = (t10[3] * c1[2] - t20[3] * c1[3]) * dk0[3]; y0[3] = (t10[3] * c1[3] + t20[3] * c1[2]) * dk0[3];
                            x1[0] = (t11[0] * c2[0] - t21[0] * c2[1]) * dk1[0]; y1[0] = (t11[0] * c2[1] + t21[0] * c2[0]) * dk1[0]; x1[1] = (t11[1] * c2[2] - t21[1] * c2[3]) * dk1[1]; y1[1] = (t11[1] * c2[3] + t21[1] * c2[2]) * dk1[1];
                            x1[2] = (t11[2] * c3[0] - t21[2] * c3[1]) * dk1[2]; y1[2] = (t11[2] * c3[1] + t21[2] * c3[0]) * dk1[2]; x1[3] = (t11[3] * c3[2] - t21[3] * c3[3]) * dk1[3]; y1[3] = (t11[3] * c3[3] + t21[3] * c3[2]) * dk1[3];
                            bf16_t* p = dst + i * 8;
                            *(u32x2*)p = pack4(x0); *(u32x2*)(p + 256) = pack4(x1); *(u32x2*)(p + 512) = pack4(y0); *(u32x2*)(p + 512 + 256) = pack4(y1); }
                    }
                }
            }
        }
    }
};

template <class Epi, class Sched, bool ALIGN_EPI = false, bool SP2 = false>
__device__ __forceinline__ void gemm_phase(PG8_LAS unsigned char* lds, const int K, const Sched& S, const Epi& E, const int tid) {
    const int wid = __builtin_amdgcn_readfirstlane(tid >> 6), lane = tid & 63, wr = wid >> 2, wc = wid & 3, fr = lane & 15, fq = lane >> 4;
    const int nt = K / BK;
    unsigned voffA[2], voffB[2];
#pragma unroll
    for (int i = 0; i < 2; ++i) { int R, C; stage_rc(tid * 16 + i * 8192, R, C); const int Rb = Epi::PERM ? ((R & ~31) + perm32(R & 31)) : R;
        voffA[i] = (unsigned)(R * K + C) * 2u; voffB[i] = (unsigned)(Rb * K + C) * 2u; }
    const size_t kstep = (size_t)(BK * 2);
    const size_t hstep = (size_t)HALF * K * 2;
    const unsigned ldsw = (unsigned)wid * 1024u;
    const int aoff = lds_byte(wr * 64 + fr, fq * 8), boff = lds_byte(wc * 32 + fr, fq * 8);
#define PG8_SA(b, h) (((b) * 2 + (h)) * HTB)
#define PG8_SB(b, h) ((4 + (b) * 2 + (h)) * HTB)
#define PG8_STAGE(bufoff, gbase, voff) do { _Pragma("unroll") for (int _i = 0; _i < 2; ++_i) \
        __builtin_amdgcn_global_load_lds((const unsigned*)((const char*)(gbase) + (voff)[_i]), (PG8_LAS unsigned*)(lds + (bufoff) + ldsw + _i * 8192), 16, 0, 0); } while (0)
#define PG8_LDA(dst, b, h) do { _Pragma("unroll") for (int m = 0; m < 4; ++m) _Pragma("unroll") for (int k = 0; k < 2; ++k) dst[m][k] = *(const PG8_LAS bf16x8*)(lds + PG8_SA(b, h) + aoff + m * 2048 + k * 1024); } while (0)
#define PG8_LDB(dst, b, h) do { _Pragma("unroll") for (int n = 0; n < 2; ++n) _Pragma("unroll") for (int k = 0; k < 2; ++k) dst[n][k] = *(const PG8_LAS bf16x8*)(lds + PG8_SB(b, h) + boff + n * 2048 + k * 1024); } while (0)
#define PG8_MMA(ai, bj, At, Bt) do { __builtin_amdgcn_s_setprio(1); _Pragma("unroll") for (int m = 0; m < 4; ++m) _Pragma("unroll") for (int n = 0; n < 2; ++n) _Pragma("unroll") for (int k = 0; k < 2; ++k) \
        acc[ai][bj][m][n] = __builtin_amdgcn_mfma_f32_16x16x32_bf16(Bt[n][k], At[m][k], acc[ai][bj][m][n], 0, 0, 0); __builtin_amdgcn_s_setprio(0); } while (0)
#define PG8_WAIT_V(n) asm volatile("s_waitcnt vmcnt(" #n ")" ::: "memory")
#define PG8_WAIT_L(n) asm volatile("s_waitcnt lgkmcnt(" #n ")" ::: "memory")
#define PG8_BAR __builtin_amdgcn_s_barrier()
#define PG8_SCHED __builtin_amdgcn_sched_barrier(0)
    Unit cur, nxt; int ui = 0;
    if (!S.next(0, cur)) return;
    f32x4 acc[2][2][4][2];
#pragma unroll
    for (int a = 0; a < 2; ++a)
#pragma unroll
        for (int b = 0; b < 2; ++b)
#pragma unroll
            for (int m = 0; m < 4; ++m)
#pragma unroll
                for (int n = 0; n < 2; ++n) acc[a][b][m][n] = (f32x4){0.f, 0.f, 0.f, 0.f};
    bf16x8 At[4][2], B0[2][2], B1[2][2];
    const char* cA = S.a_ptr(cur); const char* cB = S.b_ptr(cur);
    S.a_ready(cur);
    if constexpr (SP2) {
        PG8_STAGE(PG8_SB(0, 0), cB, voffB); PG8_STAGE(PG8_SB(0, 1), cB + hstep, voffB); PG8_STAGE(PG8_SA(0, 0), cA, voffA); PG8_STAGE(PG8_SA(0, 1), cA + hstep, voffA);
        if (wr == 1) PG8_BAR;
        PG8_WAIT_V(2); PG8_BAR;
        PG8_STAGE(PG8_SB(1, 0), cB + kstep, voffB); PG8_STAGE(PG8_SA(1, 0), cA + kstep, voffA); PG8_STAGE(PG8_SB(1, 1), cB + hstep + kstep, voffB);
        PG8_WAIT_V(6); PG8_BAR;
    } else {
        PG8_STAGE(PG8_SB(0, 0), cB, voffB); PG8_STAGE(PG8_SA(0, 0), cA, voffA); PG8_STAGE(PG8_SB(0, 1), cB + hstep, voffB); PG8_STAGE(PG8_SA(0, 1), cA + hstep, voffA);
        if (wr == 1) PG8_BAR;
        PG8_WAIT_V(4); PG8_BAR;
        PG8_STAGE(PG8_SB(1, 0), cB + kstep, voffB); PG8_STAGE(PG8_SA(1, 0), cA + kstep, voffA); PG8_STAGE(PG8_SB(1, 1), cB + hstep + kstep, voffB);
        PG8_WAIT_V(6); PG8_BAR;
    }
    for (;;) {
        const bool has_next = S.next(ui + 1, nxt);
        const char* nA = has_next ? S.a_ptr(nxt) : cA; const char* nB = has_next ? S.b_ptr(nxt) : cB;
        for (int t = 0; t < nt; t += 2) {
            const bool last = (t == nt - 2);
            const char* a1 = cA + (size_t)(t + 1) * kstep;
            const char* a2 = last ? nA : cA + (size_t)(t + 2) * kstep; const char* b2 = last ? nB : cB + (size_t)(t + 2) * kstep;
            const char* a3 = a2 + kstep; const char* b3 = b2 + kstep;
            if (last && has_next) S.a_ready(nxt);
            if constexpr (SP2) {
            PG8_LDB(B0, 0, 0); PG8_LDB(B1, 0, 1); PG8_SCHED; PG8_LDA(At, 0, 0); PG8_STAGE(PG8_SA(1, 1), a1 + hstep, voffA);
            PG8_WAIT_V(8); PG8_WAIT_L(0); PG8_BAR; PG8_MMA(0, 0, At, B0); PG8_MMA(0, 1, At, B1); PG8_BAR; PG8_SCHED;
            PG8_LDA(At, 0, 1); PG8_STAGE(PG8_SB(0, 0), b2, voffB); PG8_STAGE(PG8_SB(0, 1), b2 + hstep, voffB); PG8_STAGE(PG8_SA(0, 0), a2, voffA);
            PG8_WAIT_V(8); PG8_WAIT_L(0); PG8_BAR; PG8_MMA(1, 0, At, B0); PG8_MMA(1, 1, At, B1); PG8_BAR; PG8_SCHED;
            PG8_LDB(B0, 1, 0); PG8_LDB(B1, 1, 1); PG8_SCHED; PG8_LDA(At, 1, 0); PG8_STAGE(PG8_SA(0, 1), a2 + hstep, voffA);
            PG8_WAIT_V(8); PG8_WAIT_L(0); PG8_BAR; PG8_MMA(0, 0, At, B0); PG8_MMA(0, 1, At, B1); PG8_BAR; PG8_SCHED;
            PG8_LDA(At, 1, 1); PG8_STAGE(PG8_SB(1, 0), b3, voffB); PG8_STAGE(PG8_SB(1, 1), b3 + hstep, voffB); PG8_STAGE(PG8_SA(1, 0), a3, voffA);
            PG8_WAIT_V(8); PG8_WAIT_L(0); PG8_BAR; PG8_MMA(1, 0, At, B0); PG8_MMA(1, 1, At, B1); PG8_BAR; PG8_SCHED;
            } else {
            PG8_LDB(B0, 0, 0); PG8_SCHED; PG8_LDA(At, 0, 0); PG8_STAGE(PG8_SA(1, 1), a1 + hstep, voffA);
            PG8_WAIT_L(8); PG8_BAR; PG8_WAIT_L(0); PG8_MMA(0, 0, At, B0); PG8_BAR; PG8_SCHED;
            PG8_LDB(B1, 0, 1); PG8_STAGE(PG8_SB(0, 0), b2, voffB);
            PG8_BAR; PG8_WAIT_L(0); PG8_MMA(0, 1, At, B1); PG8_BAR;
            PG8_LDA(At, 0, 1); PG8_STAGE(PG8_SA(0, 0), a2, voffA);
            PG8_BAR; PG8_WAIT_L(0); PG8_MMA(1, 0, At, B0); PG8_BAR; PG8_SCHED;
            PG8_STAGE(PG8_SB(0, 1), b2 + hstep, voffB);
            PG8_WAIT_V(6); PG8_BAR; PG8_MMA(1, 1, At, B1); PG8_BAR;
            PG8_LDB(B0, 1, 0); PG8_SCHED; PG8_LDA(At, 1, 0); PG8_STAGE(PG8_SA(0, 1), a2 + hstep, voffA);
            PG8_WAIT_L(8); PG8_BAR; PG8_WAIT_L(0); PG8_MMA(0, 0, At, B0); PG8_BAR; PG8_SCHED;
            PG8_LDB(B1, 1, 1); PG8_STAGE(PG8_SB(1, 0), b3, voffB);
            PG8_BAR; PG8_WAIT_L(0); PG8_MMA(0, 1, At, B1); PG8_BAR;
            PG8_LDA(At, 1, 1); PG8_STAGE(PG8_SA(1, 0), a3, voffA);
            PG8_BAR; PG8_WAIT_L(0); PG8_MMA(1, 0, At, B0); PG8_BAR; PG8_SCHED;
            PG8_STAGE(PG8_SB(1, 1), b3 + hstep, voffB);
            PG8_WAIT_V(6); PG8_BAR; PG8_MMA(1, 1, At, B1); PG8_BAR;
            }
        }
        if constexpr (ALIGN_EPI) { if (wr == 0) PG8_BAR; }
        if constexpr (!Epi::AFTER_DRAIN) { E(acc, cur, wr, wc, fr, fq); S.done(cur); }
        if (!has_next) break;
#pragma unroll
        for (int a = 0; a < 2; ++a)
#pragma unroll
            for (int b = 0; b < 2; ++b)
#pragma unroll
                for (int m = 0; m < 4; ++m)
#pragma unroll
                    for (int n = 0; n < 2; ++n) acc[a][b][m][n] = (f32x4){0.f, 0.f, 0.f, 0.f};
        cur = nxt; cA = nA; cB = nB; ++ui;
        if constexpr (ALIGN_EPI) { if (wr == 1) PG8_BAR; }
    }
    PG8_WAIT_V(0);
    if constexpr (!ALIGN_EPI) { if (wr == 0) PG8_BAR; }
    PG8_BAR;
    if constexpr (Epi::AFTER_DRAIN) { E.fused(acc, cur, wr, wc, fr, fq, lds, wid, lane); S.done(cur); }
#undef PG8_SA
#undef PG8_SB
#undef PG8_STAGE
#undef PG8_LDA
#undef PG8_LDB
#undef PG8_MMA
#undef PG8_WAIT_V
#undef PG8_WAIT_L
#undef PG8_BAR
#undef PG8_SCHED
}
}

constexpr int D_MODEL = 1024, BATCH = 8, SEQ = 2048, DEPTH = 4, CHUNK = 64, NLEFT = 8, HD = 64;
constexpr int D_ATT = 384, D_RET = 384, D_CONV = 256, H_ATT = 6, H_RET = 6, CONV_K = 31, REL_CLIP = 128;
constexpr int D_FF = 4096, D_PLE = 256, D_IN = 3200, M = BATCH * SEQ, NC = SEQ / CHUNK;
constexpr int NIN_ROWS = 15 * 256;
constexpr float EPS = 1e-6f;
constexpr int C_QA = 0, C_KA = 384, C_VA = 768, C_UC = 1152, C_QR = 1664, C_KR = 2048, C_VR = 2432, C_GR = 2816;
constexpr int NWAVES = 8;

constexpr size_t MiB = 1u << 20;
constexpr size_t WS_CTL = 0, CTL_ZERO_BYTES = 1 * MiB;
constexpr size_t WS_SS = 1 * MiB;
constexpr size_t WS_WBUF = 4 * MiB, WBUF_BYTES = 29 * MiB;
constexpr size_t WS_HB = 62 * MiB, HB_BYTES = 32 * MiB;
constexpr size_t WS_PLE = 126 * MiB;
constexpr size_t WS_PROJ = 158 * MiB;
constexpr size_t WS_MIX = 262 * MiB;
constexpr size_t WS_HID = 158 * MiB;
constexpr size_t WS_PB = 294 * MiB;
constexpr size_t WS_CS = 302 * MiB;
constexpr size_t WS_CST = WS_CS + 512 * 1024;
constexpr size_t WS_BT = 303 * MiB;
constexpr size_t WS_DK = WS_CS + 2 * MiB;
constexpr size_t WS_ST = 305 * MiB;
constexpr size_t WS_PB2 = 318 * MiB;
constexpr size_t WS_END = 326 * MiB;
constexpr size_t WO_WIN = 0, WO_WO = WO_WIN + (size_t)NIN_ROWS * 1024, WO_W1 = WO_WO + 1024 * 1024, WO_W2 = WO_W1 + 4096 * 1024, WO_WPG = WO_W2 + 4096 * 1024,
                 WO_WPLE = WO_WPG + 1024 * 1024, WO_PW = WO_WPLE + 1024 * 256, WO_END = WO_PW + 256 * 256;
static_assert(WO_END * 2 <= WBUF_BYTES, "weight buffer");
constexpr int CW_BAR = 4096, CW_QUEUE = 8192;

constexpr int RING_OFF = 0, RING_BYTES = 131072;
constexpr int LDSCTL_OFF = RING_BYTES, MISC_OFF = LDSCTL_OFF + 320;
constexpr int LDS_BYTES = 147456, PTR_OFF = LDSCTL_OFF + 1024;

#define GAS __attribute__((address_space(1)))
#define LAS __attribute__((address_space(3)))
typedef unsigned short bf16;
typedef unsigned v4u __attribute__((ext_vector_type(4)));
typedef float f32x4 __attribute__((ext_vector_type(4)));
typedef GAS unsigned gu32;
#define LDS_WAIT() asm volatile("s_waitcnt lgkmcnt(0)" ::: "memory")
__device__ __forceinline__ unsigned f2bf(float f) { unsigned u = __builtin_bit_cast(unsigned, f); return (u + 0x7fffu + ((u >> 16) & 1u)) >> 16; }
__device__ __forceinline__ unsigned pk2(float lo, float hi) { return f2bf(lo) | (f2bf(hi) << 16); }
__device__ __forceinline__ float bf2f(bf16 v) { return __uint_as_float((unsigned)v << 16); }

#define XB_TMO      128
#define XB_XCNT(j)  (256  + 64 * (j))
#define XB_XSUB(j)  (1280 + 64 * (j))
#define XB_XGEN(j)  (2304 + 64 * (j))
#define XB_TOP      3328
#define XB_TOPGEN   3392
#define XCD_BAR_WORDS 3456
#define XB_SPIN_CAP (1u << 18)

__device__ __forceinline__ unsigned xb_ld(unsigned* p)              { return __hip_atomic_load(p, __ATOMIC_RELAXED, __HIP_MEMORY_SCOPE_AGENT); }
__device__ __forceinline__ unsigned xb_add(unsigned* p, unsigned v) { return __hip_atomic_fetch_add(p, v, __ATOMIC_RELAXED, __HIP_MEMORY_SCOPE_AGENT); }
__device__ __forceinline__ unsigned xb_xcc_id() { return (unsigned)__builtin_amdgcn_s_getreg((3 << 11) | 20) & 0xFu; }
#define XB_SPIN(cond, bar) do { unsigned _sp = 0; while (cond) { __builtin_amdgcn_s_sleep(1); \
    if ((++_sp & 255u) == 0u) { if (xb_ld(&(bar)[XB_TMO])) break; if (_sp > XB_SPIN_CAP) { atomicAdd(&(bar)[XB_TMO], 1u); break; } } } } while (0)

struct XcdBarrier {
    bool local;
    unsigned* bar; unsigned x;
    volatile LAS unsigned* st;
};

__device__ __forceinline__ XcdBarrier xcd_barrier_post(unsigned* bar, volatile LAS unsigned* st) {
    XcdBarrier b; b.local = false; b.bar = bar; b.x = xb_xcc_id(); b.st = st;
    if (threadIdx.x == 0) { st[2] = xb_add(&bar[XB_XCNT(b.x)], 1u); st[4] = b.x; }
    return b;
}
__device__ __forceinline__ void xcd_barrier_complete(unsigned* bar, unsigned x, unsigned& nloc, unsigned& nx, unsigned& uni) {
    const unsigned G = gridDim.x * gridDim.y * gridDim.z;
    unsigned sum, cnt, mine, n32, sp = 0u;
    for (;;) {
        sum = 0u; cnt = 0u; mine = 0u; n32 = 0u;
#pragma unroll
        for (unsigned j = 0; j < 16; ++j) { const unsigned c = xb_ld(&bar[XB_XCNT(j)]); sum += c; cnt += (c > 0u) ? 1u : 0u; mine = (j == x) ? c : mine; n32 += (j < 8u && c == 32u) ? 1u : 0u; }
        if (sum == G) break;
        __builtin_amdgcn_s_sleep(1);
        if ((++sp & 255u) == 0u) { if (xb_ld(&bar[XB_TMO])) break; if (sp > XB_SPIN_CAP) { atomicAdd(&bar[XB_TMO], 1u); break; } }
    }
    nloc = mine > 0u ? mine : 1u; nx = cnt > 0u ? cnt : 1u; uni = (sum == G && G == 256u && n32 == 8u) ? 1u : 2u;
}

__device__ __forceinline__ void xcd_barrier(const XcdBarrier& b) {
    asm volatile("s_waitcnt vmcnt(0)" ::: "memory");
    __syncthreads();
    if (threadIdx.x == 0) {
        unsigned* bar = b.bar;
        __builtin_amdgcn_s_waitcnt(0);
        unsigned nloc = b.st[0], nx = b.st[1];
        if (nloc == 0u) { unsigned uni; xcd_barrier_complete(bar, b.x, nloc, nx, uni); b.st[0] = nloc; b.st[1] = nx; b.st[3] = MK_FORCE_GLOBAL ? 2u : uni; }
        const unsigned old = xb_add(&bar[XB_XSUB(b.x)], 1u);
        const unsigned gen = old / nloc;
        if (b.local && b.st[3] == 1u) {
            if (old + 1u == (gen + 1u) * nloc) xb_add(&bar[XB_XGEN(b.x)], 1u); else XB_SPIN(xb_ld(&bar[XB_XGEN(b.x)]) == gen, bar);
            __builtin_amdgcn_fence(__ATOMIC_ACQUIRE, "agent");
            asm volatile("s_waitcnt vmcnt(0)" ::: "memory");
        } else
        if (old + 1u == (gen + 1u) * nloc) {
            __builtin_amdgcn_fence(__ATOMIC_RELEASE, "agent");
            asm volatile("s_waitcnt vmcnt(0)" ::: "memory");
            const unsigned og = xb_add(&bar[XB_TOP], 1u);
            const unsigned tg = og / nx;
            if (og + 1u == (tg + 1u) * nx) xb_add(&bar[XB_TOPGEN], 1u);
            else XB_SPIN(xb_ld(&bar[XB_TOPGEN]) == tg, bar);
            __builtin_amdgcn_fence(__ATOMIC_ACQUIRE, "agent");
            xb_add(&bar[XB_XGEN(b.x)], 1u);
            asm volatile("s_waitcnt vmcnt(0)" ::: "memory");
        } else {
            XB_SPIN(xb_ld(&bar[XB_XGEN(b.x)]) == gen, bar);
            __builtin_amdgcn_fence(__ATOMIC_ACQUIRE, "agent");
            asm volatile("s_waitcnt vmcnt(0)" ::: "memory");
        }
    }
    __syncthreads();
}

__device__ __forceinline__ unsigned long long rfl64(unsigned long long v) { const unsigned lo = __builtin_amdgcn_readfirstlane((unsigned)v), hi = __builtin_amdgcn_readfirstlane((unsigned)(v >> 32)); return ((unsigned long long)hi << 32) | lo; }
struct Args { const float* in[21]; float* out; unsigned char* ws; int ph_lo, ph_hi; };
struct Frame {
    LAS unsigned char* lds; int tid, lane, wave, G, bid, gw, ngw, dup;
    float* H; unsigned char* ws;
    __device__ __forceinline__ const float* in(int k) const { return (const float*)(uintptr_t)rfl64(((LAS unsigned long long*)(lds + PTR_OFF))[k]); }
};
__device__ __forceinline__ float wave_sum(float v) {
#pragma unroll
    for (int o = 1; o < 64; o <<= 1) v += __shfl_xor(v, o);
    return v;
}
__device__ __forceinline__ float sigmoidf_(float x) { return 1.0f / (1.0f + expf(-x)); }

__host__ __device__ __forceinline__ int in_src_col(int nb) {
    const int T = nb >> 3, r = nb & 7;
    if (T < 3) { const int bj = r >> 2, g = 4 * T + (r & 3); return (g < 6 ? C_QA + 64 * g : C_KA + 64 * (g - 6)) + 32 * bj; }
    if (T < 5) { const int bj = r >> 2; return C_UC + 256 * bj + 128 * (T - 3) + 32 * (r & 3); }
    if (T < 10) { const int bj = r >> 2, g = 4 * (T - 5) + (r & 3); if (g >= 18) return -1; return (g < 6 ? C_QR + 64 * g : (g < 12 ? C_KR + 64 * (g - 6) : C_GR + 64 * (g - 12))) + 32 * bj; }
    { const int g = 4 * (T - 10) + (r >> 1); if (g >= 18) return -1; return (g < 6 ? C_VA + 64 * g : (g < 12 ? C_VR + 64 * (g - 6) : C_KR + 64 * (g - 12))) + 32 * (r & 1); }
}
__device__ __forceinline__ void transpose_item(const float* W, int K, int N, const float* gain, bf16* WT, LAS float* scr, int k0, int n0src, int n0dst, int lane) {
    if (n0src >= 0) {
        float v[32];
#pragma unroll
        for (int i = 0; i < 32; ++i) v[i] = W[(size_t)(k0 + 2 * i + (lane >> 5)) * N + n0src + (lane & 31)];
#pragma unroll
        for (int i = 0; i < 32; ++i) scr[(2 * i + (lane >> 5)) * 33 + (lane & 31)] = v[i];
    } else {
#pragma unroll 8
        for (int i = 0; i < 32; ++i) scr[(2 * i + (lane >> 5)) * 33 + (lane & 31)] = 0.f;
    }
    LDS_WAIT(); asm volatile("" ::: "memory");
    const int c = lane & 7;
    f32x4 g0 = {1.f, 1.f, 1.f, 1.f}, g1 = g0;
    if (gain) { g0 = *(const f32x4*)(gain + k0 + 8 * c); g1 = *(const f32x4*)(gain + k0 + 8 * c + 4); }
#pragma unroll
    for (int j = 0; j < 4; ++j) { const int n = (lane >> 3) + 8 * j; const LAS float* s = scr + (8 * c) * 33 + n;
        v4u o; o.x = pk2(s[0 * 33] * g0[0], s[1 * 33] * g0[1]); o.y = pk2(s[2 * 33] * g0[2], s[3 * 33] * g0[3]); o.z = pk2(s[4 * 33] * g1[0], s[5 * 33] * g1[1]); o.w = pk2(s[6 * 33] * g1[2], s[7 * 33] * g1[3]);
        *(GAS v4u*)(WT + (size_t)(n0dst + n) * K + k0 + 8 * c) = o; }
    LDS_WAIT(); asm volatile("" ::: "memory");
}
__device__ __forceinline__ void convert_layer(Frame& F, int L) {
    bf16* WB = (bf16*)(F.ws + WS_WBUF + (size_t)(L & 1) * WBUF_BYTES);
    LAS float* scr = (LAS float*)(F.lds + RING_OFF + F.wave * 16384);
    const float* w_in = F.in(3) + (size_t)L * 1024 * D_IN; const float* w_o = F.in(14) + (size_t)L * 1024 * 1024; const float* w1 = F.in(16) + (size_t)L * 1024 * 4096;
    const float* w2 = F.in(17) + (size_t)L * 4096 * 1024; const float* w_pg = F.in(19) + (size_t)L * 1024 * 1024; const float* w_ple = F.in(20) + (size_t)L * 256 * 1024;
    const float* pw = F.in(11) + (size_t)L * 256 * 256;
    const float* g_mix = F.in(2) + L * 1024; const float* g_ffn = F.in(15) + L * 1024; const float* g_ple = F.in(18) + L * 1024;
    constexpr int I_IN = 16 * (NIN_ROWS / 32), I_O = 16 * 32, I_1 = 16 * 128, I_2 = 64 * 32, I_PG = 16 * 32, I_PLE = 4 * 32, I_PW = 4 * 8;
    constexpr int NIT = I_IN + I_O + I_1 + I_2 + I_PG + I_PLE + I_PW;
    for (int it = F.gw; it < NIT; it += F.ngw) {
        int r = it;
        if (r < I_IN) { const int nb = r % (NIN_ROWS / 32), kb = r / (NIN_ROWS / 32); transpose_item(w_in, 1024, D_IN, g_mix, WB + WO_WIN, scr, 64 * kb, in_src_col(nb), 32 * nb, F.lane); continue; } r -= I_IN;
        if (r < I_O) { transpose_item(w_o, 1024, 1024, nullptr, WB + WO_WO, scr, 64 * (r / 32), 32 * (r % 32), 32 * (r % 32), F.lane); continue; } r -= I_O;
        if (r < I_1) { transpose_item(w1, 1024, 4096, g_ffn, WB + WO_W1, scr, 64 * (r / 128), 32 * (r % 128), 32 * (r % 128), F.lane); continue; } r -= I_1;
        if (r < I_2) { transpose_item(w2, 4096, 1024, nullptr, WB + WO_W2, scr, 64 * (r / 32), 32 * (r % 32), 32 * (r % 32), F.lane); continue; } r -= I_2;
        if (r < I_PG) { transpose_item(w_pg, 1024, 1024, g_ple, WB + WO_WPG, scr, 64 * (r / 32), 32 * (r % 32), 32 * (r % 32), F.lane); continue; } r -= I_PG;
        if (r < I_PLE) { transpose_item(w_ple, 256, 1024, nullptr, WB + WO_WPLE, scr, 64 * (r / 32), 32 * (r % 32), 32 * (r % 32), F.lane); continue; } r -= I_PLE;
        transpose_item(pw, 256, 256, nullptr, WB + WO_PW, scr, 64 * (r / 8), 32 * (r % 8), 32 * (r % 8), F.lane);
    }
}
__device__ __forceinline__ void sincos_acc(float ang, float& s, float& c) {
    const double x = (double)ang; const double kd = rint(x * 0.63661977236758134);
    const double r = (x - kd * 1.5707963267948966) - kd * 6.123233995736766e-17; const int q = ((int)kd) & 3; const double r2 = r * r;
    const double sp = r * (1.0 + r2 * (-1.0 / 6 + r2 * (1.0 / 120 + r2 * (-1.0 / 5040 + r2 * (1.0 / 362880 + r2 * (-1.0 / 39916800))))));
    const double cp = 1.0 + r2 * (-0.5 + r2 * (1.0 / 24 + r2 * (-1.0 / 720 + r2 * (1.0 / 40320 + r2 * (-1.0 / 3628800 + r2 * (1.0 / 479001600))))));
    double ss, cc;
    if (q == 0) { ss = sp; cc = cp; } else if (q == 1) { ss = cp; cc = -sp; } else if (q == 2) { ss = -sp; cc = -cp; } else { ss = -cp; cc = sp; }
    s = (float)ss; c = (float)cc;
}
__device__ __forceinline__ void convert_p(Frame& F, int L) {
    const GAS f32x4* p4 = (const GAS f32x4*)(F.in(1) + (size_t)L * M * D_PLE); GAS unsigned long long* o8 = (GAS unsigned long long*)(F.ws + ((L & 1) ? WS_PB2 : WS_PB)); const int n4 = M * D_PLE / 4;
    for (int i = F.bid * 512 + F.tid; i < n4; i += F.G * 512) { const f32x4 v = p4[i]; o8[i] = (unsigned long long)pk2(v.x, v.y) | ((unsigned long long)pk2(v.z, v.w) << 32); }
}
__device__ __forceinline__ float log_gamma(int h) { return logf(1.0f - exp2f(-5.0f - (float)h)); }
__device__ __forceinline__ void prologue(Frame& F) {
    convert_layer(F, 0); convert_p(F, 0);
    const float* x = F.in(0); bf16* HB = (bf16*)(F.ws + WS_HB); float* SS = (float*)(F.ws + WS_SS);
    for (int m = F.gw; m < M; m += F.ngw) {
        const GAS f32x4* xr = (const GAS f32x4*)(x + (size_t)m * 1024) + F.lane;
        GAS unsigned long long* o8 = (GAS unsigned long long*)(HB + (size_t)m * 1024) + F.lane; float s = 0.f;
#pragma unroll
        for (int j = 0; j < 4; ++j) { const f32x4 v = xr[64 * j]; s += (v.x * v.x + v.y * v.y) + (v.z * v.z + v.w * v.w);
            o8[64 * j] = (unsigned long long)pk2(v.x, v.y) | ((unsigned long long)pk2(v.z, v.w) << 32); }
        s = wave_sum(s);
        if (F.lane < 16) SS[(size_t)m * 16 + F.lane] = F.lane == 0 ? s : 0.f;
    }
    { float2* cs = (float2*)(F.ws + WS_CS); float2* cst = (float2*)(F.ws + WS_CST);
      for (int idx = F.bid * 512 + F.tid; idx < SEQ * 32; idx += F.G * 512) { const int pos = idx >> 5, i = idx & 31; const float inv_freq = powf(10000.0f, -(float)(2 * i) / 64.0f);
          float s, c; sincos_acc((float)pos * inv_freq, s, c); cs[idx] = make_float2(c, s); cst[i * SEQ + pos] = make_float2(c, s); } }
    { float* bt = (float*)(F.ws + WS_BT); const float* rbp = F.in(6);
      for (int idx = F.bid * 512 + F.tid; idx < DEPTH * H_ATT * 7 * 1024; idx += F.G * 512) { const int reg = idx & 15, ln = (idx >> 4) & 63, di = (idx >> 10) % 7, lh = idx / 7168;
          int rel = 32 * di - 32 + (ln & 31) - ((reg & 3) + 8 * (reg >> 2) + 4 * (ln >> 5)); rel = rel < -REL_CLIP ? -REL_CLIP : (rel > REL_CLIP ? REL_CLIP : rel);
          bt[idx] = rbp[lh * 257 + rel + REL_CLIP] * 1.4426950408889634f; } }
    { float* dk = (float*)(F.ws + WS_DK);
      for (int idx = F.bid * 512 + F.tid; idx < H_RET * 64; idx += F.G * 512) dk[idx] = expf(log_gamma(idx >> 6) * (float)(63 - (idx & 63))); }
}
typedef float f32x16 __attribute__((ext_vector_type(16)));
typedef short bf16x8 __attribute__((ext_vector_type(8)));
typedef unsigned u32x2 __attribute__((ext_vector_type(2)));
#define MFMA32(a, b, c) __builtin_amdgcn_mfma_f32_32x32x16_bf16((a), (b), (c), 0, 0, 0)
constexpr float LOG2E = 1.4426950408889634f;
__device__ __forceinline__ int crow(int r, int hi) { return (r & 3) + 8 * (r >> 2) + 4 * hi; }
typedef float f32x2_t __attribute__((ext_vector_type(2))); typedef __bf16 bf16x2_t __attribute__((ext_vector_type(2)));
__device__ __forceinline__ unsigned cvtpk(float lo, float hi) { f32x2_t v = {lo, hi}; bf16x2_t b = __builtin_convertvector(v, bf16x2_t); return __builtin_bit_cast(unsigned, b); }
template <int T8> __device__ __forceinline__ bf16x8 packfrag(const f32x16& x) {
    v4u p; p.x = cvtpk(x[8 * T8 + 0], x[8 * T8 + 1]); p.y = cvtpk(x[8 * T8 + 2], x[8 * T8 + 3]); p.z = cvtpk(x[8 * T8 + 4], x[8 * T8 + 5]); p.w = cvtpk(x[8 * T8 + 6], x[8 * T8 + 7]);
    return __builtin_bit_cast(bf16x8, p);
}
__device__ __forceinline__ f32x16 splat16(float v) { f32x16 r;
#pragma unroll
    for (int i = 0; i < 16; ++i) r[i] = v;
    return r; }
__device__ __forceinline__ float ex2(float x) { return __builtin_amdgcn_exp2f(x); }
constexpr size_t FRAG_T = 6291456;
__device__ __forceinline__ const bf16x8* ftok(const bf16* base, int bh, int blk, int lane) { return (const bf16x8*)(base + ((size_t)(bh * 64 + blk) * 4) * 512) + lane; }
__device__ __forceinline__ const bf16x8* fdim(const bf16* base, int bh, int kb16, int lane) { return (const bf16x8*)(base + ((size_t)(bh * 128 + kb16) * 2) * 512) + lane; }

constexpr int ATT_SLOT = 16384, ATT_NSLOT = 8;
__device__ __forceinline__ void attn_dma(const bf16* KF, const bf16* VF, int bh, int c, LAS unsigned char* ring, int w, int lane) {
    const int slot = c & (ATT_NSLOT - 1);
    const bf16x8* kg = ftok(KF, bh, 2 * c, lane) + 64 * w; const bf16x8* vg = fdim(VF, bh, 4 * c, lane) + 64 * w;
    __builtin_amdgcn_global_load_lds((const unsigned*)kg, (LAS unsigned*)(ring + slot * ATT_SLOT + w * 1024), 16, 0, 0);
    __builtin_amdgcn_global_load_lds((const unsigned*)vg, (LAS unsigned*)(ring + slot * ATT_SLOT + 8192 + w * 1024), 16, 0, 0);
}
template <bool TILE> __device__ __forceinline__ void attn_step(f32x16& o0, f32x16& o1, float& mref, float& lsum, const bf16x8 (&qf)[4], const LAS unsigned char* slotp, const int lane,
                                                              const float cbias, const f32x4 (&bt)[8]) {
    bf16x8 kf[8], vf[8];
    { const unsigned la = (unsigned)(uintptr_t)slotp + (unsigned)lane * 16u;
#define ATT_DSR(dst, off) asm volatile("ds_read_b128 %0, %1 offset:" #off : "=v"(dst) : "v"(la))
      ATT_DSR(kf[0], 0); ATT_DSR(kf[1], 1024); ATT_DSR(kf[2], 2048); ATT_DSR(kf[3], 3072); ATT_DSR(kf[4], 4096); ATT_DSR(kf[5], 5120); ATT_DSR(kf[6], 6144); ATT_DSR(kf[7], 7168);
      ATT_DSR(vf[0], 8192); ATT_DSR(vf[1], 9216); ATT_DSR(vf[2], 10240); ATT_DSR(vf[3], 11264); ATT_DSR(vf[4], 12288); ATT_DSR(vf[5], 13312); ATT_DSR(vf[6], 14336); ATT_DSR(vf[7], 15360);
#undef ATT_DSR
      asm volatile("s_waitcnt lgkmcnt(8)" : "+v"(kf[0]), "+v"(kf[1]), "+v"(kf[2]), "+v"(kf[3]), "+v"(kf[4]), "+v"(kf[5]), "+v"(kf[6]), "+v"(kf[7]));
      __builtin_amdgcn_sched_barrier(0); }
    f32x16 p0, p1;
    if constexpr (TILE) {
#pragma unroll
        for (int i = 0; i < 4; ++i) { p0[i] = bt[0][i] - mref; p0[4 + i] = bt[1][i] - mref; p0[8 + i] = bt[2][i] - mref; p0[12 + i] = bt[3][i] - mref;
                                      p1[i] = bt[4][i] - mref; p1[4 + i] = bt[5][i] - mref; p1[8 + i] = bt[6][i] - mref; p1[12 + i] = bt[7][i] - mref; }
    } else { p0 = splat16(cbias - mref); p1 = p0; }
#pragma unroll
    for (int s = 0; s < 4; ++s) { p0 = MFMA32(kf[s], qf[s], p0); p1 = MFMA32(kf[4 + s], qf[s], p1); }
#define ATT_MX3(a, b, c) __builtin_fmaxf(__builtin_fmaxf((a), (b)), (c))
    { float ra = ATT_MX3(p0[0], p0[1], p1[0]), rb2 = ATT_MX3(p0[2], p0[3], p1[1]); ra = ATT_MX3(ra, p1[2], p1[3]);
#pragma unroll
      for (int r = 4; r < 16; r += 4) { ra = ATT_MX3(ra, p0[r], p0[r + 1]); rb2 = ATT_MX3(rb2, p0[r + 2], p0[r + 3]); ra = ATT_MX3(ra, p1[r], p1[r + 1]); rb2 = ATT_MX3(rb2, p1[r + 2], p1[r + 3]); }
      float rm = __builtin_fmaxf(ra, rb2);
      if (__builtin_expect(__any(rm > 20.0f), 0)) {
          rm = __builtin_fmaxf(rm, __shfl_xor(rm, 32)); const float d = rm > 20.0f ? rm : 0.f, f = ex2(-d); mref += d; lsum *= f;
#pragma unroll
          for (int r = 0; r < 16; ++r) { p0[r] -= d; p1[r] -= d; o0[r] *= f; o1[r] *= f; } } }
#undef ATT_MX3
    float ps = 0.f;
#pragma unroll
    for (int r = 0; r < 16; ++r) { p0[r] = ex2(p0[r]); p1[r] = ex2(p1[r]); ps += p0[r] + p1[r]; }
    lsum += ps;
    asm volatile("s_waitcnt lgkmcnt(0)" : "+v"(vf[0]), "+v"(vf[1]), "+v"(vf[2]), "+v"(vf[3]), "+v"(vf[4]), "+v"(vf[5]), "+v"(vf[6]), "+v"(vf[7]));
    __builtin_amdgcn_sched_barrier(0);
    { bf16x8 pf;
      pf = packfrag<0>(p0); o0 = MFMA32(vf[0], pf, o0); o1 = MFMA32(vf[1], pf, o1);
      pf = packfrag<1>(p0); o0 = MFMA32(vf[2], pf, o0); o1 = MFMA32(vf[3], pf, o1);
      pf = packfrag<0>(p1); o0 = MFMA32(vf[4], pf, o0); o1 = MFMA32(vf[5], pf, o1);
      pf = packfrag<1>(p1); o0 = MFMA32(vf[6], pf, o0); o1 = MFMA32(vf[7], pf, o1); }
}
__device__ __forceinline__ void attn_block_unit(Frame& F, const bf16* QF, const bf16* KF, const bf16* VF, const float* BT, const float* rb, bf16* MIX, int bh, int n0) {
    const int w = F.wave, lane = F.lane, hi = lane >> 5, q = lane & 31, jn = w >> 1, qh = w & 1, n = n0 + jn, h = bh % 6, b = bh / 6;
    LAS unsigned char* ring = F.lds + RING_OFF;
    bf16x8 qf[4];
    { const bf16x8* qp = ftok(QF, bh, n * 2 + qh, lane);
#pragma unroll
      for (int s = 0; s < 4; ++s) qf[s] = qp[64 * s]; }
    f32x16 o0 = splat16(0.f), o1 = splat16(0.f); float mref = 0.f, lsum = 0.f;
    const float cbias = rb[h * 257 + 256] * LOG2E;
    const int t0 = 5 - n0 < 0 ? 0 : 5 - n0;
    const int cmin = n0 - 8 < 0 ? 0 : n0 - 8, NB = n0 + 4 - cmin;
    const GAS float* btg = (const GAS float*)BT + ((size_t)(h * 7) * 64 + lane) * 16;
    f32x4 bt[8];
#pragma unroll
    for (int i = 0; i < 8; ++i) bt[i] = (f32x4){0.f, 0.f, 0.f, 0.f};
    int nis = 0;
    for (; nis < NB && nis <= n0 - 5 + t0 - cmin + 2; ++nis) attn_dma(KF, VF, bh, cmin + nis, ring, w, lane);
    for (int t = t0; t <= 8; ++t) {
        if (t <= 6) asm volatile("s_waitcnt vmcnt(4) lgkmcnt(0)\n\ts_barrier" ::: "memory"); else asm volatile("s_waitcnt vmcnt(0) lgkmcnt(0)\n\ts_barrier" ::: "memory");
        f32x4 btn[8];
        if (t >= 5 && t < 8) { const int D0 = 64 * (7 - t) + 32 * qh, D1 = D0 - 32; const int i0 = D0 >= 160 ? 6 : (D0 + 32) >> 5, i1 = D1 >= 160 ? 6 : (D1 + 32) >> 5;
            const GAS f32x4* bp = (const GAS f32x4*)(btg + i0 * 1024); const GAS f32x4* bq = (const GAS f32x4*)(btg + i1 * 1024);
#pragma unroll
            for (int i = 0; i < 4; ++i) { btn[i] = bp[i]; btn[4 + i] = bq[i]; } }
        else {
#pragma unroll
            for (int i = 0; i < 8; ++i) btn[i] = bt[i]; }
        if (nis < NB && nis <= n0 - 5 + t - cmin + 3) { attn_dma(KF, VF, bh, cmin + nis, ring, w, lane); ++nis; }
        const int c = n - 8 + t;
        if (c >= 0) {
            const LAS unsigned char* slotp = ring + (c & (ATT_NSLOT - 1)) * ATT_SLOT;
            if (t < 6) attn_step<false>(o0, o1, mref, lsum, qf, slotp, lane, cbias, bt); else attn_step<true>(o0, o1, mref, lsum, qf, slotp, lane, cbias, bt);
        }
#pragma unroll
        for (int i = 0; i < 8; ++i) bt[i] = btn[i];
    }
    lsum += __shfl_xor(lsum, 32);
    const float inv = 1.0f / lsum;
    bf16* op = MIX + (size_t)(b * SEQ + n * CHUNK + qh * 32 + q) * 1024 + h * 64 + 4 * hi;
#pragma unroll
    for (int g = 0; g < 4; ++g) { u32x2 wv;
        wv.x = cvtpk(o0[4 * g] * inv, o0[4 * g + 1] * inv); wv.y = cvtpk(o0[4 * g + 2] * inv, o0[4 * g + 3] * inv); *(u32x2*)(op + 8 * g) = wv;
        wv.x = cvtpk(o1[4 * g] * inv, o1[4 * g + 1] * inv); wv.y = cvtpk(o1[4 * g + 2] * inv, o1[4 * g + 3] * inv); *(u32x2*)(op + 32 + 8 * g) = wv; }
    __syncthreads();
}
__device__ __forceinline__ void ret_state_unit(Frame& F, const bf16* KTr, const bf16* VFr, bf16* STg, int bh) {
    const int w = F.wave, lane = F.lane, tid = F.tid, hi = lane >> 5, cq = lane & 31, h = bh % 6, jc = w >> 1, hw = w & 1;
    LAS float* KVS = (LAS float*)(F.lds + RING_OFF);
    const float dec = expf(log_gamma(h) * 64.0f);
    const int se = tid >> 3, sd = tid & 7;
    const int st_off = ((((se >> 5) * 4 + (sd >> 1)) * 64 + (sd & 1) * 32 + (se & 31)) * 8);
    f32x4 st0 = {0.f, 0.f, 0.f, 0.f}, st1 = st0;
    bf16x8 kk[8], vv[4];
    { const bf16x8* kp = fdim(KTr, bh, 4 * jc, lane); const bf16x8* vp = fdim(VFr, bh, 4 * jc, lane) + 64 * hw;
#pragma unroll
      for (int s = 0; s < 4; ++s) { kk[2 * s] = kp[128 * s]; kk[2 * s + 1] = kp[128 * s + 64]; vv[s] = vp[128 * s]; } }
    for (int r = 0; r < 8; ++r) {
        f32x16 a0 = splat16(0.f), a1 = splat16(0.f);
#pragma unroll
        for (int s = 0; s < 4; ++s) { a0 = MFMA32(vv[s], kk[2 * s], a0); a1 = MFMA32(vv[s], kk[2 * s + 1], a1); }
        if (r < 7) { const int n1 = 4 * (r + 1) + jc; const bf16x8* kp = fdim(KTr, bh, 4 * n1, lane); const bf16x8* vp = fdim(VFr, bh, 4 * n1, lane) + 64 * hw;
#pragma unroll
          for (int s = 0; s < 4; ++s) { kk[2 * s] = kp[128 * s]; kk[2 * s + 1] = kp[128 * s + 64]; vv[s] = vp[128 * s]; } }
        { LAS float* out = KVS + jc * 4096 + 32 * hw * 64 + cq;
#pragma unroll
          for (int i = 0; i < 16; ++i) { const int e = crow(i, hi); out[e * 64] = a0[i]; out[e * 64 + 32] = a1[i]; } }
        __syncthreads();
#pragma unroll
        for (int j = 0; j < 4; ++j) {
            v4u pk; pk.x = cvtpk(st0[0], st0[1]); pk.y = cvtpk(st0[2], st0[3]); pk.z = cvtpk(st1[0], st1[1]); pk.w = cvtpk(st1[2], st1[3]);
            *(v4u*)(STg + ((size_t)(bh * 32 + 4 * r + j)) * 4096 + st_off) = pk;
            const LAS float* kvp = KVS + j * 4096 + se * 64 + 8 * sd; const f32x4 x0 = *(const LAS f32x4*)kvp, x1 = *(const LAS f32x4*)(kvp + 4);
            st0 = st0 * dec + x0; st1 = st1 * dec + x1; }
        __syncthreads();
    }
}
__device__ __forceinline__ void rout_unit(const bf16* QFr, const bf16* KFr, const bf16* VFr, const bf16* STg, const bf16* G, const float* gn_g, bf16* MIX, int b, int h, int n, int ch, int lane) {
    const int bh = b * 6 + h, hi = lane >> 5, cq = lane & 31, cc = 32 * ch + cq;
    const float lg2 = log_gamma(h) * LOG2E;
    const size_t token = (size_t)b * SEQ + n * CHUNK + cc;
    bf16x8 qf[4], kf[8], vf[8], sf[8]; u32x2 gw[8];
    { const bf16x8* qp = ftok(QFr, bh, n * 2 + ch, lane); const bf16x8* kp = ftok(KFr, bh, n * 2, lane); const bf16x8* vp = fdim(VFr, bh, 4 * n, lane);
      const bf16x8* sp = (const bf16x8*)(STg + ((size_t)(bh * 32 + n)) * 4096) + lane;
      const bf16* gp = G + token * 384 + h * 64 + 4 * hi;
#pragma unroll
      for (int s = 0; s < 4; ++s) qf[s] = qp[64 * s];
#pragma unroll
      for (int s = 0; s < 8; ++s) kf[s] = kp[64 * s];
#pragma unroll
      for (int s = 0; s < 8; ++s) sf[s] = sp[64 * s];
#pragma unroll
      for (int s = 0; s < 8; ++s) vf[s] = vp[64 * s];
#pragma unroll
      for (int g = 0; g < 4; ++g) { gw[g] = *(const u32x2*)(gp + 8 * g); gw[4 + g] = *(const u32x2*)(gp + 32 + 8 * g); } }
    f32x16 s0 = splat16(0.f), s1 = splat16(0.f);
#pragma unroll
    for (int s = 0; s < 4; ++s) { s0 = MFMA32(kf[s], qf[s], s0); s1 = MFMA32(kf[4 + s], qf[s], s1); }
#pragma unroll
    for (int i = 0; i < 16; ++i) { const int m0 = crow(i, hi); const int d0 = cc - m0, d1 = cc - m0 - 32;
        s0[i] *= ex2(lg2 * (float)(d0 < 0 ? -d0 : d0)); s1[i] *= ex2(lg2 * (float)(d1 < 0 ? -d1 : d1)); }
    f32x16 o0 = splat16(0.f), o1 = splat16(0.f);
#pragma unroll
    for (int s = 0; s < 4; ++s) { o0 = MFMA32(sf[s], qf[s], o0); o1 = MFMA32(sf[4 + s], qf[s], o1); }
    { const float qd = ex2(lg2 * (float)(cc + 1));
#pragma unroll
      for (int i = 0; i < 16; ++i) { o0[i] *= qd; o1[i] *= qd; } }
    { bf16x8 pf;
      pf = packfrag<0>(s0); o0 = MFMA32(vf[0], pf, o0); o1 = MFMA32(vf[1], pf, o1);
      pf = packfrag<1>(s0); o0 = MFMA32(vf[2], pf, o0); o1 = MFMA32(vf[3], pf, o1);
      pf = packfrag<0>(s1); o0 = MFMA32(vf[4], pf, o0); o1 = MFMA32(vf[5], pf, o1);
      pf = packfrag<1>(s1); o0 = MFMA32(vf[6], pf, o0); o1 = MFMA32(vf[7], pf, o1); }
    float sm = 0.f;
#pragma unroll
    for (int i = 0; i < 16; ++i) sm += o0[i] + o1[i];
    sm += __shfl_xor(sm, 32); const float mu = sm * (1.0f / 64.0f);
    float vr = 0.f;
#pragma unroll
    for (int i = 0; i < 16; ++i) { o0[i] -= mu; o1[i] -= mu; vr += o0[i] * o0[i] + o1[i] * o1[i]; }
    vr += __shfl_xor(vr, 32); const float rstd = rsqrtf(vr * (1.0f / 64.0f) + EPS);
    const float* gg = gn_g + h * 64 + 4 * hi; bf16* op = MIX + token * 1024 + D_ATT + D_CONV + h * 64 + 4 * hi;
#pragma unroll
    for (int g = 0; g < 4; ++g) {
        { const f32x4 gn = *(const f32x4*)(gg + 8 * g); u32x2 wv;
          wv.x = cvtpk(o0[4 * g] * rstd * gn[0] * __uint_as_float(gw[g].x << 16), o0[4 * g + 1] * rstd * gn[1] * __uint_as_float(gw[g].x & 0xffff0000u));
          wv.y = cvtpk(o0[4 * g + 2] * rstd * gn[2] * __uint_as_float(gw[g].y << 16), o0[4 * g + 3] * rstd * gn[3] * __uint_as_float(gw[g].y & 0xffff0000u)); *(u32x2*)(op + 8 * g) = wv; }
        { const f32x4 gn = *(const f32x4*)(gg + 32 + 8 * g); u32x2 wv;
          wv.x = cvtpk(o1[4 * g] * rstd * gn[0] * __uint_as_float(gw[4 + g].x << 16), o1[4 * g + 1] * rstd * gn[1] * __uint_as_float(gw[4 + g].x & 0xffff0000u));
          wv.y = cvtpk(o1[4 * g + 2] * rstd * gn[2] * __uint_as_float(gw[4 + g].y << 16), o1[4 * g + 3] * rstd * gn[3] * __uint_as_float(gw[4 + g].y & 0xffff0000u)); *(u32x2*)(op + 32 + 8 * g) = wv; }
    }
}
__device__ __forceinline__ float dpp_sum8(float v) {
    v += __builtin_bit_cast(float, __builtin_amdgcn_update_dpp(0, __builtin_bit_cast(int, v), 0xB1, 0xF, 0xF, true));
    v += __builtin_bit_cast(float, __builtin_amdgcn_update_dpp(0, __builtin_bit_cast(int, v), 0x4E, 0xF, 0xF, true));
    v += __builtin_bit_cast(float, __builtin_amdgcn_update_dpp(0, __builtin_bit_cast(int, v), 0x141, 0xF, 0xF, true));
    return v;
}
__device__ __forceinline__ void conv_unit(Frame& F, int L, int unit, const bf16* GLU, const bf16* PWT, bf16* MIX) {
    const float* cw = F.in(7) + L * CONV_K * 256; const float* cb = F.in(8) + L * 256; const float* lng = F.in(9) + L * 256; const float* lnb = F.in(10) + L * 256; const float* pwb = F.in(12) + L * 256;
    LAS unsigned char* lds = F.lds + RING_OFF; LAS float* Y = (LAS float*)(lds + 49152);
    const int t0 = unit * 64, s0 = t0 & 2047, tid = F.tid, lane = F.lane, w = F.wave;
    const int cp = tid & 127, tg = tid >> 7;
    f32x2_t wv[31];
#pragma unroll
    for (int j = 0; j < 31; ++j) wv[j] = *(const f32x2_t*)(cw + j * 256 + 2 * cp);
    const f32x2_t bb = *(const f32x2_t*)(cb + 2 * cp);
    for (int i = tid; i < 94 * 32; i += 512) { const int r = i >> 5, c16 = i & 31; v4u v = {0u, 0u, 0u, 0u};
        if (s0 - 30 + r >= 0) v = *(const v4u*)(GLU + (size_t)(t0 - 30 + r) * 256 + c16 * 8);
        *(LAS v4u*)(lds + r * 512 + c16 * 16) = v; }
    __syncthreads();
    { unsigned win[46];
#pragma unroll
      for (int i = 0; i < 46; ++i) win[i] = *(const LAS unsigned*)(lds + (tg * 16 + i) * 512 + cp * 4);
#pragma unroll
      for (int tt = 0; tt < 16; ++tt) { f32x2_t a = bb;
#pragma unroll
          for (int j = 0; j < 31; ++j) { const f32x2_t x = {__uint_as_float(win[tt + j] << 16), __uint_as_float(win[tt + j] & 0xffff0000u)}; a = __builtin_elementwise_fma(x, wv[j], a); }
          *(LAS f32x2_t*)(Y + (tg * 16 + tt) * 256 + 2 * cp) = a; } }
    const int hi = lane >> 5;
    bf16x8 Af[16];
    { const bf16* ap = PWT + (size_t)(32 * w + (lane & 31)) * 256 + 8 * hi;
#pragma unroll
      for (int s = 0; s < 16; ++s) Af[s] = *(const bf16x8*)(ap + 16 * s); }
    __syncthreads();
    { const int t = tid >> 3, p = tid & 7;
      f32x4 v[8]; float sm = 0.f;
#pragma unroll
      for (int i = 0; i < 8; ++i) { v[i] = *(const LAS f32x4*)(Y + t * 256 + 32 * p + 4 * i); sm += (v[i].x + v[i].y) + (v[i].z + v[i].w); }
      const float mu = dpp_sum8(sm) * (1.f / 256.f); float q = 0.f;
#pragma unroll
      for (int i = 0; i < 8; ++i) { v[i] = v[i] - mu; q += (v[i].x * v[i].x + v[i].y * v[i].y) + (v[i].z * v[i].z + v[i].w * v[i].w); }
      const float r = rsqrtf(dpp_sum8(q) * (1.f / 256.f) + EPS);
#pragma unroll
      for (int c8 = 0; c8 < 4; ++c8) {
          const f32x4 g0 = *(const f32x4*)(lng + 32 * p + 8 * c8), g1 = *(const f32x4*)(lng + 32 * p + 8 * c8 + 4), b0 = *(const f32x4*)(lnb + 32 * p + 8 * c8), b1 = *(const f32x4*)(lnb + 32 * p + 8 * c8 + 4);
          f32x4 o0 = v[2 * c8] * r * g0 + b0, o1 = v[2 * c8 + 1] * r * g1 + b1;
#pragma unroll
          for (int j = 0; j < 4; ++j) { o0[j] *= pg8::sigm(o0[j]); o1[j] *= pg8::sigm(o1[j]); }
          v4u pk; pk.x = cvtpk(o0[0], o0[1]); pk.y = cvtpk(o0[2], o0[3]); pk.z = cvtpk(o1[0], o1[1]); pk.w = cvtpk(o1[2], o1[3]);
          *(LAS v4u*)(lds + ((((t >> 5) * 16 + 2 * p + (c8 >> 1)) * 64 + (c8 & 1) * 32 + (t & 31)) * 16)) = pk; } }
    __syncthreads();
    { f32x16 a0 = splat16(0.f), a1 = splat16(0.f);
#pragma unroll
      for (int s = 0; s < 16; ++s) { const bf16x8 B0 = *(const LAS bf16x8*)(lds + (s * 64 + lane) * 16), B1 = *(const LAS bf16x8*)(lds + ((16 + s) * 64 + lane) * 16);
          a0 = MFMA32(Af[s], B0, a0); a1 = MFMA32(Af[s], B1, a1); }
      bf16* op = MIX + (size_t)(t0 + (lane & 31)) * 1024 + D_ATT + 32 * w + 4 * hi; const float* bp = pwb + 32 * w + 4 * hi;
#pragma unroll
      for (int g = 0; g < 4; ++g) { const f32x4 bv = *(const f32x4*)(bp + 8 * g); u32x2 x;
          x.x = cvtpk(a0[4 * g] + bv[0], a0[4 * g + 1] + bv[1]); x.y = cvtpk(a0[4 * g + 2] + bv[2], a0[4 * g + 3] + bv[3]); *(u32x2*)(op + 8 * g) = x;
          x.x = cvtpk(a1[4 * g] + bv[0], a1[4 * g + 1] + bv[1]); x.y = cvtpk(a1[4 * g + 2] + bv[2], a1[4 * g + 3] + bv[3]); *(u32x2*)(op + 32 * 1024 + 8 * g) = x; } }
    __syncthreads();
}

template <int SUB> __device__ __forceinline__ void layer_phase(Frame& F, const int L) {
    bf16* HBP = (bf16*)(F.ws + WS_HB + (size_t)(L & 1) * HB_BYTES); bf16* HBQ = (bf16*)(F.ws + WS_HB + (size_t)((L + 1) & 1) * HB_BYTES);
    float* SS0 = (float*)(F.ws + WS_SS); float* SS1 = SS0 + (size_t)M * 16; float* SS2 = SS1 + (size_t)M * 16;
    bf16* PJ = (bf16*)(F.ws + WS_PROJ); bf16* MIX = (bf16*)(F.ws + WS_MIX);
    bf16 *QFa = PJ, *KFa = PJ + FRAG_T, *VFa = PJ + 2 * FRAG_T, *QFr = PJ + 3 * FRAG_T, *KFr = PJ + 4 * FRAG_T, *KTr = PJ + 5 * FRAG_T, *VFr = PJ + 6 * FRAG_T, *GG = PJ + 7 * FRAG_T, *GLU = PJ + 8 * FRAG_T;
    bf16* HID = (bf16*)(F.ws + WS_HID); bf16* PLE = (bf16*)(F.ws + WS_PLE);
    const bf16* WB = (const bf16*)(F.ws + WS_WBUF + (size_t)(L & 1) * WBUF_BYTES);
    if constexpr (SUB == 0) {
        pg8::InProjOrder S; S.init(M, NIN_ROWS, 1024, F.G, F.bid, HBP, WB + WO_WIN);
        pg8::EpiInProj E{{PJ, SS0, F.in(4) + L * 64, F.in(5) + L * 64, F.ws + WS_CS}};
        pg8::gemm_phase<pg8::EpiInProj, pg8::InProjOrder, true, true>(F.lds + RING_OFF, 1024, S, E, F.tid);
        if (F.G == 256) {
            __syncthreads();
            pg8::PleOrder S2; S2.init(F.bid, (const bf16*)(F.ws + ((L & 1) ? WS_PB2 : WS_PB)), WB + WO_WPLE);
            pg8::EpiBf16<0, false> E2{PLE, 1024, nullptr};
            int wv2 = F.wave; asm volatile("" : "+s"(wv2));
            const int t2 = wv2 * 64 + (int)__builtin_amdgcn_mbcnt_hi(~0u, __builtin_amdgcn_mbcnt_lo(~0u, 0u));
            int kk = 256; asm volatile("" : "+s"(kk));
            pg8::gemm_phase<pg8::EpiBf16<0, false>, pg8::PleOrder, false, true>(F.lds + RING_OFF, kk, S2, E2, t2);
        }
    } else if constexpr (SUB == 1 || SUB == 2) {
        const int qx = F.bid & 7;
        const float* bt = (const float*)(F.ws + WS_BT) + (size_t)L * H_ATT * 7 * 1024; const float* rb = F.in(6) + L * H_ATT * 257; const float* gn = F.in(13) + L * D_RET;
        bf16* STg = (bf16*)(F.ws + WS_ST);
        gu32* qctr = (gu32*)(F.ws + WS_CTL) + CW_QUEUE + (L * 2 + (SUB - 1)) * 256 + qx * 16 + 8 * F.dup;
        volatile LAS unsigned* qslot = (volatile LAS unsigned*)(F.lds + MISC_OFF) + 16;
        constexpr int NITEMS = SUB == 1 ? 6 + 24 + 32 : 24 + 48;
        for (;;) {
            __syncthreads();
            if (F.tid == 0) *qslot = __hip_atomic_fetch_add(qctr, 1u, __ATOMIC_RELAXED, __HIP_MEMORY_SCOPE_AGENT);
            __syncthreads();
            const int it = (int)__builtin_amdgcn_readfirstlane(*qslot);
            if (it >= NITEMS) break;
            Frame F2 = F; { int t_ = F.tid; asm volatile("" : "+v"(t_)); F2.tid = t_; F2.lane = t_ & 63; }
            int au = -1;
            if constexpr (SUB == 1) {
                if (it < 6) ret_state_unit(F2, KTr, VFr, STg, 6 * qx + it);
                else if (it < 30) au = it - 6;
                else conv_unit(F2, L, 32 * qx + (it - 30), GLU, WB + WO_PW, MIX);
            } else {
                if (it < 24) au = 24 + it;
                else { const int u = it - 24, bh = 6 * qx + (u >> 3), n = 4 * (u & 7) + (F2.wave >> 1); rout_unit(QFr, KFr, VFr, STg, GG, gn, MIX, bh / 6, bh % 6, n, F2.wave & 1, F2.lane); }
            }
            if (au >= 0) { int grp, hh; if (au < 36) { grp = 2 + au / 6; hh = au % 6; } else { grp = 1 - (au - 36) / 6; hh = (au - 36) % 6; }
                attn_block_unit(F2, QFa, KFa, VFa, bt, rb, MIX, 6 * qx + hh, 4 * grp); }
        }
        __syncthreads();
        if constexpr (SUB == 2) { if (L + 1 < DEPTH) { convert_p(F, L + 1); convert_layer(F, L + 1); } }
    } else if constexpr (SUB == 3) {
        pg8::StaticOrder S; S.init(M, 1024, 1024, F.G, F.bid, MIX, WB + WO_WO);
        pg8::EpiRes<false> E{HBP, HBQ, SS1, nullptr, nullptr, nullptr};
        pg8::gemm_phase<pg8::EpiRes<false>, pg8::StaticOrder, false, true>(F.lds + RING_OFF, 1024, S, E, F.tid);
    } else if constexpr (SUB == 4) {
        pg8::StaticOrder S; S.init(M, 4096, 1024, F.G, F.bid, HBQ, WB + WO_W1);
        pg8::EpiBf16<1, true> E{HID, 4096, SS1};
        pg8::gemm_phase<pg8::EpiBf16<1, true>, pg8::StaticOrder, true, true>(F.lds + RING_OFF, 1024, S, E, F.tid);
    } else if constexpr (SUB == 5) {
        pg8::StaticOrder S; S.init(M, 1024, 4096, F.G, F.bid, HID, WB + WO_W2);
        pg8::EpiRes<false> E{HBQ, HBP, SS2, nullptr, nullptr, nullptr};
        pg8::gemm_phase<pg8::EpiRes<false>, pg8::StaticOrder, false, true>(F.lds + RING_OFF, 4096, S, E, F.tid);
    } else {
        if (F.G != 256) { pg8::StaticOrder S; S.init(M, 1024, 256, F.G, F.bid, (const bf16*)(F.ws + ((L & 1) ? WS_PB2 : WS_PB)), WB + WO_WPLE);
          pg8::EpiBf16<0, false> E{PLE, 1024, nullptr};
          pg8::gemm_phase<pg8::EpiBf16<0, false>, pg8::StaticOrder, false, true>(F.lds + RING_OFF, 256, S, E, F.tid); }
        __syncthreads();
        { pg8::StaticOrder S; S.init(M, 1024, 1024, F.G, F.bid, HBP, WB + WO_WPG);
          pg8::EpiRes<true> E{HBP, HBQ, SS0, SS2, PLE, L == DEPTH - 1 ? F.H : nullptr};
          pg8::gemm_phase<pg8::EpiRes<true>, pg8::StaticOrder, false, true>(F.lds + RING_OFF, 1024, S, E, F.tid); }
    }
}
constexpr int PH_PER_LAYER = 7, N_PHASES = 1 + PH_PER_LAYER * DEPTH;
__global__ void __launch_bounds__(NWAVES * 64, 2) mk_fwd(Args args) {
    extern __shared__ __attribute__((aligned(16))) unsigned char lds[];
    LAS unsigned char* const ldsb = (LAS unsigned char*)lds;
    for (int u = threadIdx.x; u < (LDS_BYTES - LDSCTL_OFF) / 4; u += NWAVES * 64) ((LAS unsigned*)(ldsb + LDSCTL_OFF))[u] = 0u;
    __syncthreads();
    if (threadIdx.x == 0) {
        LAS unsigned long long* P = (LAS unsigned long long*)(ldsb + PTR_OFF);
#pragma unroll
        for (int i = 0; i < 21; ++i) P[i] = (unsigned long long)(uintptr_t)args.in[i];
        P[21] = (unsigned long long)(uintptr_t)args.out; P[22] = (unsigned long long)(uintptr_t)args.ws;
    }
    __syncthreads();
    XcdBarrier bar; { unsigned char* ws0 = args.ws; bar.bar = (unsigned*)(ws0 + WS_CTL) + CW_BAR; bar.x = 0; bar.st = nullptr;
    const bool multi = (args.ph_hi - args.ph_lo) > 1;
    if (multi) bar = xcd_barrier_post((unsigned*)(ws0 + WS_CTL) + CW_BAR, (volatile LAS unsigned*)(ldsb + MISC_OFF) + 8); }
    const int lo = args.ph_lo, hi = args.ph_hi;
    const int wave0 = __builtin_amdgcn_readfirstlane(threadIdx.x >> 6);
#define FRAME_INIT() \
        int wv_ = wave0, bid_ = blockIdx.x; \
        { volatile LAS unsigned* ms_ = (volatile LAS unsigned*)(ldsb + MISC_OFF) + 8; const unsigned md_ = ms_[3], rk_ = ms_[2], xc_ = ms_[4]; bid_ = __builtin_amdgcn_readfirstlane(md_ == 1u ? (int)(rk_ * 8u + xc_) : bid_); }     \
        asm volatile("" : "+s"(wv_)); asm volatile("" : "+s"(bid_)); \
        int tid_ = wv_ * 64 + (int)__builtin_amdgcn_mbcnt_hi(~0u, __builtin_amdgcn_mbcnt_lo(~0u, 0u)); \
        Frame F; F.lds = ldsb; F.tid = tid_; F.lane = tid_ & 63; F.wave = __builtin_amdgcn_readfirstlane(tid_ >> 6); \
        F.G = gridDim.x; F.bid = bid_; F.gw = F.bid * NWAVES + F.wave; F.ngw = F.G * NWAVES; F.dup = 0; \
        { LAS unsigned long long* P = (LAS unsigned long long*)(ldsb + PTR_OFF); \
          F.H = (float*)(uintptr_t)rfl64(P[21]); F.ws = (unsigned char*)(uintptr_t)rfl64(P[22]); }
#define GRID_BAR(LOC) do { XcdBarrier b2; b2.local = (LOC); b2.bar = (unsigned*)(F.ws + WS_CTL) + CW_BAR; b2.x = xb_xcc_id(); b2.st = (volatile LAS unsigned*)(F.lds + MISC_OFF) + 8; xcd_barrier(b2); } while (0)
#define RUN_PHASE(ph, call) if (lo <= (ph) && (ph) < hi) { FRAME_INIT(); call; if ((ph) + 1 < hi) GRID_BAR(false); }
#ifndef MK_DUP_SUB
#define MK_DUP_SUB -1
#endif
#define RUN_PHASE_L(ph, SUBI, L) if (lo <= (ph) && (ph) < hi) { FRAME_INIT(); layer_phase<SUBI>(F, (L)); if (SUBI == MK_DUP_SUB) { GRID_BAR(false); F.dup = 1; layer_phase<SUBI>(F, (L)); } if ((ph) + 1 < hi) GRID_BAR(SUBI != 3 && SUBI != 6); }
    RUN_PHASE(0, prologue(F))
#define RUN_LAYER(L) \
    RUN_PHASE_L(1 + 7 * (L) + 0, 0, L) RUN_PHASE_L(1 + 7 * (L) + 1, 1, L) RUN_PHASE_L(1 + 7 * (L) + 2, 2, L) RUN_PHASE_L(1 + 7 * (L) + 3, 3, L) \
    RUN_PHASE_L(1 + 7 * (L) + 4, 4, L) RUN_PHASE_L(1 + 7 * (L) + 5, 5, L) RUN_PHASE_L(1 + 7 * (L) + 6, 6, L)
    RUN_LAYER(0) RUN_LAYER(1) RUN_LAYER(2) RUN_LAYER(3)
}

extern "C" void kernel_launch(void* const* d_in, const int* in_sizes, int n_in, void* d_out, int out_size, void* d_ws, size_t ws_size, hipStream_t stream) {
    static int grid = 0;
    if (grid == 0) {
        if (n_in != 21 || out_size != M * D_MODEL || ws_size < WS_END) { fprintf(stderr, "kernel_launch: unexpected shapes / workspace (%d inputs, out %d, ws %zu)\n", n_in, out_size, ws_size); grid = -1; return; }
        int dev = 0, cus = 0, per_cu = 0;
        if (hipGetDevice(&dev) != hipSuccess || hipDeviceGetAttribute(&cus, hipDeviceAttributeMultiprocessorCount, dev) != hipSuccess) { grid = -1; return; }
        if (hipFuncSetAttribute((const void*)mk_fwd, hipFuncAttributeMaxDynamicSharedMemorySize, LDS_BYTES) != hipSuccess) { fprintf(stderr, "kernel_launch: hipFuncSetAttribute failed\n"); grid = -1; return; }
        if (hipOccupancyMaxActiveBlocksPerMultiprocessor(&per_cu, (const void*)mk_fwd, NWAVES * 64, LDS_BYTES) != hipSuccess || per_cu < 1) { fprintf(stderr, "kernel_launch: occupancy query says %d\n", per_cu); per_cu = 1; }
        (void)hipGetLastError();
        grid = cus;
    }
    if (grid < 0) return;
    if (hipMemsetAsync((char*)d_ws + WS_CTL, 0, CTL_ZERO_BYTES, stream) != hipSuccess) return;
    Args a{};
    for (int i = 0; i < 21; ++i) a.in[i] = (const float*)d_in[i];
    a.out = (float*)d_out; a.ws = (unsigned char*)d_ws;
#if MK_PER_PHASE
    for (int ph = 0; ph < N_PHASES; ++ph) { a.ph_lo = ph; a.ph_hi = ph + 1; hipLaunchKernelGGL(mk_fwd, dim3(grid), dim3(NWAVES * 64), LDS_BYTES, stream, a); }
#else
    a.ph_lo = 0; a.ph_hi = N_PHASES;
    void* kargs[] = {&a};
    hipError_t e = hipLaunchCooperativeKernel((const void*)mk_fwd, dim3(grid), dim3(NWAVES * 64), kargs, LDS_BYTES, stream);
    if (e != hipSuccess) fprintf(stderr, "kernel_launch: cooperative launch failed: %s (grid %d)\n", hipGetErrorString(e), grid);
#endif
}
```
